# Optimizing an MI355X kernel written in HIP

```python
import jax, jax.numpy as jnp
from jax import lax
import numpy as np

D_MODEL = 2048
BATCH = 2
SEQ = 4096
DEPTH = 4

GRID_W = 64
CTX_LEN = 256

N_HEADS = 4
D_KEY = D_MODEL // 2
D_VAL = D_MODEL
HEAD_K = D_KEY // N_HEADS
HEAD_V = D_VAL // N_HEADS
GATE_RANK = 16
GATE_NORM = 16.0
CHUNK = 64

POOL_WINDOWS = (2, 4, 8, 16)
D_POOL = D_MODEL // 2
POOL_GROUP = D_POOL // len(POOL_WINDOWS)

D_FF = ((8 * D_MODEL + 3 * 256 - 1) // (3 * 256)) * 256

N_BRANCH = 2
N_MOD = 6
DEEPNORM_ALPHA = (2.0 * DEPTH) ** 0.25
DEEPNORM_BETA = (8.0 * DEPTH) ** -0.25
LN_EPS = 1e-5
RMS_EPS = 1e-6

PROJ_WIDTHS = (D_KEY, D_KEY, D_VAL, D_VAL, 2 * GATE_RANK, D_POOL, N_BRANCH * D_MODEL)
D_PROJ = sum(PROJ_WIDTHS)
SPLIT_POINTS = tuple(int(s) for s in np.cumsum(PROJ_WIDTHS)[:-1])

kernel_name = "hybrid_gla_pool_diffusion_trunk"


def _layer_norm(x, gain, bias):
    xf = x.astype(jnp.float32)
    mu = jnp.mean(xf, axis=-1, keepdims=True)
    var = jnp.mean(jnp.square(xf - mu), axis=-1, keepdims=True)
    y = (xf - mu) * lax.rsqrt(var + LN_EPS)
    return (y * gain + bias).astype(x.dtype)


def _modulation(cond, w_ada, b_ada):
    return jnp.split(jax.nn.silu(cond) @ w_ada + b_ada, N_MOD, axis=-1)


def _heads(t, head_dim):
    b, l, _ = t.shape
    return t.reshape(b, l, -1, head_dim).transpose(0, 2, 1, 3)


def _split_proj(proj, w_decay_up, b_decay_up):
    q, k, v, g, a_lr, p, bg = jnp.split(proj, SPLIT_POINTS, axis=-1)
    q = _heads(q * HEAD_K ** -0.5, HEAD_K)
    k = _heads(k, HEAD_K)
    v = _heads(v, HEAD_V)
    log_decay = []
    for d in range(2):
        z = a_lr[..., d * GATE_RANK:(d + 1) * GATE_RANK] @ w_decay_up[d] + b_decay_up[d]
        log_decay.append(_heads(jax.nn.log_sigmoid(z.astype(jnp.float32)) / GATE_NORM, HEAD_K))
    return q, k, v, log_decay[0], log_decay[1], g, p, bg


def _gla_chunked(q, k, v, log_a, s0):
    b_, h_, l_, _ = q.shape
    n = l_ // CHUNK

    def chunks(t):
        return t.reshape(b_, h_, n, CHUNK, t.shape[-1]).astype(jnp.float32)

    q, k, v, log_a = chunks(q), chunks(k), chunks(v), chunks(log_a)
    cum = jnp.cumsum(log_a, axis=3)
    ref = cum[:, :, :, CHUNK // 2 - 1:CHUNK // 2]
    q_in = q * jnp.exp(cum - ref)
    k_in = k * jnp.exp(ref - cum)
    scores = jnp.einsum('bhnid,bhnjd->bhnij', q_in, k_in)
    mask = jnp.tril(jnp.ones((CHUNK, CHUNK), dtype=bool))
    scores = jnp.where(mask, scores, 0.0)
    o_intra = jnp.einsum('bhnij,bhnjv->bhniv', scores, v)
    last = cum[:, :, :, -1:]
    q_inter = q * jnp.exp(cum)
    k_state = k * jnp.exp(last - cum)
    decay_chunk = jnp.exp(last[:, :, :, 0, :])
    xs = (jnp.moveaxis(q_inter, 2, 0), jnp.moveaxis(k_state, 2, 0),
          jnp.moveaxis(v, 2, 0), jnp.moveaxis(decay_chunk, 2, 0))

    def step(state, inp):
        qc, kc, vc, dc = inp
        o = jnp.einsum('bhid,bhdv->bhiv', qc, state)
        state = dc[..., None] * state + jnp.einsum('bhjd,bhjv->bhdv', kc, vc)
        return state, o

    s_final, o_inter = lax.scan(step, s0.astype(jnp.float32), xs)
    o = o_intra + jnp.moveaxis(o_inter, 0, 2)
    return o.reshape(b_, h_, l_, HEAD_V), s_final


def _gla_two_way(q, k, v, la_fwd, la_bwd, s0_fwd, s0_bwd):
    flip = lambda t: jnp.flip(t, axis=2)
    o_f, s_f = _gla_chunked(q, k, v, la_fwd, s0_fwd)
    o_b, s_b = _gla_chunked(flip(q), flip(k), flip(v), flip(la_bwd), s0_bwd)
    return o_f + flip(o_b), s_f, s_b


def _box_mean(t, axis, window):
    n = t.shape[axis]
    lo = window // 2
    hi = window - lo - 1
    cs = jnp.cumsum(t.astype(jnp.float32), axis=axis)
    zero = jnp.zeros_like(lax.slice_in_dim(cs, 0, 1, axis=axis))
    cs = jnp.concatenate([zero, cs], axis=axis)
    idx = jnp.arange(n)
    upper = jnp.minimum(idx + hi + 1, n)
    lower = jnp.maximum(idx - lo, 0)
    total = jnp.take(cs, upper, axis=axis) - jnp.take(cs, lower, axis=axis)
    shape = [1] * t.ndim
    shape[axis] = n
    count = (upper - lower).astype(jnp.float32).reshape(shape)
    return (total / count).astype(t.dtype)


def _pool_branch(p, rows, w_pool_group, pool_scale, w_pool_out):
    outs = []
    for i, w in enumerate(POOL_WINDOWS):
        pg = p[..., i * POOL_GROUP:(i + 1) * POOL_GROUP]
        if rows is None:
            mean = _box_mean(pg, 1, w)
        else:
            b, l, ch = pg.shape
            img = pg.reshape(b, rows, GRID_W, ch)
            mean = _box_mean(_box_mean(img, 2, w), 1, w).reshape(b, l, ch)
        outs.append((mean - pg) @ w_pool_group[i])
    return (jnp.concatenate(outs, axis=-1) * pool_scale) @ w_pool_out


def _gla_output(o, g, gain, w_gla_out):
    of = o.transpose(0, 2, 1, 3)
    of = of * lax.rsqrt(jnp.mean(of * of, axis=-1, keepdims=True) + RMS_EPS)
    b, l = of.shape[:2]
    of = of.reshape(b, l, D_VAL).astype(g.dtype) * gain
    return (of * jax.nn.silu(g)) @ w_gla_out


def _merge(o, g, p, bg, rows, gla_norm_gain, w_gla_out, w_pool_group, pool_scale, w_pool_out, w_out):
    y_gla = _gla_output(o, g, gla_norm_gain, w_gla_out)
    y_pool = _pool_branch(p, rows, w_pool_group, pool_scale, w_pool_out)
    gate_gla, gate_pool = jnp.split(jax.nn.sigmoid(bg), N_BRANCH, axis=-1)
    return (gate_gla * y_gla + gate_pool * y_pool) @ w_out


def _token_mixer(h_lat, h_ctx, rows, ctx_out, w_in, w_decay_up, b_decay_up, gla_norm_gain,
                 w_pool_group, pool_scale, w_gla_out, w_pool_out, w_out):
    q_c, k_c, v_c, laf_c, lab_c, g_c, p_c, bg_c = _split_proj(h_ctx @ w_in, w_decay_up, b_decay_up)
    q_l, k_l, v_l, laf_l, lab_l, g_l, p_l, bg_l = _split_proj(h_lat @ w_in, w_decay_up, b_decay_up)
    s0 = jnp.zeros((h_lat.shape[0], N_HEADS, HEAD_K, HEAD_V), jnp.float32)
    o_c, s_fwd, s_bwd = _gla_two_way(q_c, k_c, v_c, laf_c, lab_c, s0, s0)
    o_l, _, _ = _gla_two_way(q_l, k_l, v_l, laf_l, lab_l, s_fwd, s_bwd)
    y_lat = _merge(o_l, g_l, p_l, bg_l, rows, gla_norm_gain, w_gla_out, w_pool_group,
                   pool_scale, w_pool_out, w_out)
    y_ctx = None
    if ctx_out:
        y_ctx = _merge(o_c, g_c, p_c, bg_c, None, gla_norm_gain, w_gla_out, w_pool_group,
                       pool_scale, w_pool_out, w_out)
    return y_lat, y_ctx


def _swiglu(h, w_ffn_in, w_ffn_out):
    gate, up = jnp.split(h @ w_ffn_in, 2, axis=-1)
    return (jax.nn.silu(gate) * up) @ w_ffn_out


def setup_inputs(seed: int = 0) -> dict:
    key = jax.random.key(seed)
    ks = jax.random.split(key, 24)
    f32 = jnp.float32
    nrm = lambda k, shape, s: jax.random.normal(k, shape, f32) * s
    L = DEPTH
    return {
        "x": nrm(ks[0], (BATCH, SEQ, D_MODEL), 1.0),
        "c": nrm(ks[1], (BATCH, D_MODEL), 1.0),
        "ctx": nrm(ks[2], (BATCH, CTX_LEN, D_MODEL), 1.0),
        "c_ctx": nrm(ks[3], (D_MODEL,), 1.0),
        "w_ada": nrm(ks[4], (L, D_MODEL, N_MOD * D_MODEL), 0.5 * D_MODEL ** -0.5),
        "b_ada": nrm(ks[5], (L, N_MOD * D_MODEL), 0.02),
        "w_in": nrm(ks[6], (L, D_MODEL, D_PROJ), D_MODEL ** -0.5),
        "w_decay_up": nrm(ks[7], (L, 2, GATE_RANK, D_KEY), GATE_RANK ** -0.5),
        "b_decay_up": nrm(ks[8], (L, 2, D_KEY), 0.1),
        "gla_norm_gain": 1.0 + nrm(ks[9], (L, D_VAL), 0.1),
        "w_pool_group": nrm(ks[10], (L, len(POOL_WINDOWS), POOL_GROUP, POOL_GROUP), POOL_GROUP ** -0.5),
        "pool_scale": 1.0 + nrm(ks[11], (L, D_POOL), 0.1),
        "w_gla_out": nrm(ks[12], (L, D_VAL, D_MODEL), D_VAL ** -0.5),
        "w_pool_out": nrm(ks[13], (L, D_POOL, D_MODEL), D_POOL ** -0.5),
        "w_out": nrm(ks[14], (L, D_MODEL, D_MODEL), DEEPNORM_BETA * D_MODEL ** -0.5),
        "ln_mix_gain": 1.0 + nrm(ks[15], (L, D_MODEL), 0.1),
        "ln_mix_bias": nrm(ks[16], (L, D_MODEL), 0.02),
        "w_ffn_in": nrm(ks[17], (L, D_MODEL, 2 * D_FF), D_MODEL ** -0.5),
        "w_ffn_out": nrm(ks[18], (L, D_FF, D_MODEL), DEEPNORM_BETA * D_FF ** -0.5),
        "ln_ffn_gain": 1.0 + nrm(ks[19], (L, D_MODEL), 0.1),
        "ln_ffn_bias": nrm(ks[20], (L, D_MODEL), 0.02),
    }


def reference(x, c, ctx, c_ctx, w_ada, b_ada, w_in, w_decay_up, b_decay_up, gla_norm_gain,
              w_pool_group, pool_scale, w_gla_out, w_pool_out, w_out, ln_mix_gain, ln_mix_bias,
              w_ffn_in, w_ffn_out, ln_ffn_gain, ln_ffn_bias):
    rows = x.shape[1] // GRID_W
    for layer in range(DEPTH):
        ctx_out = layer < DEPTH - 1
        sh_m, sc_m, gt_m, sh_f, sc_f, gt_f = _modulation(c[:, None, :], w_ada[layer], b_ada[layer])
        csh_m, csc_m, cgt_m, csh_f, csc_f, cgt_f = _modulation(c_ctx, w_ada[layer], b_ada[layer])
        h_lat = x * (1.0 + sc_m) + sh_m
        h_ctx = ctx * (1.0 + csc_m) + csh_m
        mix_lat, mix_ctx = _token_mixer(h_lat, h_ctx, rows, ctx_out, w_in[layer], w_decay_up[layer],
                                        b_decay_up[layer], gla_norm_gain[layer], w_pool_group[layer],
                                        pool_scale[layer], w_gla_out[layer], w_pool_out[layer], w_out[layer])
        x = _layer_norm(DEEPNORM_ALPHA * x + gt_m * mix_lat, ln_mix_gain[layer], ln_mix_bias[layer])
        ffn_lat = _swiglu(x * (1.0 + sc_f) + sh_f, w_ffn_in[layer], w_ffn_out[layer])
        x = _layer_norm(DEEPNORM_ALPHA * x + gt_f * ffn_lat, ln_ffn_gain[layer], ln_ffn_bias[layer])
        if ctx_out:
            ctx = _layer_norm(DEEPNORM_ALPHA * ctx + cgt_m * mix_ctx, ln_mix_gain[layer], ln_mix_bias[layer])
            ffn_ctx = _swiglu(ctx * (1.0 + csc_f) + csh_f, w_ffn_in[layer], w_ffn_out[layer])
            ctx = _layer_norm(DEEPNORM_ALPHA * ctx + cgt_f * ffn_ctx, ln_ffn_gain[layer], ln_ffn_bias[layer])
    return x
```

```cpp
#include <hip/hip_runtime.h>
#include <cstdio>
#include <cstdint>
namespace pg8 {
#define PG8_LAS __attribute__((address_space(3)))
typedef unsigned short bf16_t;
typedef short bf16x8 __attribute__((ext_vector_type(8)));
typedef float f32x4 __attribute__((ext_vector_type(4)));
typedef unsigned u32x4 __attribute__((ext_vector_type(4)));
constexpr int BM = 256, BK = 64, HALF = 128, HTB = HALF * BK * 2  , STAGE_BYTES = 8 * HTB, NXCD = 8, WGM = 8;

__host__ __device__ __forceinline__ int lds_byte(int r, int c) { const int st = (r >> 4) * 2 + (c >> 5), rr = r & 15, cc = c & 31, ob = rr * 64 + cc * 2; return st * 1024 + (ob ^ (((ob >> 9) & 1) << 5)); }
__host__ __device__ __forceinline__ void stage_rc(int b, int& R, int& C) { const int st = b / 1024, sb = b % 1024, swz = sb ^ (((sb >> 9) & 1) << 5); R = (st >> 1) * 16 + swz / 64; C = (st & 1) * 32 + (swz % 64) / 2; }
__host__ __device__ __forceinline__ int perm32(int rho) { const int n = rho >> 4, i = rho & 15; return 8 * (i >> 2) + 4 * n + (i & 3); }

struct Unit { int pm, pn; };
struct Gemm { const bf16_t* A; const bf16_t* Bt; int M, N, K; };

struct StaticOrder {
    int nM, nN, nwg, G, c;
    __host__ __device__ void init(int M, int N, int G_, int c_) { nM = M / BM; nN = N / BM; nwg = nM * nN; G = G_; c = c_; }
    __host__ __device__ bool next(int i, Unit& u) const {
        const long L = (long)i * G + c; if (L >= nwg) return false;
        int wgid = (int)L; { const int q = nwg / NXCD, r = nwg % NXCD, xcd = wgid % NXCD, off = wgid / NXCD; wgid = (xcd < r ? xcd * (q + 1) : r * (q + 1) + (xcd - r) * q) + off; }
        const int nig = WGM * nN, gid = wgid / nig, fm = gid * WGM, gsz = (nM - fm) < WGM ? (nM - fm) : WGM;
        u.pm = fm + ((wgid % nig) % gsz); u.pn = (wgid % nig) / gsz; return true;
    }
    __device__ __forceinline__ void a_ready(const Unit&) const {}
    __device__ __forceinline__ void done(const Unit&) const {}
};
__device__ __forceinline__ unsigned cvt_pk_bf16(float lo, float hi) { unsigned r; asm volatile("v_cvt_pk_bf16_f32 %0, %1, %2" : "=v"(r) : "v"(lo), "v"(hi)); return r; }
template <class Epi, class Sched, bool ALIGN_EPI = false, bool SP2 = false>
__device__ __forceinline__ void gemm_phase(PG8_LAS unsigned char* lds, const Gemm g, const Sched& S, const Epi& E) {
    const int tid = threadIdx.x, wid = __builtin_amdgcn_readfirstlane(tid >> 6), lane = tid & 63, wr = wid >> 2, wc = wid & 3, fr = lane & 15, fq = lane >> 4;
    const int K = g.K, nt = K / BK;
    unsigned voffA[2], voffB[2];
#pragma unroll
    for (int i = 0; i < 2; ++i) { int R, C; stage_rc(tid * 16 + i * 8192, R, C); const int Rb = Epi::PERM ? ((R & ~31) + perm32(R & 31)) : R;
        voffA[i] = (unsigned)(R * K + C) * 2u; voffB[i] = (unsigned)(Rb * K + C) * 2u; }
    const size_t kstep = (size_t)(BK * 2);
    const size_t hstep = (size_t)HALF * K * 2;
    const size_t tstep = 2 * hstep;
    const unsigned ldsw = (unsigned)wid * 1024u;
    const int aoff = lds_byte(wr * 64 + fr, fq * 8), boff = lds_byte(wc * 32 + fr, fq * 8);
#define PG8_SA(b, h) (((b) * 2 + (h)) * HTB)
#define PG8_SB(b, h) ((4 + (b) * 2 + (h)) * HTB)
#define PG8_STAGE(bufoff, gbase, voff) do { _Pragma("unroll") for (int _i = 0; _i < 2; ++_i) \
        __builtin_amdgcn_global_load_lds((const unsigned*)((const char*)(gbase) + (voff)[_i]), (PG8_LAS unsigned*)(lds + (bufoff) + ldsw + _i * 8192), 16, 0, 0); } while (0)
#define PG8_LDA(dst, b, h) do { _Pragma("unroll") for (int m = 0; m < 4; ++m) _Pragma("unroll") for (int k = 0; k < 2; ++k) dst[m][k] = *(const PG8_LAS bf16x8*)(lds + PG8_SA(b, h) + aoff + m * 2048 + k * 1024); } while (0)
#define PG8_LDB(dst, b, h) do { _Pragma("unroll") for (int n = 0; n < 2; ++n) _Pragma("unroll") for (int k = 0; k < 2; ++k) dst[n][k] = *(const PG8_LAS bf16x8*)(lds + PG8_SB(b, h) + boff + n * 2048 + k * 1024); } while (0)
#define PG8_MMA(ai, bj, At, Bt) do { __builtin_amdgcn_s_setprio(1); _Pragma("unroll") for (int m = 0; m < 4; ++m) _Pragma("unroll") for (int n = 0; n < 2; ++n) _Pragma("unroll") for (int k = 0; k < 2; ++k) \
        acc[ai][bj][m][n] = __builtin_amdgcn_mfma_f32_16x16x32_bf16(Bt[n][k], At[m][k], acc[ai][bj][m][n], 0, 0, 0); __builtin_amdgcn_s_setprio(0); } while (0)
#define PG8_WAIT_V(n) asm volatile("s_waitcnt vmcnt(" #n ")" ::: "memory")
#define PG8_WAIT_L(n) asm volatile("s_waitcnt lgkmcnt(" #n ")" ::: "memory")
#define PG8_BAR __builtin_amdgcn_s_barrier()
#define PG8_SCHED __builtin_amdgcn_sched_barrier(0)
    Unit cur, nxt; int ui = 0;
    if (!S.next(0, cur)) return;
    f32x4 acc[2][2][4][2];
#pragma unroll
    for (int a = 0; a < 2; ++a)
#pragma unroll
        for (int b = 0; b < 2; ++b)
#pragma unroll
            for (int m = 0; m < 4; ++m)
#pragma unroll
                for (int n = 0; n < 2; ++n) acc[a][b][m][n] = (f32x4){0.f, 0.f, 0.f, 0.f};
    bf16x8 At[4][2], B0[2][2], B1[2][2];
    const char* cA = (const char*)g.A + (size_t)cur.pm * tstep; const char* cB = (const char*)g.Bt + (size_t)cur.pn * tstep;
    S.a_ready(cur);
    if constexpr (SP2) {
        PG8_STAGE(PG8_SB(0, 0), cB, voffB); PG8_STAGE(PG8_SB(0, 1), cB + hstep, voffB); PG8_STAGE(PG8_SA(0, 0), cA, voffA); PG8_STAGE(PG8_SA(0, 1), cA + hstep, voffA);
        if (wr == 1) PG8_BAR;
        PG8_WAIT_V(2); PG8_BAR;
        PG8_STAGE(PG8_SB(1, 0), cB + kstep, voffB); PG8_STAGE(PG8_SA(1, 0), cA + kstep, voffA); PG8_STAGE(PG8_SB(1, 1), cB + hstep + kstep, voffB);
        PG8_WAIT_V(6); PG8_BAR;
    } else {
        PG8_STAGE(PG8_SB(0, 0), cB, voffB); PG8_STAGE(PG8_SA(0, 0), cA, voffA); PG8_STAGE(PG8_SB(0, 1), cB + hstep, voffB); PG8_STAGE(PG8_SA(0, 1), cA + hstep, voffA);
        if (wr == 1) PG8_BAR;
        PG8_WAIT_V(4); PG8_BAR;
        PG8_STAGE(PG8_SB(1, 0), cB + kstep, voffB); PG8_STAGE(PG8_SA(1, 0), cA + kstep, voffA); PG8_STAGE(PG8_SB(1, 1), cB + hstep + kstep, voffB);
        PG8_WAIT_V(6); PG8_BAR;
    }
    for (;;) {
        const bool has_next = S.next(ui + 1, nxt);
        const char* nA = has_next ? (const char*)g.A + (size_t)nxt.pm * tstep : cA; const char* nB = has_next ? (const char*)g.Bt + (size_t)nxt.pn * tstep : cB;
        for (int t = 0; t < nt; t += 2) {
            const bool last = (t == nt - 2);
            const char* a1 = cA + (size_t)(t + 1) * kstep;
            const char* a2 = last ? nA : cA + (size_t)(t + 2) * kstep; const char* b2 = last ? nB : cB + (size_t)(t + 2) * kstep;
            const char* a3 = a2 + kstep; const char* b3 = b2 + kstep;
            if (last && has_next) S.a_ready(nxt);
            if constexpr (SP2) {
            PG8_LDB(B0, 0, 0); PG8_LDB(B1, 0, 1); PG8_SCHED; PG8_LDA(At, 0, 0); PG8_STAGE(PG8_SA(1, 1), a1 + hstep, voffA);
            PG8_WAIT_V(8); PG8_WAIT_L(0); PG8_BAR; PG8_MMA(0, 0, At, B0); PG8_MMA(0, 1, At, B1); PG8_BAR; PG8_SCHED;
            PG8_LDA(At, 0, 1); PG8_STAGE(PG8_SB(0, 0), b2, voffB); PG8_STAGE(PG8_SB(0, 1), b2 + hstep, voffB); PG8_STAGE(PG8_SA(0, 0), a2, voffA);
            PG8_WAIT_V(8); PG8_WAIT_L(0); PG8_BAR; PG8_MMA(1, 0, At, B0); PG8_MMA(1, 1, At, B1); PG8_BAR; PG8_SCHED;
            PG8_LDB(B0, 1, 0); PG8_LDB(B1, 1, 1); PG8_SCHED; PG8_LDA(At, 1, 0); PG8_STAGE(PG8_SA(0, 1), a2 + hstep, voffA);
            PG8_WAIT_V(8); PG8_WAIT_L(0); PG8_BAR; PG8_MMA(0, 0, At, B0); PG8_MMA(0, 1, At, B1); PG8_BAR; PG8_SCHED;
            PG8_LDA(At, 1, 1); PG8_STAGE(PG8_SB(1, 0), b3, voffB); PG8_STAGE(PG8_SB(1, 1), b3 + hstep, voffB); PG8_STAGE(PG8_SA(1, 0), a3, voffA);
            PG8_WAIT_V(8); PG8_WAIT_L(0); PG8_BAR; PG8_MMA(1, 0, At, B0); PG8_MMA(1, 1, At, B1); PG8_BAR; PG8_SCHED;
            } else {
            PG8_LDB(B0, 0, 0); PG8_SCHED; PG8_LDA(At, 0, 0); PG8_STAGE(PG8_SA(1, 1), a1 + hstep, voffA);
            PG8_WAIT_L(8); PG8_BAR; PG8_WAIT_L(0); PG8_MMA(0, 0, At, B0); PG8_BAR; PG8_SCHED;
            PG8_LDB(B1, 0, 1); PG8_STAGE(PG8_SB(0, 0), b2, voffB);
            PG8_BAR; PG8_WAIT_L(0); PG8_MMA(0, 1, At, B1); PG8_BAR;
            PG8_LDA(At, 0, 1); PG8_STAGE(PG8_SA(0, 0), a2, voffA);
            PG8_BAR; PG8_WAIT_L(0); PG8_MMA(1, 0, At, B0); PG8_BAR; PG8_SCHED;
            PG8_STAGE(PG8_SB(0, 1), b2 + hstep, voffB);
            PG8_WAIT_V(6); PG8_BAR; PG8_MMA(1, 1, At, B1); PG8_BAR;
            PG8_LDB(B0, 1, 0); PG8_SCHED; PG8_LDA(At, 1, 0); PG8_STAGE(PG8_SA(0, 1), a2 + hstep, voffA);
            PG8_WAIT_L(8); PG8_BAR; PG8_WAIT_L(0); PG8_MMA(0, 0, At, B0); PG8_BAR; PG8_SCHED;
            PG8_LDB(B1, 1, 1); PG8_STAGE(PG8_SB(1, 0), b3, voffB);
            PG8_BAR; PG8_WAIT_L(0); PG8_MMA(0, 1, At, B1); PG8_BAR;
            PG8_LDA(At, 1, 1); PG8_STAGE(PG8_SA(1, 0), a3, voffA);
            PG8_BAR; PG8_WAIT_L(0); PG8_MMA(1, 0, At, B0); PG8_BAR; PG8_SCHED;
            PG8_STAGE(PG8_SB(1, 1), b3 + hstep, voffB);
            PG8_WAIT_V(6); PG8_BAR; PG8_MMA(1, 1, At, B1); PG8_BAR;
            }
        }
        if constexpr (ALIGN_EPI) { if (wr == 0) PG8_BAR; }
        if constexpr (!Epi::AFTER_DRAIN) { E(acc, cur, wr, wc, fr, fq); S.done(cur); }
        if (!has_next) break;
#pragma unroll
        for (int a = 0; a < 2; ++a)
#pragma unroll
            for (int b = 0; b < 2; ++b)
#pragma unroll
                for (int m = 0; m < 4; ++m)
#pragma unroll
                    for (int n = 0; n < 2; ++n) acc[a][b][m][n] = (f32x4){0.f, 0.f, 0.f, 0.f};
        cur = nxt; cA = nA; cB = nB; ++ui;
        if constexpr (ALIGN_EPI) { if (wr == 1) PG8_BAR; }
    }
    PG8_WAIT_V(0);
    if constexpr (!ALIGN_EPI) { if (wr == 0) PG8_BAR; }
    PG8_BAR;
    if constexpr (Epi::AFTER_DRAIN) { E.fused(acc, cur, wr, wc, fr, fq, lds, wid, lane); S.done(cur); }
#undef PG8_SA
#undef PG8_SB
#undef PG8_STAGE
#undef PG8_LDA
#undef PG8_LDB
#undef PG8_MMA
#undef PG8_WAIT_V
#undef PG8_WAIT_L
#undef PG8_BAR
#undef PG8_SCHED
}
}
#define GAS __attribute__((address_space(1)))
#define LAS __attribute__((address_space(3)))
typedef unsigned short bf16;
typedef unsigned v4u __attribute__((ext_vector_type(4)));
typedef float f32x4 __attribute__((ext_vector_type(4)));
typedef short bf16x8 __attribute__((ext_vector_type(8)));
typedef GAS unsigned gu32;
typedef GAS unsigned long long gu64;
#define RLX_AGENT __ATOMIC_RELAXED, __HIP_MEMORY_SCOPE_AGENT
#define LDS_WAIT() asm volatile("s_waitcnt lgkmcnt(0)" ::: "memory")
#define VM_WAIT() asm volatile("s_waitcnt vmcnt(0)" ::: "memory")
__device__ __forceinline__ unsigned long long rt() { return __builtin_amdgcn_s_memrealtime(); }
__device__ __forceinline__ unsigned f2bf(float f) { unsigned u = __builtin_bit_cast(unsigned, f); return (u + 0x7fffu + ((u >> 16) & 1u)) >> 16; }
__device__ __forceinline__ unsigned pk2(float lo, float hi) { return f2bf(lo) | (f2bf(hi) << 16); }

#define XB_TMO      128
#define XB_XCNT(j)  (256  + 64 * (j))
#define XB_XSUB(j)  (1280 + 64 * (j))
#define XB_XGEN(j)  (2304 + 64 * (j))
#define XB_TOP      3328
#define XB_TOPGEN   3392
#define XCD_BAR_WORDS 3456
#define XB_SPIN_CAP (1u << 18)

__device__ __forceinline__ unsigned xb_ld(unsigned* p)              { return __hip_atomic_load(p, __ATOMIC_RELAXED, __HIP_MEMORY_SCOPE_AGENT); }
__device__ __forceinline__ unsigned xb_add(unsigned* p, unsigned v) { return __hip_atomic_fetch_add(p, v, __ATOMIC_RELAXED, __HIP_MEMORY_SCOPE_AGENT); }
__device__ __forceinline__ unsigned xb_xcc_id() { return (unsigned)__builtin_amdgcn_s_getreg((3 << 11) | 20) & 0xFu; }
#define XB_SPIN(cond, bar) do { unsigned _sp = 0; while (cond) { __builtin_amdgcn_s_sleep(1); \
    if ((++_sp & 255u) == 0u) { if (xb_ld(&(bar)[XB_TMO])) break; if (_sp > XB_SPIN_CAP) { atomicAdd(&(bar)[XB_TMO], 1u); break; } } } } while (0)

struct XcdBarrier {
    unsigned* bar; unsigned x;
    volatile LAS unsigned* st;
};

__device__ __forceinline__ XcdBarrier xcd_barrier_post(unsigned* bar, volatile LAS unsigned* st) {
    XcdBarrier b; b.bar = bar; b.x = xb_xcc_id(); b.st = st;
    if (threadIdx.x == 0) (void)xb_add(&bar[XB_XCNT(b.x)], 1u);
    return b;
}
__device__ __forceinline__ void xcd_barrier_complete(unsigned* bar, unsigned x, unsigned& nloc, unsigned& nx) {
    const unsigned G = gridDim.x * gridDim.y * gridDim.z;
    unsigned sum, cnt, mine, sp = 0u;
    for (;;) {
        sum = 0u; cnt = 0u; mine = 0u;
#pragma unroll
        for (unsigned j = 0; j < 16; ++j) { const unsigned c = xb_ld(&bar[XB_XCNT(j)]); sum += c; cnt += (c > 0u) ? 1u : 0u; mine = (j == x) ? c : mine; }
        if (sum == G) break;
        __builtin_amdgcn_s_sleep(1);
        if ((++sp & 255u) == 0u) { if (xb_ld(&bar[XB_TMO])) break; if (sp > XB_SPIN_CAP) { atomicAdd(&bar[XB_TMO], 1u); break; } }
    }
    nloc = mine > 0u ? mine : 1u; nx = cnt > 0u ? cnt : 1u;
}

__device__ __forceinline__ void xcd_barrier(const XcdBarrier& b) {
    asm volatile("s_waitcnt vmcnt(0)" ::: "memory");
    __syncthreads();
    if (threadIdx.x == 0) {
        unsigned* bar = b.bar;
        __builtin_amdgcn_s_waitcnt(0);
        unsigned nloc = b.st[0], nx = b.st[1];
        if (nloc == 0u) { xcd_barrier_complete(bar, b.x, nloc, nx); b.st[0] = nloc; b.st[1] = nx; }
        const unsigned old = xb_add(&bar[XB_XSUB(b.x)], 1u);
        const unsigned gen = old / nloc;
        if (old + 1u == (gen + 1u) * nloc) {
            __builtin_amdgcn_fence(__ATOMIC_RELEASE, "agent");
            asm volatile("s_waitcnt vmcnt(0)" ::: "memory");
            const unsigned og = xb_add(&bar[XB_TOP], 1u);
            const unsigned tg = og / nx;
            if (og + 1u == (tg + 1u) * nx) xb_add(&bar[XB_TOPGEN], 1u);
            else XB_SPIN(xb_ld(&bar[XB_TOPGEN]) == tg, bar);
            __builtin_amdgcn_fence(__ATOMIC_ACQUIRE, "agent");
            xb_add(&bar[XB_XGEN(b.x)], 1u);
            asm volatile("s_waitcnt vmcnt(0)" ::: "memory");
        } else {
            XB_SPIN(xb_ld(&bar[XB_XGEN(b.x)]) == gen, bar);
            __builtin_amdgcn_fence(__ATOMIC_ACQUIRE, "agent");
            asm volatile("s_waitcnt vmcnt(0)" ::: "memory");
        }
    }
    __syncthreads();
}

constexpr int DM = 2048, NBATCH = 2, SEQ = 4096, DEPTH = 4, CTXL = 256;
constexpr int NH = 4, HK = 256, HV = 512, RANK = 16;
constexpr int DPOOL = 1024, DFF = 5632, NMODV = 6 * DM;
constexpr int MLAT = NBATCH * SEQ, MCTX = NBATCH * CTXL, MTOT = MLAT + MCTX;
constexpr int NPROJ = 11520, NPROJ_SRC = 11296, NFFI = 2 * DFF;
constexpr int CQ = 0, CK = 1024, CV = 2048, CG = 4096, CP = 6144, CBG = 7168, CBP = 9216, CA = 11264;
constexpr float ALPHA = 1.6817928305074290f;
constexpr float LN_EPS = 1e-5f, RMS_EPS = 1e-6f;
constexpr int NWAVES = 8, NTHREADS = 512;
constexpr int LDS_BYTES = 147456;
constexpr int RING_BYTES = 131072, MISC_OFF = RING_BYTES + 320;

constexpr size_t al256(size_t x) { return (x + 255) & ~(size_t)255; }
constexpr size_t WS_CTL = 0, CTL_BYTES = 1u << 20;
constexpr size_t SZ_MODP = (size_t)DEPTH * 8 * 3 * NMODV * 4, SZ_MOD = (size_t)DEPTH * 3 * NMODV * 4;
constexpr size_t WS_MODP = WS_CTL + CTL_BYTES, WS_MOD = al256(WS_MODP + SZ_MODP), WS_W = al256(WS_MOD + SZ_MOD);
constexpr size_t WO_IN = 0, SZ_IN = (size_t)NPROJ * DM * 2;
constexpr size_t WO_GO = WO_IN + SZ_IN, SZ_GO = (size_t)DM * DM * 2;
constexpr size_t WO_PG = WO_GO + SZ_GO, SZ_PG = (size_t)1024 * 1024 * 2;
constexpr size_t WO_PO = WO_PG + SZ_PG, SZ_PO = (size_t)DM * 1024 * 2;
constexpr size_t WO_OUT = WO_PO + SZ_PO, SZ_OUT = (size_t)DM * DM * 2;
constexpr size_t WO_FI = WO_OUT + SZ_OUT, SZ_FI = (size_t)NFFI * DM * 2;
constexpr size_t WO_FO = WO_FI + SZ_FI, SZ_FO = (size_t)DM * DFF * 2;
constexpr size_t W_LAYER = WO_FO + SZ_FO;
constexpr size_t WS_X = al256(WS_W + DEPTH * W_LAYER), SZ_X = (size_t)MTOT * DM * 4;
constexpr size_t WS_V = WS_X + SZ_X;
constexpr size_t WS_H = WS_V + SZ_X, SZ_H = (size_t)MTOT * DM * 2;
constexpr size_t WS_PROJ = WS_H + SZ_H, SZ_PROJ = (size_t)MTOT * NPROJ * 2;
constexpr size_t WS_ACT = WS_PROJ;
constexpr size_t WS_LA = WS_PROJ + SZ_PROJ, SZ_LA = (size_t)2 * MTOT * 1024 * 4;
constexpr size_t WS_O = WS_LA + SZ_LA, SZ_O = (size_t)MTOT * DM * 4;
constexpr size_t WS_AGLA = WS_O + 2 * SZ_O;
constexpr size_t WS_HM = WS_AGLA + SZ_H, SZ_HM = (size_t)MTOT * 1024 * 4;
constexpr size_t WS_T = WS_HM + SZ_HM, SZ_T = (size_t)MTOT * 1024 * 2;
constexpr size_t WS_U = WS_T + SZ_T;
constexpr size_t WS_TEMP = WS_U + SZ_T;
constexpr size_t WS_MRG = WS_TEMP + SZ_X;
constexpr size_t WS_END = WS_MRG + SZ_H;

struct Params {
    const float *x, *c, *ctx, *c_ctx, *w_ada, *b_ada, *w_in, *w_dup, *b_dup, *gla_gain, *w_pg, *pool_scale, *w_go, *w_po, *w_out, *ln1g, *ln1b, *w_fi, *w_fo, *ln2g, *ln2b;
    float* out; unsigned char* ws; int layer; int pad;
};
typedef float f32x2g __attribute__((ext_vector_type(2)));
typedef unsigned u32x2g __attribute__((ext_vector_type(2)));
struct Frame { LAS unsigned char* lds; int tid, lane, wave, vcu, G, gw, NGW; };

__device__ __forceinline__ bf16* wlayer(const Params& p, int l, size_t off) { return (bf16*)(p.ws + WS_W + (size_t)l * W_LAYER + off); }
__device__ __forceinline__ const float* modv(const Params& p, int l, int mi, int which) { return (const float*)(p.ws + WS_MOD) + ((size_t)l * 3 + mi) * NMODV + (size_t)which * DM; }
__device__ __forceinline__ float bf2f(unsigned short b) { return __builtin_bit_cast(float, (unsigned)b << 16); }
__device__ __forceinline__ float bflo(unsigned w) { return __builtin_bit_cast(float, w << 16); }
__device__ __forceinline__ float bfhi(unsigned w) { return __builtin_bit_cast(float, w & 0xffff0000u); }
__device__ __forceinline__ float fast_sigmoid(float x) { return __builtin_amdgcn_rcpf(1.0f + __expf(-x)); }
__device__ __forceinline__ float wave_sum(float v) {
#pragma unroll
    for (int o = 1; o < 64; o <<= 1) v += __shfl_xor(v, o);
    return v;
}
__device__ __forceinline__ int mod_index(int row) { return row < SEQ ? 0 : (row < MLAT ? 1 : 2); }

struct EpiProj {
    static constexpr bool PERM = true, AFTER_DRAIN = false;
    bf16* O;
    __device__ __forceinline__ void operator()(const pg8::f32x4 (&acc)[2][2][4][2], const pg8::Unit& u, int wr, int wc, int fr, int fq) const {
        const int row0 = u.pm * 256 + wr * 64 + fr, col0 = u.pn * 256 + wc * 32 + 8 * fq;
        const int mode = (u.pn >= 16 && u.pn < 24) ? 1 : ((u.pn >= 28 && u.pn < 44) ? 2 : 0);
#pragma unroll
        for (int ai = 0; ai < 2; ++ai)
#pragma unroll
            for (int m = 0; m < 4; ++m) { bf16* rowp = O + (size_t)(row0 + ai * 128 + m * 16) * NPROJ + col0;
#pragma unroll
                for (int bj = 0; bj < 2; ++bj) { pg8::f32x4 v0 = acc[ai][bj][m][0], v1 = acc[ai][bj][m][1];
                    if (mode != 0) {
#pragma unroll
                        for (int j = 0; j < 4; ++j) { const float s0 = fast_sigmoid(v0[j]), s1 = fast_sigmoid(v1[j]); v0[j] = (mode == 1) ? v0[j] * s0 : s0; v1[j] = (mode == 1) ? v1[j] * s1 : s1; } }
                    pg8::u32x4 w; w.x = pg8::cvt_pk_bf16(v0[0], v0[1]); w.y = pg8::cvt_pk_bf16(v0[2], v0[3]); w.z = pg8::cvt_pk_bf16(v1[0], v1[1]); w.w = pg8::cvt_pk_bf16(v1[2], v1[3]);
                    *(pg8::u32x4*)(rowp + bj * 128) = w; } }
    }
};
struct EpiBf16Plain {
    static constexpr bool PERM = true, AFTER_DRAIN = false;
    bf16* O; int ldc;
    __device__ __forceinline__ void operator()(const pg8::f32x4 (&acc)[2][2][4][2], const pg8::Unit& u, int wr, int wc, int fr, int fq) const {
        const int row0 = u.pm * 256 + wr * 64 + fr, col0 = u.pn * 256 + wc * 32 + 8 * fq;
#pragma unroll
        for (int ai = 0; ai < 2; ++ai)
#pragma unroll
            for (int m = 0; m < 4; ++m) { bf16* rowp = O + (size_t)(row0 + ai * 128 + m * 16) * ldc + col0;
#pragma unroll
                for (int bj = 0; bj < 2; ++bj) { const pg8::f32x4 v0 = acc[ai][bj][m][0], v1 = acc[ai][bj][m][1];
                    pg8::u32x4 w; w.x = pg8::cvt_pk_bf16(v0[0], v0[1]); w.y = pg8::cvt_pk_bf16(v0[2], v0[3]); w.z = pg8::cvt_pk_bf16(v1[0], v1[1]); w.w = pg8::cvt_pk_bf16(v1[2], v1[3]);
                    *(pg8::u32x4*)(rowp + bj * 128) = w; } }
    }
};
struct EpiGateTemp {
    static constexpr bool PERM = true, AFTER_DRAIN = false;
    float* T; const bf16* PROJ;
    __device__ __forceinline__ void operator()(const pg8::f32x4 (&acc)[2][2][4][2], const pg8::Unit& u, int wr, int wc, int fr, int fq) const {
        const int row0 = u.pm * 256 + wr * 64 + fr, col0 = u.pn * 256 + wc * 32 + 8 * fq;
#pragma unroll
        for (int ai = 0; ai < 2; ++ai)
#pragma unroll
            for (int m = 0; m < 4; ++m) { const int row = row0 + ai * 128 + m * 16;
#pragma unroll
                for (int bj = 0; bj < 2; ++bj) { const int c = col0 + bj * 128;
                    const pg8::u32x4 gw = *(const pg8::u32x4*)(PROJ + (size_t)row * NPROJ + CBP + c);
                    pg8::f32x4 v0 = acc[ai][bj][m][0], v1 = acc[ai][bj][m][1];
                    v0[0] *= bflo(gw.x); v0[1] *= bfhi(gw.x); v0[2] *= bflo(gw.y); v0[3] *= bfhi(gw.y);
                    v1[0] *= bflo(gw.z); v1[1] *= bfhi(gw.z); v1[2] *= bflo(gw.w); v1[3] *= bfhi(gw.w);
                    float* tp = T + (size_t)row * DM + c; *(pg8::f32x4*)tp = v0; *(pg8::f32x4*)(tp + 4) = v1; } }
    }
};
struct EpiMerge {
    static constexpr bool PERM = true, AFTER_DRAIN = false;
    bf16* O; const float* T; const bf16* PROJ;
    __device__ __forceinline__ void operator()(const pg8::f32x4 (&acc)[2][2][4][2], const pg8::Unit& u, int wr, int wc, int fr, int fq) const {
        const int row0 = u.pm * 256 + wr * 64 + fr, col0 = u.pn * 256 + wc * 32 + 8 * fq;
#pragma unroll
        for (int ai = 0; ai < 2; ++ai)
#pragma unroll
            for (int m = 0; m < 4; ++m) { const int row = row0 + ai * 128 + m * 16;
#pragma unroll
                for (int bj = 0; bj < 2; ++bj) { const int c = col0 + bj * 128;
                    const pg8::u32x4 gw = *(const pg8::u32x4*)(PROJ + (size_t)row * NPROJ + CBG + c);
                    const float* tp = T + (size_t)row * DM + c; const pg8::f32x4 t0 = *(const pg8::f32x4*)tp, t1 = *(const pg8::f32x4*)(tp + 4);
                    pg8::f32x4 v0 = acc[ai][bj][m][0], v1 = acc[ai][bj][m][1];
                    v0[0] = v0[0] * bflo(gw.x) + t0[0]; v0[1] = v0[1] * bfhi(gw.x) + t0[1]; v0[2] = v0[2] * bflo(gw.y) + t0[2]; v0[3] = v0[3] * bfhi(gw.y) + t0[3];
                    v1[0] = v1[0] * bflo(gw.z) + t1[0]; v1[1] = v1[1] * bfhi(gw.z) + t1[1]; v1[2] = v1[2] * bflo(gw.w) + t1[2]; v1[3] = v1[3] * bfhi(gw.w) + t1[3];
                    pg8::u32x4 w; w.x = pg8::cvt_pk_bf16(v0[0], v0[1]); w.y = pg8::cvt_pk_bf16(v0[2], v0[3]); w.z = pg8::cvt_pk_bf16(v1[0], v1[1]); w.w = pg8::cvt_pk_bf16(v1[2], v1[3]);
                    *(pg8::u32x4*)(O + (size_t)row * DM + c) = w; } }
    }
};
struct EpiResid {
    static constexpr bool PERM = false, AFTER_DRAIN = false;
    float* V; const float* xlat; const float* xctx; const float* gt0;
    __device__ __forceinline__ void operator()(const pg8::f32x4 (&acc)[2][2][4][2], const pg8::Unit& u, int wr, int wc, int fr, int fq) const {
        const int row0 = u.pm * 256 + wr * 64 + fr, col0 = u.pn * 256 + wc * 32 + 4 * fq;
        const int mi = u.pm < 16 ? 0 : (u.pm < 32 ? 1 : 2);
        const float* gt = gt0 + (size_t)mi * NMODV + col0;
        pg8::f32x4 gv[2][2];
#pragma unroll
        for (int bj = 0; bj < 2; ++bj)
#pragma unroll
            for (int n = 0; n < 2; ++n) gv[bj][n] = *(const pg8::f32x4*)(gt + bj * 128 + n * 16);
#pragma unroll
        for (int ai = 0; ai < 2; ++ai)
#pragma unroll
            for (int m = 0; m < 4; ++m) { const int row = row0 + ai * 128 + m * 16;
                const float* xr = (u.pm < 32 ? xlat + (size_t)row * DM : xctx + (size_t)(row - MLAT) * DM) + col0; float* vr = V + (size_t)row * DM + col0;
#pragma unroll
                for (int bj = 0; bj < 2; ++bj)
#pragma unroll
                    for (int n = 0; n < 2; ++n) { const pg8::f32x4 xv = *(const pg8::f32x4*)(xr + bj * 128 + n * 16);
                        *(pg8::f32x4*)(vr + bj * 128 + n * 16) = xv * ALPHA + gv[bj][n] * acc[ai][bj][m][n]; } }
    }
};
struct EpiSwiglu {
    static constexpr bool PERM = true, AFTER_DRAIN = false;
    bf16* O;
    __device__ __forceinline__ void operator()(const pg8::f32x4 (&acc)[2][2][4][2], const pg8::Unit& u, int wr, int wc, int fr, int fq) const {
        const int row0 = u.pm * 256 + wr * 64 + fr, col0 = u.pn * 128 + wc * 32 + 8 * fq;
#pragma unroll
        for (int ai = 0; ai < 2; ++ai)
#pragma unroll
            for (int m = 0; m < 4; ++m) { const int row = row0 + ai * 128 + m * 16;
                pg8::f32x4 a0, a1;
#pragma unroll
                for (int j = 0; j < 4; ++j) { const float g0 = acc[ai][0][m][0][j], g1 = acc[ai][0][m][1][j];
                    a0[j] = g0 * fast_sigmoid(g0) * acc[ai][1][m][0][j]; a1[j] = g1 * fast_sigmoid(g1) * acc[ai][1][m][1][j]; }
                pg8::u32x4 w; w.x = pg8::cvt_pk_bf16(a0[0], a0[1]); w.y = pg8::cvt_pk_bf16(a0[2], a0[3]); w.z = pg8::cvt_pk_bf16(a1[0], a1[1]); w.w = pg8::cvt_pk_bf16(a1[2], a1[3]);
                *(pg8::u32x4*)(O + (size_t)row * DFF + col0) = w; }
    }
};

__device__ __forceinline__ void transpose_item(const float* W, int N, int k0, int n0, bf16* WT, int ldk, int drow0, float colscale, const float* rowscale, LAS float* scr, int lane) {
#pragma unroll 8
    for (int i = 0; i < 32; ++i) { const int kk = 2 * i + (lane >> 5); float v = W[(size_t)(k0 + kk) * N + n0 + (lane & 31)]; if (rowscale) v *= rowscale[k0 + kk]; scr[kk * 33 + (lane & 31)] = v * colscale; }
    LDS_WAIT(); asm volatile("" ::: "memory");
    const int c = lane & 7;
#pragma unroll
    for (int j = 0; j < 4; ++j) { const int n = (lane >> 3) + 8 * j; const LAS float* s = scr + (8 * c) * 33 + n;
        v4u o; o.x = pk2(s[0 * 33], s[1 * 33]); o.y = pk2(s[2 * 33], s[3 * 33]); o.z = pk2(s[4 * 33], s[5 * 33]); o.w = pk2(s[6 * 33], s[7 * 33]);
        *(GAS v4u*)(WT + (size_t)(drow0 + n) * ldk + k0 + 8 * c) = o; }
    LDS_WAIT(); asm volatile("" ::: "memory");
}
constexpr int IT_IN = 32 * (NPROJ_SRC / 32), IT_GO = 32 * 64, IT_PO = 16 * 64, IT_OUT = 32 * 64, IT_FI = 32 * (NFFI / 32), IT_FO = (DFF / 64) * 64, IT_PG = 128, IT_ZIN = 224, IT_ZPG = 1024;
constexpr int IT_LAYER = IT_IN + IT_GO + IT_PO + IT_OUT + IT_FI + IT_FO + IT_PG + IT_ZIN + IT_ZPG;
constexpr int IT_MOD = DEPTH * 48 * 8;
__device__ __forceinline__ void phase_prologue_a(const Frame& F, const Params& p) {
    LAS float* scr = (LAS float*)(F.lds + F.wave * 16384);
    for (int it = F.gw; it < IT_MOD; it += F.NGW) {
        const int l = it / 384, r = it % 384, nb = r / 8, kb = r % 8, k0 = 256 * kb, n0 = 256 * nb + 4 * F.lane;
#pragma unroll
        for (int j = 0; j < 4; ++j) { const int k = k0 + F.lane + 64 * j;
            const float c0 = p.c[k], c1 = p.c[DM + k], c2 = p.c_ctx[k];
            scr[(F.lane + 64 * j) * 3 + 0] = c0 / (1.0f + expf(-c0)); scr[(F.lane + 64 * j) * 3 + 1] = c1 / (1.0f + expf(-c1)); scr[(F.lane + 64 * j) * 3 + 2] = c2 / (1.0f + expf(-c2)); }
        LDS_WAIT(); asm volatile("" ::: "memory");
        f32x4 a0 = {0.f, 0.f, 0.f, 0.f}, a1 = a0, a2 = a0;
        const float* wp = p.w_ada + ((size_t)l * DM + k0) * NMODV + n0;
#pragma unroll 8
        for (int kk = 0; kk < 256; ++kk) { const f32x4 w = *(const GAS f32x4*)(wp + (size_t)kk * NMODV); const float s0 = scr[kk * 3], s1 = scr[kk * 3 + 1], s2 = scr[kk * 3 + 2];
            a0 += w * s0; a1 += w * s1; a2 += w * s2; }
        float* mp = (float*)(p.ws + WS_MODP) + ((size_t)(l * 8 + kb) * 3) * NMODV + n0;
        *(GAS f32x4*)(mp) = a0; *(GAS f32x4*)(mp + NMODV) = a1; *(GAS f32x4*)(mp + 2 * NMODV) = a2;
        LDS_WAIT(); asm volatile("" ::: "memory");
    }
    for (int it = F.gw; it < DEPTH * IT_LAYER; it += F.NGW) {
        const int l = it / IT_LAYER; int r = it % IT_LAYER;
        if (r < IT_IN) { const int nblk = NPROJ_SRC / 32, kb = r / nblk, n0 = 32 * (r % nblk);
            int drow; float cs = 1.0f;
            if (n0 < 6144) { drow = n0; if (n0 < 1024) cs = 0.0625f; } else if (n0 < 6176) drow = CA + (n0 - 6144); else if (n0 < 7200) drow = CP + (n0 - 6176); else drow = CBG + (n0 - 7200);
            transpose_item(p.w_in + (size_t)l * DM * NPROJ_SRC, NPROJ_SRC, 64 * kb, n0, wlayer(p, l, WO_IN), DM, drow, cs, nullptr, scr, F.lane); continue; } r -= IT_IN;
        if (r < IT_GO) { transpose_item(p.w_go + (size_t)l * DM * DM, DM, 64 * (r / 64), 32 * (r % 64), wlayer(p, l, WO_GO), DM, 32 * (r % 64), 1.0f, nullptr, scr, F.lane); continue; } r -= IT_GO;
        if (r < IT_PO) { transpose_item(p.w_po + (size_t)l * DPOOL * DM, DM, 64 * (r / 64), 32 * (r % 64), wlayer(p, l, WO_PO), DPOOL, 32 * (r % 64), 1.0f, p.pool_scale + (size_t)l * DPOOL, scr, F.lane); continue; } r -= IT_PO;
        if (r < IT_OUT) { transpose_item(p.w_out + (size_t)l * DM * DM, DM, 64 * (r / 64), 32 * (r % 64), wlayer(p, l, WO_OUT), DM, 32 * (r % 64), 1.0f, nullptr, scr, F.lane); continue; } r -= IT_OUT;
        if (r < IT_FI) { const int nblk = NFFI / 32, kb = r / nblk, n0 = 32 * (r % nblk), up = n0 >= DFF ? 1 : 0, ch = n0 - up * DFF;
            transpose_item(p.w_fi + (size_t)l * DM * NFFI, NFFI, 64 * kb, n0, wlayer(p, l, WO_FI), DM, 256 * (ch / 128) + 128 * up + (ch % 128), 1.0f, nullptr, scr, F.lane); continue; } r -= IT_FI;
        if (r < IT_FO) { transpose_item(p.w_fo + (size_t)l * DFF * DM, DM, 64 * (r / 64), 32 * (r % 64), wlayer(p, l, WO_FO), DFF, 32 * (r % 64), 1.0f, nullptr, scr, F.lane); continue; } r -= IT_FO;
        if (r < IT_PG) { const int g = r / 32, q = r % 32;
            transpose_item(p.w_pg + ((size_t)l * 4 + g) * 256 * 256, 256, 64 * (q / 8), 32 * (q % 8), wlayer(p, l, WO_PG) + 256 * g, 1024, 256 * g + 32 * (q % 8), 1.0f, nullptr, scr, F.lane); continue; } r -= IT_PG;
        if (r < IT_ZIN) { GAS v4u* zp = (GAS v4u*)(wlayer(p, l, WO_IN) + (size_t)(NPROJ_SRC + r) * DM);
#pragma unroll
            for (int j = 0; j < 4; ++j) zp[F.lane + 64 * j] = (v4u){0u, 0u, 0u, 0u};
            continue; } r -= IT_ZIN;
        { GAS v4u* zp = (GAS v4u*)(wlayer(p, l, WO_PG) + (size_t)r * 1024); const int g = r >> 8;
#pragma unroll
          for (int j = 0; j < 2; ++j) { const int ch = F.lane + 64 * j; if ((ch >> 5) != g) zp[ch] = (v4u){0u, 0u, 0u, 0u}; } }
    }
}
__device__ __forceinline__ void phase_prologue_b(const Frame& F, const Params& p) {
    const float* MP = (const float*)(p.ws + WS_MODP); float* MO = (float*)(p.ws + WS_MOD);
    for (int e = F.vcu * NTHREADS + F.tid; e < DEPTH * 3 * NMODV; e += F.G * NTHREADS) { const int l = e / (3 * NMODV), r = e % (3 * NMODV), n = r % NMODV;
        float s = p.b_ada[(size_t)l * NMODV + n];
#pragma unroll
        for (int kb = 0; kb < 8; ++kb) s += MP[((size_t)(l * 8 + kb) * 3) * NMODV + r];
        MO[e] = s; }
    LAS float* sm = (LAS float*)F.lds;
    for (int e = F.tid; e < 3 * 2 * DM; e += NTHREADS) { const int mi = e / (2 * DM), r = e % (2 * DM);
        float s = p.b_ada[r];
#pragma unroll
        for (int kb = 0; kb < 8; ++kb) s += MP[((size_t)kb * 3 + mi) * NMODV + r];
        sm[e] = s; }
    __syncthreads();
    bf16* H = (bf16*)(p.ws + WS_H);
    for (int row = F.gw; row < MTOT; row += F.NGW) { const int mi = mod_index(row);
        const float* xr = row < MLAT ? p.x + (size_t)row * DM : p.ctx + (size_t)(row - MLAT) * DM;
        const LAS float* sh = sm + mi * 2 * DM; const LAS float* sc = sh + DM;
        GAS unsigned long long* o8 = (GAS unsigned long long*)(H + (size_t)row * DM) + F.lane;
#pragma unroll
        for (int j = 0; j < 8; ++j) { const int c = 4 * F.lane + 256 * j; const f32x4 v = *(const GAS f32x4*)(xr + c);
            const float y0 = v.x * (1.0f + sc[c]) + sh[c], y1 = v.y * (1.0f + sc[c + 1]) + sh[c + 1], y2 = v.z * (1.0f + sc[c + 2]) + sh[c + 2], y3 = v.w * (1.0f + sc[c + 3]) + sh[c + 3];
            o8[64 * j] = (unsigned long long)pk2(y0, y1) | ((unsigned long long)pk2(y2, y3) << 32); } }
    __syncthreads();
}
__device__ __forceinline__ void phase_ln(const Frame& F, const Params& p, int l, int sub, int M) {
    const float* V = (const float*)(p.ws + WS_V); float* X = (float*)(p.ws + WS_X); bf16* H = (bf16*)(p.ws + WS_H);
    const float* gain = (sub == 0 ? p.ln1g : p.ln2g) + (size_t)l * DM; const float* bias = (sub == 0 ? p.ln1b : p.ln2b) + (size_t)l * DM;
    const bool last = (sub == 1 && l == DEPTH - 1);
    const int lm = sub == 0 ? l : l + 1, wsh = sub == 0 ? 3 : 0, wsc = sub == 0 ? 4 : 1;
    for (int row = F.gw; row < M; row += F.NGW) {
        const GAS f32x4* vr = (const GAS f32x4*)(V + (size_t)row * DM) + F.lane;
        f32x4 v[8]; float s = 0.f;
#pragma unroll
        for (int j = 0; j < 8; ++j) { v[j] = vr[64 * j]; s += (v[j].x + v[j].y) + (v[j].z + v[j].w); }
        const float mean = wave_sum(s) * (1.f / DM); float s2 = 0.f;
#pragma unroll
        for (int j = 0; j < 8; ++j) { v[j] = v[j] - mean; s2 += (v[j].x * v[j].x + v[j].y * v[j].y) + (v[j].z * v[j].z + v[j].w * v[j].w); }
        const float rstd = 1.f / sqrtf(wave_sum(s2) * (1.f / DM) + LN_EPS);
#pragma unroll
        for (int j = 0; j < 8; ++j) { const int c = 4 * F.lane + 256 * j; const f32x4 g = *(const GAS f32x4*)(gain + c), b = *(const GAS f32x4*)(bias + c); v[j] = v[j] * rstd * g + b; }
        if (last) { GAS f32x4* o = (GAS f32x4*)(p.out + (size_t)row * DM) + F.lane;
#pragma unroll
            for (int j = 0; j < 8; ++j) o[64 * j] = v[j];
        } else {
            GAS f32x4* xo = (GAS f32x4*)(X + (size_t)row * DM) + F.lane;
            const int mi = mod_index(row); const float* sh = modv(p, lm, mi, wsh); const float* sc = modv(p, lm, mi, wsc);
            GAS unsigned long long* o8 = (GAS unsigned long long*)(H + (size_t)row * DM) + F.lane;
#pragma unroll
            for (int j = 0; j < 8; ++j) { const int c = 4 * F.lane + 256 * j; xo[64 * j] = v[j];
                const f32x4 a = *(const GAS f32x4*)(sc + c), b = *(const GAS f32x4*)(sh + c); const f32x4 y = v[j] * (a + 1.0f) + b;
                o8[64 * j] = (unsigned long long)pk2(y.x, y.y) | ((unsigned long long)pk2(y.z, y.w) << 32); } }
    }
}
__device__ __forceinline__ void phase_pool(const Frame& F, const Params& p, int pass) {
    const bf16* PROJ = (const bf16*)(p.ws + WS_PROJ); float* HM = (float*)(p.ws + WS_HM); bf16* T = (bf16*)(p.ws + WS_T);
    for (int task = F.gw; task < MTOT * 8; task += F.NGW) { const int row = task >> 3, cb = task & 7, c = cb * 128 + 2 * F.lane, g = cb >> 1, w = 2 << g, lo = w >> 1, hi = w - lo - 1;
        int idx, n, stride;
        if (row < MLAT) { const int t = row & (SEQ - 1); if (pass == 0) { idx = t & 63; n = 64; stride = 1; } else { idx = t >> 6; n = 64; stride = 64; } }
        else { const int t = (row - MLAT) & (CTXL - 1); idx = t; n = (pass == 0) ? CTXL : 1; stride = 1; if (pass == 1) idx = 0; }
        const int lower = max(idx - lo, 0), upper = min(idx + hi + 1, n);
        float s0 = 0.f, s1 = 0.f;
        if (pass == 0) { for (int q = lower; q < upper; ++q) { const unsigned wv = *(const GAS unsigned*)(PROJ + (size_t)(row + (q - idx) * stride) * NPROJ + CP + c); s0 += bflo(wv); s1 += bfhi(wv); } }
        else { for (int q = lower; q < upper; ++q) { const f32x2g hv = *(const GAS f32x2g*)(HM + (size_t)(row + (q - idx) * stride) * DPOOL + c); s0 += hv.x; s1 += hv.y; } }
        const float inv = 1.0f / (float)(upper - lower); s0 *= inv; s1 *= inv;
        if (pass == 0) { *(GAS f32x2g*)(HM + (size_t)row * DPOOL + c) = (f32x2g){s0, s1}; }
        else { const unsigned wv = *(const GAS unsigned*)(PROJ + (size_t)row * NPROJ + CP + c); *(GAS unsigned*)(T + (size_t)row * DPOOL + c) = pk2(s0 - bflo(wv), s1 - bfhi(wv)); }
    }
}
__device__ __forceinline__ float log_sigmoid_f(float z) { return fminf(z, 0.f) - log1pf(expf(-fabsf(z))); }
__device__ __forceinline__ void phase_la(const Frame& F, const Params& p, int l) {
    const bf16* PROJ = (const bf16*)(p.ws + WS_PROJ); float* LA = (float*)(p.ws + WS_LA);
    for (int task = F.gw; task < MTOT * 2; task += F.NGW) { const int row = task >> 1, dir = task & 1;
        const bf16* ap = PROJ + (size_t)row * NPROJ + CA + dir * 16; float a[16];
#pragma unroll
        for (int r = 0; r < 16; ++r) a[r] = bf2f(ap[r]);
        const float* wu = p.w_dup + ((size_t)l * 2 + dir) * RANK * 1024; const float* bu = p.b_dup + ((size_t)l * 2 + dir) * 1024;
#pragma unroll
        for (int j = 0; j < 4; ++j) { const int d = 4 * F.lane + 256 * j; f32x4 z = *(const GAS f32x4*)(bu + d);
#pragma unroll
            for (int r = 0; r < 16; ++r) z += *(const GAS f32x4*)(wu + (size_t)r * 1024 + d) * a[r];
            f32x4 o; o.x = log_sigmoid_f(z.x) * 0.0625f; o.y = log_sigmoid_f(z.y) * 0.0625f; o.z = log_sigmoid_f(z.z) * 0.0625f; o.w = log_sigmoid_f(z.w) * 0.0625f;
            *(GAS f32x4*)(LA + ((size_t)dir * MTOT + row) * 1024 + d) = o; } }
}
__device__ __forceinline__ void phase_gla_naive(const Frame& F, const Params& p) {
    const bf16* PROJ = (const bf16*)(p.ws + WS_PROJ); const float* LA = (const float*)(p.ws + WS_LA); float* O = (float*)(p.ws + WS_O);
    for (int it = F.gw; it < NBATCH * NH * HV; it += F.NGW) { const int b = it >> 11, h = (it >> 9) & 3, vcol = it & 511;
        for (int dir = 0; dir < 2; ++dir) {
            float S0 = 0.f, S1 = 0.f, S2 = 0.f, S3 = 0.f;
#pragma unroll 4
            for (int step = 0; step < CTXL + SEQ; ++step) {
                int row; if (step < CTXL) { const int t = dir ? CTXL - 1 - step : step; row = MLAT + b * CTXL + t; } else { const int s2 = step - CTXL; const int t = dir ? SEQ - 1 - s2 : s2; row = b * SEQ + t; }
                const bf16* pr = PROJ + (size_t)row * NPROJ;
                const u32x2g qw = *(const GAS u32x2g*)(pr + CQ + h * HK + 4 * F.lane), kw = *(const GAS u32x2g*)(pr + CK + h * HK + 4 * F.lane);
                const f32x4 la = *(const GAS f32x4*)(LA + ((size_t)dir * MTOT + row) * 1024 + h * HK + 4 * F.lane);
                const float vv = bf2f(pr[CV + h * HV + vcol]);
                S0 = expf(la.x) * S0 + bflo(kw.x) * vv; S1 = expf(la.y) * S1 + bfhi(kw.x) * vv; S2 = expf(la.z) * S2 + bflo(kw.y) * vv; S3 = expf(la.w) * S3 + bfhi(kw.y) * vv;
                const float part = wave_sum((bflo(qw.x) * S0 + bfhi(qw.x) * S1) + (bflo(qw.y) * S2 + bfhi(qw.y) * S3));
                if (F.lane == 0) { float* op = O + (size_t)row * DM + h * HV + vcol; *op = dir ? *op + part : part; }
            }
        }
    }
}
template <int NO> __device__ __forceinline__ void phase_gout(const Frame& F, const Params& p, int l, int M) {
    const bf16* PROJ = (const bf16*)(p.ws + WS_PROJ); const float* O = (const float*)(p.ws + WS_O); bf16* A = (bf16*)(p.ws + WS_AGLA);
    const float* gain = p.gla_gain + (size_t)l * DM;
    for (int task = F.gw; task < M * NH; task += F.NGW) { const int row = task >> 2, h = task & 3, c = h * HV + 8 * F.lane;
        f32x4 o0 = *(const GAS f32x4*)(O + (size_t)row * DM + c), o1 = *(const GAS f32x4*)(O + (size_t)row * DM + c + 4);
        if (NO == 2) { o0 += *(const GAS f32x4*)(O + (size_t)(MTOT + row) * DM + c); o1 += *(const GAS f32x4*)(O + (size_t)(MTOT + row) * DM + c + 4); }
        const float ss = wave_sum((o0.x * o0.x + o0.y * o0.y) + (o0.z * o0.z + o0.w * o0.w) + (o1.x * o1.x + o1.y * o1.y) + (o1.z * o1.z + o1.w * o1.w));
        const float r = 1.0f / sqrtf(ss * (1.0f / HV) + RMS_EPS);
        const f32x4 g0 = *(const GAS f32x4*)(gain + c), g1 = *(const GAS f32x4*)(gain + c + 4);
        const v4u gw = *(const GAS v4u*)(PROJ + (size_t)row * NPROJ + CG + c);
        v4u w; w.x = pk2(o0.x * r * g0.x * bflo(gw.x), o0.y * r * g0.y * bfhi(gw.x)); w.y = pk2(o0.z * r * g0.z * bflo(gw.y), o0.w * r * g0.w * bfhi(gw.y));
        w.z = pk2(o1.x * r * g1.x * bflo(gw.z), o1.y * r * g1.y * bfhi(gw.z)); w.w = pk2(o1.z * r * g1.z * bflo(gw.w), o1.w * r * g1.w * bfhi(gw.w));
        *(GAS v4u*)(A + (size_t)row * DM + c) = w; }
}

enum { PH_PRO_A = 0, PH_PRO_B, PH_WIN, PH_LA, PH_GLA, PH_GOUT, PH_POOL0, PH_POOL1, PH_PGRP, PH_PPO, PH_GO, PH_WOUT, PH_LN0, PH_FFI, PH_FFO, PH_LN1, PH_COUNT };

template <int PH> __device__ __forceinline__ void run_phase(const Frame& F, const Params& p, int l) {
    const int M = (l == DEPTH - 1) ? MLAT : MTOT;
    bf16* H = (bf16*)(p.ws + WS_H); bf16* PROJ = (bf16*)(p.ws + WS_PROJ); bf16* ACT = (bf16*)(p.ws + WS_ACT); float* X = (float*)(p.ws + WS_X); float* V = (float*)(p.ws + WS_V);
    bf16* AGLA = (bf16*)(p.ws + WS_AGLA); bf16* T = (bf16*)(p.ws + WS_T); bf16* U = (bf16*)(p.ws + WS_U); float* TEMP = (float*)(p.ws + WS_TEMP); bf16* MRG = (bf16*)(p.ws + WS_MRG);
    pg8::StaticOrder S;
    if constexpr (PH == PH_PRO_A) phase_prologue_a(F, p);
    if constexpr (PH == PH_PRO_B) phase_prologue_b(F, p);
    if constexpr (PH == PH_WIN) { pg8::Gemm g{H, wlayer(p, l, WO_IN), MTOT, NPROJ, DM}; S.init(MTOT, NPROJ, F.G, (int)blockIdx.x); EpiProj E{PROJ};
        pg8::gemm_phase<EpiProj, pg8::StaticOrder, true, true>(F.lds, g, S, E); }
    if constexpr (PH == PH_LA) phase_la(F, p, l);
    if constexpr (PH == PH_GLA) phase_gla_naive(F, p);
    if constexpr (PH == PH_GOUT) phase_gout<1>(F, p, l, M);
    if constexpr (PH == PH_POOL0) phase_pool(F, p, 0);
    if constexpr (PH == PH_POOL1) phase_pool(F, p, 1);
    if constexpr (PH == PH_PGRP) { pg8::Gemm g{T, wlayer(p, l, WO_PG), M, 1024, 1024}; S.init(M, 1024, F.G, (int)blockIdx.x); EpiBf16Plain E{U, 1024};
        pg8::gemm_phase<EpiBf16Plain, pg8::StaticOrder, true, true>(F.lds, g, S, E); }
    if constexpr (PH == PH_PPO) { pg8::Gemm g{U, wlayer(p, l, WO_PO), M, DM, DPOOL}; S.init(M, DM, F.G, (int)blockIdx.x); EpiGateTemp E{TEMP, PROJ};
        pg8::gemm_phase<EpiGateTemp, pg8::StaticOrder, true, true>(F.lds, g, S, E); }
    if constexpr (PH == PH_GO) { pg8::Gemm g{AGLA, wlayer(p, l, WO_GO), M, DM, DM}; S.init(M, DM, F.G, (int)blockIdx.x); EpiMerge E{MRG, TEMP, PROJ};
        pg8::gemm_phase<EpiMerge, pg8::StaticOrder, true, true>(F.lds, g, S, E); }
    if constexpr (PH == PH_WOUT) { pg8::Gemm g{MRG, wlayer(p, l, WO_OUT), M, DM, DM}; S.init(M, DM, F.G, (int)blockIdx.x);
        EpiResid E{V, l == 0 ? p.x : X, l == 0 ? p.ctx : X + (size_t)MLAT * DM, modv(p, l, 0, 2)};
        pg8::gemm_phase<EpiResid, pg8::StaticOrder, true, true>(F.lds, g, S, E); }
    if constexpr (PH == PH_LN0) phase_ln(F, p, l, 0, M);
    if constexpr (PH == PH_FFI) { pg8::Gemm g{H, wlayer(p, l, WO_FI), M, NFFI, DM}; S.init(M, NFFI, F.G, (int)blockIdx.x); EpiSwiglu E{ACT};
        pg8::gemm_phase<EpiSwiglu, pg8::StaticOrder, true, true>(F.lds, g, S, E); }
    if constexpr (PH == PH_FFO) { pg8::Gemm g{ACT, wlayer(p, l, WO_FO), M, DM, DFF}; S.init(M, DM, F.G, (int)blockIdx.x);
        EpiResid E{V, X, X + (size_t)MLAT * DM, modv(p, l, 0, 5)};
        pg8::gemm_phase<EpiResid, pg8::StaticOrder, true, true>(F.lds, g, S, E); }
    if constexpr (PH == PH_LN1) phase_ln(F, p, l, 1, M);
}
__device__ __forceinline__ Frame make_frame(unsigned char* lds) {
    Frame F; F.lds = (LAS unsigned char*)lds; F.tid = threadIdx.x; F.lane = F.tid & 63; F.wave = __builtin_amdgcn_readfirstlane(F.tid >> 6);
    F.G = gridDim.x; const int bx = blockIdx.x; F.vcu = (F.G % 8 == 0) ? (bx % 8) * (F.G / 8) + bx / 8 : bx; F.gw = F.vcu * NWAVES + F.wave; F.NGW = F.G * NWAVES;
    return F;
}
template <int PH> __global__ void __launch_bounds__(NTHREADS, 2) k_phase(Params p) {
    extern __shared__ __attribute__((aligned(16))) unsigned char lds[];
    const Frame F = make_frame(lds);
    run_phase<PH>(F, p, p.layer);
}

template <int PH> static void launch_phase(Params p, int layer, int grid, hipStream_t stream) {
    static bool attr = false;
    if (!attr) { (void)hipFuncSetAttribute((const void*)k_phase<PH>, hipFuncAttributeMaxDynamicSharedMemorySize, LDS_BYTES); attr = true; }
    p.layer = layer;
    hipLaunchKernelGGL(k_phase<PH>, dim3(grid), dim3(NTHREADS), LDS_BYTES, stream, p);
}
extern "C" void kernel_launch(void* const* d_in, const int* in_sizes, int n_in, void* d_out, int out_size, void* d_ws, size_t ws_size, hipStream_t stream) {
    static int grid = 0;
    if (grid == 0) {
        if (n_in != 21 || out_size != MLAT * DM || ws_size < WS_END) { fprintf(stderr, "kernel_launch: unexpected problem (n_in %d, out %d, ws %zu, need %zu)\n", n_in, out_size, ws_size, (size_t)WS_END); grid = -1; return; }
        int dev = 0, cus = 0;
        if (hipGetDevice(&dev) != hipSuccess || hipDeviceGetAttribute(&cus, hipDeviceAttributeMultiprocessorCount, dev) != hipSuccess) { grid = -1; return; }
        grid = cus;
    }
    if (grid < 0) return;
    (void)hipMemsetAsync((char*)d_ws + WS_CTL, 0, CTL_BYTES, stream);
    Params p{};
    const float** pp = (const float**)&p;
    for (int i = 0; i < 21; ++i) pp[i] = (const float*)d_in[i];
    p.out = (float*)d_out; p.ws = (unsigned char*)d_ws; p.layer = 0; p.pad = 0;
    launch_phase<PH_PRO_A>(p, 0, grid, stream);
    launch_phase<PH_PRO_B>(p, 0, grid, stream);
    for (int l = 0; l < DEPTH; ++l) {
        launch_phase<PH_WIN>(p, l, grid, stream);
        launch_phase<PH_LA>(p, l, grid, stream);
        launch_phase<PH_GLA>(p, l, grid, stream);
        launch_phase<PH_GOUT>(p, l, grid, stream);
        launch_phase<PH_POOL0>(p, l, grid, stream);
        launch_phase<PH_POOL1>(p, l, grid, stream);
        launch_phase<PH_PGRP>(p, l, grid, stream);
        launch_phase<PH_PPO>(p, l, grid, stream);
        launch_phase<PH_GO>(p, l, grid, stream);
        launch_phase<PH_WOUT>(p, l, grid, stream);
        launch_phase<PH_LN0>(p, l, grid, stream);
        launch_phase<PH_FFI>(p, l, grid, stream);
        launch_phase<PH_FFO>(p, l, grid, stream);
        launch_phase<PH_LN1>(p, l, grid, stream);
    }
}
```

```cpp
#include <hip/hip_runtime.h>
#include <cstdio>
#include <cstdint>
namespace pg8 {
#define PG8_LAS __attribute__((address_space(3)))
typedef unsigned short bf16_t;
typedef short bf16x8 __attribute__((ext_vector_type(8)));
typedef float f32x4 __attribute__((ext_vector_type(4)));
typedef unsigned u32x4 __attribute__((ext_vector_type(4)));
constexpr int BM = 256, BK = 64, HALF = 128, HTB = HALF * BK * 2  , STAGE_BYTES = 8 * HTB, NXCD = 8, WGM = 8;

__host__ __device__ __forceinline__ int lds_byte(int r, int c) { const int st = (r >> 4) * 2 + (c >> 5), rr = r & 15, cc = c & 31, ob = rr * 64 + cc * 2; return st * 1024 + (ob ^ (((ob >> 9) & 1) << 5)); }
__host__ __device__ __forceinline__ void stage_rc(int b, int& R, int& C) { const int st = b / 1024, sb = b % 1024, swz = sb ^ (((sb >> 9) & 1) << 5); R = (st >> 1) * 16 + swz / 64; C = (st & 1) * 32 + (swz % 64) / 2; }
__host__ __device__ __forceinline__ int perm32(int rho) { const int n = rho >> 4, i = rho & 15; return 8 * (i >> 2) + 4 * n + (i & 3); }

struct Unit { int pm, pn; };
struct Gemm { const bf16_t* A; const bf16_t* Bt; int M, N, K; };

struct StaticOrder {
    int nM, nN, nwg, G, c;
    __host__ __device__ void init(int M, int N, int G_, int c_) { nM = M / BM; nN = N / BM; nwg = nM * nN; G = G_; c = c_; }
    __host__ __device__ bool next(int i, Unit& u) const {
        const long L = (long)i * G + c; if (L >= nwg) return false;
        int wgid = (int)L; { const int q = nwg / NXCD, r = nwg % NXCD, xcd = wgid % NXCD, off = wgid / NXCD; wgid = (xcd < r ? xcd * (q + 1) : r * (q + 1) + (xcd - r) * q) + off; }
        const int nig = WGM * nN, gid = wgid / nig, fm = gid * WGM, gsz = (nM - fm) < WGM ? (nM - fm) : WGM;
        u.pm = fm + ((wgid % nig) % gsz); u.pn = (wgid % nig) / gsz; return true;
    }
    __device__ __forceinline__ void a_ready(const Unit&) const {}
    __device__ __forceinline__ void done(const Unit&) const {}
};
__device__ __forceinline__ unsigned cvt_pk_bf16(float lo, float hi) { unsigned r; asm volatile("v_cvt_pk_bf16_f32 %0, %1, %2" : "=v"(r) : "v"(lo), "v"(hi)); return r; }
template <class Epi, class Sched, bool ALIGN_EPI = false, bool SP2 = false>
__device__ __forceinline__ void gemm_phase(PG8_LAS unsigned char* lds, const Gemm g, const Sched& S, const Epi& E) {
    int tid_ = threadIdx.x; asm volatile("" : "+v"(tid_));
    const int tid = tid_, wid = __builtin_amdgcn_readfirstlane(tid >> 6), lane = tid & 63, wr = wid >> 2, wc = wid & 3, fr = lane & 15, fq = lane >> 4;
    const int K = g.K, nt = K / BK;
    unsigned voffA[2], voffB[2];
#pragma unroll
    for (int i = 0; i < 2; ++i) { int R, C; stage_rc(tid * 16 + i * 8192, R, C); const int Rb = Epi::PERM ? ((R & ~31) + perm32(R & 31)) : R;
        voffA[i] = (unsigned)(R * K + C) * 2u; voffB[i] = (unsigned)(Rb * K + C) * 2u; }
    const size_t kstep = (size_t)(BK * 2);
    const size_t hstep = (size_t)HALF * K * 2;
    const size_t tstep = 2 * hstep;
    const unsigned ldsw = (unsigned)wid * 1024u;
    const int aoff = lds_byte(wr * 64 + fr, fq * 8), boff = lds_byte(wc * 32 + fr, fq * 8);
#define PG8_SA(b, h) (((b) * 2 + (h)) * HTB)
#define PG8_SB(b, h) ((4 + (b) * 2 + (h)) * HTB)
#define PG8_STAGE(bufoff, gbase, voff) do { _Pragma("unroll") for (int _i = 0; _i < 2; ++_i) \
        __builtin_amdgcn_global_load_lds((const unsigned*)((const char*)(gbase) + (voff)[_i]), (PG8_LAS unsigned*)(lds + (bufoff) + ldsw + _i * 8192), 16, 0, 0); } while (0)
#define PG8_LDA(dst, b, h) do { _Pragma("unroll") for (int m = 0; m < 4; ++m) _Pragma("unroll") for (int k = 0; k < 2; ++k) dst[m][k] = *(const PG8_LAS bf16x8*)(lds + PG8_SA(b, h) + aoff + m * 2048 + k * 1024); } while (0)
#define PG8_LDB(dst, b, h) do { _Pragma("unroll") for (int n = 0; n < 2; ++n) _Pragma("unroll") for (int k = 0; k < 2; ++k) dst[n][k] = *(const PG8_LAS bf16x8*)(lds + PG8_SB(b, h) + boff + n * 2048 + k * 1024); } while (0)
#define PG8_MMA(ai, bj, At, Bt) do { __builtin_amdgcn_s_setprio(1); _Pragma("unroll") for (int m = 0; m < 4; ++m) _Pragma("unroll") for (int n = 0; n < 2; ++n) _Pragma("unroll") for (int k = 0; k < 2; ++k) \
        acc[ai][bj][m][n] = __builtin_amdgcn_mfma_f32_16x16x32_bf16(Bt[n][k], At[m][k], acc[ai][bj][m][n], 0, 0, 0); __builtin_amdgcn_s_setprio(0); } while (0)
#define PG8_WAIT_V(n) asm volatile("s_waitcnt vmcnt(" #n ")" ::: "memory")
#define PG8_WAIT_L(n) asm volatile("s_waitcnt lgkmcnt(" #n ")" ::: "memory")
#define PG8_BAR __builtin_amdgcn_s_barrier()
#define PG8_SCHED __builtin_amdgcn_sched_barrier(0)
    Unit cur, nxt; int ui = 0;
    if (!S.next(0, cur)) return;
    f32x4 acc[2][2][4][2];
#pragma unroll
    for (int a = 0; a < 2; ++a)
#pragma unroll
        for (int b = 0; b < 2; ++b)
#pragma unroll
            for (int m = 0; m < 4; ++m)
#pragma unroll
                for (int n = 0; n < 2; ++n) acc[a][b][m][n] = (f32x4){0.f, 0.f, 0.f, 0.f};
    bf16x8 At[4][2], B0[2][2], B1[2][2];
    const char* cA = (const char*)g.A + (size_t)cur.pm * tstep; const char* cB = (const char*)g.Bt + (size_t)cur.pn * tstep;
    S.a_ready(cur);
    if constexpr (SP2) {
        PG8_STAGE(PG8_SB(0, 0), cB, voffB); PG8_STAGE(PG8_SB(0, 1), cB + hstep, voffB); PG8_STAGE(PG8_SA(0, 0), cA, voffA); PG8_STAGE(PG8_SA(0, 1), cA + hstep, voffA);
        if (wr == 1) PG8_BAR;
        PG8_WAIT_V(2); PG8_BAR;
        PG8_STAGE(PG8_SB(1, 0), cB + kstep, voffB); PG8_STAGE(PG8_SA(1, 0), cA + kstep, voffA); PG8_STAGE(PG8_SB(1, 1), cB + hstep + kstep, voffB);
        PG8_WAIT_V(6); PG8_BAR;
    } else {
        PG8_STAGE(PG8_SB(0, 0), cB, voffB); PG8_STAGE(PG8_SA(0, 0), cA, voffA); PG8_STAGE(PG8_SB(0, 1), cB + hstep, voffB); PG8_STAGE(PG8_SA(0, 1), cA + hstep, voffA);
        if (wr == 1) PG8_BAR;
        PG8_WAIT_V(4); PG8_BAR;
        PG8_STAGE(PG8_SB(1, 0), cB + kstep, voffB); PG8_STAGE(PG8_SA(1, 0), cA + kstep, voffA); PG8_STAGE(PG8_SB(1, 1), cB + hstep + kstep, voffB);
        PG8_WAIT_V(6); PG8_BAR;
    }
    for (;;) {
        const bool has_next = S.next(ui + 1, nxt);
        const char* nA = has_next ? (const char*)g.A + (size_t)nxt.pm * tstep : cA; const char* nB = has_next ? (const char*)g.Bt + (size_t)nxt.pn * tstep : cB;
        for (int t = 0; t < nt; t += 2) {
            const bool last = (t == nt - 2);
            const char* a1 = cA + (size_t)(t + 1) * kstep;
            const char* a2 = last ? nA : cA + (size_t)(t + 2) * kstep; const char* b2 = last ? nB : cB + (size_t)(t + 2) * kstep;
            const char* a3 = a2 + kstep; const char* b3 = b2 + kstep;
            if (last && has_next) S.a_ready(nxt);
            if constexpr (SP2) {
            PG8_LDB(B0, 0, 0); PG8_LDB(B1, 0, 1); PG8_SCHED; PG8_LDA(At, 0, 0); PG8_STAGE(PG8_SA(1, 1), a1 + hstep, voffA);
            PG8_WAIT_V(8); PG8_WAIT_L(0); PG8_BAR; PG8_MMA(0, 0, At, B0); PG8_MMA(0, 1, At, B1); PG8_BAR; PG8_SCHED;
            PG8_LDA(At, 0, 1); PG8_STAGE(PG8_SB(0, 0), b2, voffB); PG8_STAGE(PG8_SB(0, 1), b2 + hstep, voffB); PG8_STAGE(PG8_SA(0, 0), a2, voffA);
            PG8_WAIT_V(8); PG8_WAIT_L(0); PG8_BAR; PG8_MMA(1, 0, At, B0); PG8_MMA(1, 1, At, B1); PG8_BAR; PG8_SCHED;
            PG8_LDB(B0, 1, 0); PG8_LDB(B1, 1, 1); PG8_SCHED; PG8_LDA(At, 1, 0); PG8_STAGE(PG8_SA(0, 1), a2 + hstep, voffA);
            PG8_WAIT_V(8); PG8_WAIT_L(0); PG8_BAR; PG8_MMA(0, 0, At, B0); PG8_MMA(0, 1, At, B1); PG8_BAR; PG8_SCHED;
            PG8_LDA(At, 1, 1); PG8_STAGE(PG8_SB(1, 0), b3, voffB); PG8_STAGE(PG8_SB(1, 1), b3 + hstep, voffB); PG8_STAGE(PG8_SA(1, 0), a3, voffA);
            PG8_WAIT_V(8); PG8_WAIT_L(0); PG8_BAR; PG8_MMA(1, 0, At, B0); PG8_MMA(1, 1, At, B1); PG8_BAR; PG8_SCHED;
            } else {
            PG8_LDB(B0, 0, 0); PG8_SCHED; PG8_LDA(At, 0, 0); PG8_STAGE(PG8_SA(1, 1), a1 + hstep, voffA);
            PG8_WAIT_L(8); PG8_BAR; PG8_WAIT_L(0); PG8_MMA(0, 0, At, B0); PG8_BAR; PG8_SCHED;
            PG8_LDB(B1, 0, 1); PG8_STAGE(PG8_SB(0, 0), b2, voffB);
            PG8_BAR; PG8_WAIT_L(0); PG8_MMA(0, 1, At, B1); PG8_BAR;
            PG8_LDA(At, 0, 1); PG8_STAGE(PG8_SA(0, 0), a2, voffA);
            PG8_BAR; PG8_WAIT_L(0); PG8_MMA(1, 0, At, B0); PG8_BAR; PG8_SCHED;
            PG8_STAGE(PG8_SB(0, 1), b2 + hstep, voffB);
            PG8_WAIT_V(6); PG8_BAR; PG8_MMA(1, 1, At, B1); PG8_BAR;
            PG8_LDB(B0, 1, 0); PG8_SCHED; PG8_LDA(At, 1, 0); PG8_STAGE(PG8_SA(0, 1), a2 + hstep, voffA);
            PG8_WAIT_L(8); PG8_BAR; PG8_WAIT_L(0); PG8_MMA(0, 0, At, B0); PG8_BAR; PG8_SCHED;
            PG8_LDB(B1, 1, 1); PG8_STAGE(PG8_SB(1, 0), b3, voffB);
            PG8_BAR; PG8_WAIT_L(0); PG8_MMA(0, 1, At, B1); PG8_BAR;
            PG8_LDA(At, 1, 1); PG8_STAGE(PG8_SA(1, 0), a3, voffA);
            PG8_BAR; PG8_WAIT_L(0); PG8_MMA(1, 0, At, B0); PG8_BAR; PG8_SCHED;
            PG8_STAGE(PG8_SB(1, 1), b3 + hstep, voffB);
            PG8_WAIT_V(6); PG8_BAR; PG8_MMA(1, 1, At, B1); PG8_BAR;
            }
        }
        if constexpr (ALIGN_EPI) { if (wr == 0) PG8_BAR; }
        if constexpr (!Epi::AFTER_DRAIN) { E(acc, cur, wr, wc, fr, fq); S.done(cur); }
        if (!has_next) break;
#pragma unroll
        for (int a = 0; a < 2; ++a)
#pragma unroll
            for (int b = 0; b < 2; ++b)
#pragma unroll
                for (int m = 0; m < 4; ++m)
#pragma unroll
                    for (int n = 0; n < 2; ++n) acc[a][b][m][n] = (f32x4){0.f, 0.f, 0.f, 0.f};
        cur = nxt; cA = nA; cB = nB; ++ui;
        if constexpr (ALIGN_EPI) { if (wr == 1) PG8_BAR; }
    }
    PG8_WAIT_V(0);
    if constexpr (!ALIGN_EPI) { if (wr == 0) PG8_BAR; }
    PG8_BAR;
    if constexpr (Epi::AFTER_DRAIN) { E.fused(acc, cur, wr, wc, fr, fq, lds, wid, lane); S.done(cur); }
#undef PG8_SA
#undef PG8_SB
#undef PG8_STAGE
#undef PG8_LDA
#undef PG8_LDB
#undef PG8_MMA
#undef PG8_WAIT_V
#undef PG8_WAIT_L
#undef PG8_BAR
#undef PG8_SCHED
}
}
#define GAS __attribute__((address_space(1)))
#define LAS __attribute__((address_space(3)))
typedef unsigned short bf16;
typedef unsigned v4u __attribute__((ext_vector_type(4)));
typedef float f32x4 __attribute__((ext_vector_type(4)));
typedef short bf16x8 __attribute__((ext_vector_type(8)));
typedef GAS unsigned gu32;
typedef GAS unsigned long long gu64;
#define RLX_AGENT __ATOMIC_RELAXED, __HIP_MEMORY_SCOPE_AGENT
#define LDS_WAIT() asm volatile("s_waitcnt lgkmcnt(0)" ::: "memory")
#define VM_WAIT() asm volatile("s_waitcnt vmcnt(0)" ::: "memory")
__device__ __forceinline__ unsigned long long rt() { return __builtin_amdgcn_s_memrealtime(); }
__device__ __forceinline__ unsigned f2bf(float f) { unsigned u = __builtin_bit_cast(unsigned, f); return (u + 0x7fffu + ((u >> 16) & 1u)) >> 16; }
__device__ __forceinline__ unsigned pk2(float lo, float hi) { return f2bf(lo) | (f2bf(hi) << 16); }

#define XB_TMO      128
#define XB_XCNT(j)  (256  + 64 * (j))
#define XB_XSUB(j)  (1280 + 64 * (j))
#define XB_XGEN(j)  (2304 + 64 * (j))
#define XB_TOP      3328
#define XB_TOPGEN   3392
#define XCD_BAR_WORDS 3456
#define XB_SPIN_CAP (1u << 18)

__device__ __forceinline__ unsigned xb_ld(unsigned* p)              { return __hip_atomic_load(p, __ATOMIC_RELAXED, __HIP_MEMORY_SCOPE_AGENT); }
__device__ __forceinline__ unsigned xb_add(unsigned* p, unsigned v) { return __hip_atomic_fetch_add(p, v, __ATOMIC_RELAXED, __HIP_MEMORY_SCOPE_AGENT); }
__device__ __forceinline__ unsigned xb_xcc_id() { return (unsigned)__builtin_amdgcn_s_getreg((3 << 11) | 20) & 0xFu; }
#define XB_SPIN(cond, bar) do { unsigned _sp = 0; while (cond) { __builtin_amdgcn_s_sleep(1); \
    if ((++_sp & 255u) == 0u) { if (xb_ld(&(bar)[XB_TMO])) break; if (_sp > XB_SPIN_CAP) { atomicAdd(&(bar)[XB_TMO], 1u); break; } } } } while (0)

struct XcdBarrier {
    unsigned* bar; unsigned x;
    volatile LAS unsigned* st;
};

__device__ __forceinline__ XcdBarrier xcd_barrier_post(unsigned* bar, volatile LAS unsigned* st) {
    XcdBarrier b; b.bar = bar; b.x = xb_xcc_id(); b.st = st;
    if (threadIdx.x == 0) (void)xb_add(&bar[XB_XCNT(b.x)], 1u);
    return b;
}
__device__ __forceinline__ void xcd_barrier_complete(unsigned* bar, unsigned x, unsigned& nloc, unsigned& nx) {
    const unsigned G = gridDim.x * gridDim.y * gridDim.z;
    unsigned sum, cnt, mine, sp = 0u;
    for (;;) {
        sum = 0u; cnt = 0u; mine = 0u;
#pragma unroll
        for (unsigned j = 0; j < 16; ++j) { const unsigned c = xb_ld(&bar[XB_XCNT(j)]); sum += c; cnt += (c > 0u) ? 1u : 0u; mine = (j == x) ? c : mine; }
        if (sum == G) break;
        __builtin_amdgcn_s_sleep(1);
        if ((++sp & 255u) == 0u) { if (xb_ld(&bar[XB_TMO])) break; if (sp > XB_SPIN_CAP) { atomicAdd(&bar[XB_TMO], 1u); break; } }
    }
    nloc = mine > 0u ? mine : 1u; nx = cnt > 0u ? cnt : 1u;
}

__device__ __forceinline__ void xcd_barrier(const XcdBarrier& b) {
    asm volatile("s_waitcnt vmcnt(0)" ::: "memory");
    __syncthreads();
    if (threadIdx.x == 0) {
        unsigned* bar = b.bar;
        __builtin_amdgcn_s_waitcnt(0);
        unsigned nloc = b.st[0], nx = b.st[1];
        if (nloc == 0u) { xcd_barrier_complete(bar, b.x, nloc, nx); b.st[0] = nloc; b.st[1] = nx; }
        const unsigned old = xb_add(&bar[XB_XSUB(b.x)], 1u);
        const unsigned gen = old / nloc;
        if (old + 1u == (gen + 1u) * nloc) {
            __builtin_amdgcn_fence(__ATOMIC_RELEASE, "agent");
            asm volatile("s_waitcnt vmcnt(0)" ::: "memory");
            const unsigned og = xb_add(&bar[XB_TOP], 1u);
            const unsigned tg = og / nx;
            if (og + 1u == (tg + 1u) * nx) xb_add(&bar[XB_TOPGEN], 1u);
            else XB_SPIN(xb_ld(&bar[XB_TOPGEN]) == tg, bar);
            __builtin_amdgcn_fence(__ATOMIC_ACQUIRE, "agent");
            xb_add(&bar[XB_XGEN(b.x)], 1u);
            asm volatile("s_waitcnt vmcnt(0)" ::: "memory");
        } else {
            XB_SPIN(xb_ld(&bar[XB_XGEN(b.x)]) == gen, bar);
            __builtin_amdgcn_fence(__ATOMIC_ACQUIRE, "agent");
            asm volatile("s_waitcnt vmcnt(0)" ::: "memory");
        }
    }
    __syncthreads();
}

constexpr int DM = 2048, NBATCH = 2, SEQ = 4096, DEPTH = 4, CTXL = 256;
constexpr int NH = 4, HK = 256, HV = 512, RANK = 16;
constexpr int DPOOL = 1024, DFF = 5632, NMODV = 6 * DM;
constexpr int MLAT = NBATCH * SEQ, MCTX = NBATCH * CTXL, MTOT = MLAT + MCTX;
constexpr int NPROJ = 11520, NPROJ_SRC = 11296, NFFI = 2 * DFF;
constexpr int CQ = 0, CK = 1024, CV = 2048, CG = 4096, CP = 6144, CBG = 7168, CBP = 9216, CA = 11264;
constexpr float ALPHA = 1.6817928305074290f;
constexpr float LN_EPS = 1e-5f, RMS_EPS = 1e-6f;
constexpr int NWAVES = 8, NTHREADS = 512;
constexpr int LDS_BYTES = 147456;
constexpr int RING_BYTES = 131072, MISC_OFF = RING_BYTES + 320;

constexpr size_t al256(size_t x) { return (x + 255) & ~(size_t)255; }
constexpr size_t WS_CTL = 0, CTL_BYTES = 1u << 20;
constexpr size_t SZ_MODP = (size_t)DEPTH * 8 * 3 * NMODV * 4, SZ_MOD = (size_t)DEPTH * 3 * NMODV * 4;
constexpr size_t WS_MODP = WS_CTL + CTL_BYTES, WS_MOD = al256(WS_MODP + SZ_MODP), WS_W = al256(WS_MOD + SZ_MOD);
constexpr size_t WO_IN = 0, SZ_IN = (size_t)NPROJ * DM * 2;
constexpr size_t WO_GO = WO_IN + SZ_IN, SZ_GO = (size_t)DM * DM * 2;
constexpr size_t WO_PG = WO_GO + SZ_GO, SZ_PG = (size_t)1024 * 1024 * 2;
constexpr size_t WO_PO = WO_PG + SZ_PG, SZ_PO = (size_t)DM * 1024 * 2;
constexpr size_t WO_OUT = WO_PO + SZ_PO, SZ_OUT = (size_t)DM * DM * 2;
constexpr size_t WO_FI = WO_OUT + SZ_OUT, SZ_FI = (size_t)NFFI * DM * 2;
constexpr size_t WO_FO = WO_FI + SZ_FI, SZ_FO = (size_t)DM * DFF * 2;
constexpr size_t W_LAYER = WO_FO + SZ_FO;
constexpr size_t WS_X = al256(WS_W + DEPTH * W_LAYER), SZ_X = (size_t)MTOT * DM * 4;
constexpr size_t WS_V = WS_X + SZ_X;
constexpr size_t WS_H = WS_V + SZ_X, SZ_H = (size_t)MTOT * DM * 2;
constexpr size_t WS_PROJ = WS_H + SZ_H, SZ_PROJ = (size_t)MTOT * NPROJ * 2;
constexpr size_t WS_ACT = WS_PROJ;
constexpr size_t WS_LA = WS_PROJ + SZ_PROJ, SZ_LA = (size_t)2 * MTOT * 1024 * 4;
constexpr size_t WS_O = WS_LA + SZ_LA, SZ_O = (size_t)MTOT * DM * 4;
constexpr size_t WS_AGLA = WS_O + 2 * SZ_O;
constexpr size_t WS_HM = WS_AGLA + SZ_H, SZ_HM = (size_t)MTOT * 1024 * 4;
constexpr size_t WS_T = WS_HM + SZ_HM, SZ_T = (size_t)MTOT * 1024 * 2;
constexpr size_t WS_U = WS_T + SZ_T;
constexpr size_t WS_TEMP = WS_U + SZ_T;
constexpr size_t WS_MRG = WS_TEMP + SZ_X;
constexpr size_t WS_END = WS_MRG + SZ_H;

struct Params {
    const float *x, *c, *ctx, *c_ctx, *w_ada, *b_ada, *w_in, *w_dup, *b_dup, *gla_gain, *w_pg, *pool_scale, *w_go, *w_po, *w_out, *ln1g, *ln1b, *w_fi, *w_fo, *ln2g, *ln2b;
    float* out; unsigned char* ws; int layer; int pad;
};
typedef float f32x2g __attribute__((ext_vector_type(2)));
typedef unsigned u32x2g __attribute__((ext_vector_type(2)));
struct Frame { LAS unsigned char* lds; int tid, lane, wave, vcu, G, gw, NGW; };

__device__ __forceinline__ bf16* wlayer(const Params& p, int l, size_t off) { return (bf16*)(p.ws + WS_W + (size_t)l * W_LAYER + off); }
__device__ __forceinline__ const float* modv(const Params& p, int l, int mi, int which) { return (const float*)(p.ws + WS_MOD) + ((size_t)l * 3 + mi) * NMODV + (size_t)which * DM; }
__device__ __forceinline__ float bf2f(unsigned short b) { return __builtin_bit_cast(float, (unsigned)b << 16); }
__device__ __forceinline__ float bflo(unsigned w) { return __builtin_bit_cast(float, w << 16); }
__device__ __forceinline__ float bfhi(unsigned w) { return __builtin_bit_cast(float, w & 0xffff0000u); }
__device__ __forceinline__ float fast_sigmoid(float x) { return __builtin_amdgcn_rcpf(1.0f + __expf(-x)); }
__device__ __forceinline__ float wave_sum(float v) {
#pragma unroll
    for (int o = 1; o < 64; o <<= 1) v += __shfl_xor(v, o);
    return v;
}
__device__ __forceinline__ int mod_index(int row) { return row < SEQ ? 0 : (row < MLAT ? 1 : 2); }

struct EpiProj {
    static constexpr bool PERM = true, AFTER_DRAIN = false;
    bf16* O;
    __device__ __forceinline__ void operator()(const pg8::f32x4 (&acc)[2][2][4][2], const pg8::Unit& u, int wr, int wc, int fr, int fq) const {
        const int row0 = u.pm * 256 + wr * 64 + fr, col0 = u.pn * 256 + wc * 32 + 8 * fq;
        const int mode = (u.pn >= 16 && u.pn < 24) ? 1 : ((u.pn >= 28 && u.pn < 44) ? 2 : 0);
#pragma unroll
        for (int ai = 0; ai < 2; ++ai)
#pragma unroll
            for (int m = 0; m < 4; ++m) { bf16* rowp = O + (size_t)(row0 + ai * 128 + m * 16) * NPROJ + col0;
#pragma unroll
                for (int bj = 0; bj < 2; ++bj) { pg8::f32x4 v0 = acc[ai][bj][m][0], v1 = acc[ai][bj][m][1];
                    if (mode != 0) {
#pragma unroll
                        for (int j = 0; j < 4; ++j) { const float s0 = fast_sigmoid(v0[j]), s1 = fast_sigmoid(v1[j]); v0[j] = (mode == 1) ? v0[j] * s0 : s0; v1[j] = (mode == 1) ? v1[j] * s1 : s1; } }
                    pg8::u32x4 w; w.x = pg8::cvt_pk_bf16(v0[0], v0[1]); w.y = pg8::cvt_pk_bf16(v0[2], v0[3]); w.z = pg8::cvt_pk_bf16(v1[0], v1[1]); w.w = pg8::cvt_pk_bf16(v1[2], v1[3]);
                    *(pg8::u32x4*)(rowp + bj * 128) = w; } }
    }
};
struct EpiBf16Plain {
    static constexpr bool PERM = true, AFTER_DRAIN = false;
    bf16* O; int ldc;
    __device__ __forceinline__ void operator()(const pg8::f32x4 (&acc)[2][2][4][2], const pg8::Unit& u, int wr, int wc, int fr, int fq) const {
        const int row0 = u.pm * 256 + wr * 64 + fr, col0 = u.pn * 256 + wc * 32 + 8 * fq;
#pragma unroll
        for (int ai = 0; ai < 2; ++ai)
#pragma unroll
            for (int m = 0; m < 4; ++m) { bf16* rowp = O + (size_t)(row0 + ai * 128 + m * 16) * ldc + col0;
#pragma unroll
                for (int bj = 0; bj < 2; ++bj) { const pg8::f32x4 v0 = acc[ai][bj][m][0], v1 = acc[ai][bj][m][1];
                    pg8::u32x4 w; w.x = pg8::cvt_pk_bf16(v0[0], v0[1]); w.y = pg8::cvt_pk_bf16(v0[2], v0[3]); w.z = pg8::cvt_pk_bf16(v1[0], v1[1]); w.w = pg8::cvt_pk_bf16(v1[2], v1[3]);
                    *(pg8::u32x4*)(rowp + bj * 128) = w; } }
    }
};
struct EpiGateTemp {
    static constexpr bool PERM = true, AFTER_DRAIN = false;
    float* T; const bf16* PROJ;
    __device__ __forceinline__ void operator()(const pg8::f32x4 (&acc)[2][2][4][2], const pg8::Unit& u, int wr, int wc, int fr, int fq) const {
        const int row0 = u.pm * 256 + wr * 64 + fr, col0 = u.pn * 256 + wc * 32 + 8 * fq;
#pragma unroll
        for (int ai = 0; ai < 2; ++ai)
#pragma unroll
            for (int m = 0; m < 4; ++m) { const int row = row0 + ai * 128 + m * 16;
#pragma unroll
                for (int bj = 0; bj < 2; ++bj) { const int c = col0 + bj * 128;
                    const pg8::u32x4 gw = *(const pg8::u32x4*)(PROJ + (size_t)row * NPROJ + CBP + c);
                    pg8::f32x4 v0 = acc[ai][bj][m][0], v1 = acc[ai][bj][m][1];
                    v0[0] *= bflo(gw.x); v0[1] *= bfhi(gw.x); v0[2] *= bflo(gw.y); v0[3] *= bfhi(gw.y);
                    v1[0] *= bflo(gw.z); v1[1] *= bfhi(gw.z); v1[2] *= bflo(gw.w); v1[3] *= bfhi(gw.w);
                    float* tp = T + (size_t)row * DM + c; *(pg8::f32x4*)tp = v0; *(pg8::f32x4*)(tp + 4) = v1; } }
    }
};
struct EpiMerge {
    static constexpr bool PERM = true, AFTER_DRAIN = false;
    bf16* O; const float* T; const bf16* PROJ;
    __device__ __forceinline__ void operator()(const pg8::f32x4 (&acc)[2][2][4][2], const pg8::Unit& u, int wr, int wc, int fr, int fq) const {
        const int row0 = u.pm * 256 + wr * 64 + fr, col0 = u.pn * 256 + wc * 32 + 8 * fq;
#pragma unroll
        for (int ai = 0; ai < 2; ++ai)
#pragma unroll
            for (int m = 0; m < 4; ++m) { const int row = row0 + ai * 128 + m * 16;
#pragma unroll
                for (int bj = 0; bj < 2; ++bj) { const int c = col0 + bj * 128;
                    const pg8::u32x4 gw = *(const pg8::u32x4*)(PROJ + (size_t)row * NPROJ + CBG + c);
                    const float* tp = T + (size_t)row * DM + c; const pg8::f32x4 t0 = *(const pg8::f32x4*)tp, t1 = *(const pg8::f32x4*)(tp + 4);
                    pg8::f32x4 v0 = acc[ai][bj][m][0], v1 = acc[ai][bj][m][1];
                    v0[0] = v0[0] * bflo(gw.x) + t0[0]; v0[1] = v0[1] * bfhi(gw.x) + t0[1]; v0[2] = v0[2] * bflo(gw.y) + t0[2]; v0[3] = v0[3] * bfhi(gw.y) + t0[3];
                    v1[0] = v1[0] * bflo(gw.z) + t1[0]; v1[1] = v1[1] * bfhi(gw.z) + t1[1]; v1[2] = v1[2] * bflo(gw.w) + t1[2]; v1[3] = v1[3] * bfhi(gw.w) + t1[3];
                    pg8::u32x4 w; w.x = pg8::cvt_pk_bf16(v0[0], v0[1]); w.y = pg8::cvt_pk_bf16(v0[2], v0[3]); w.z = pg8::cvt_pk_bf16(v1[0], v1[1]); w.w = pg8::cvt_pk_bf16(v1[2], v1[3]);
                    *(pg8::u32x4*)(O + (size_t)row * DM + c) = w; } }
    }
};
struct EpiResid {
    static constexpr bool PERM = false, AFTER_DRAIN = false;
    float* V; const float* xlat; const float* xctx; const float* gt0;
    __device__ __forceinline__ void operator()(const pg8::f32x4 (&acc)[2][2][4][2], const pg8::Unit& u, int wr, int wc, int fr, int fq) const {
        const int row0 = u.pm * 256 + wr * 64 + fr, col0 = u.pn * 256 + wc * 32 + 4 * fq;
        const int mi = u.pm < 16 ? 0 : (u.pm < 32 ? 1 : 2);
        const float* gt = gt0 + (size_t)mi * NMODV + col0;
        pg8::f32x4 gv[2][2];
#pragma unroll
        for (int bj = 0; bj < 2; ++bj)
#pragma unroll
            for (int n = 0; n < 2; ++n) gv[bj][n] = *(const pg8::f32x4*)(gt + bj * 128 + n * 16);
#pragma unroll
        for (int ai = 0; ai < 2; ++ai)
#pragma unroll
            for (int m = 0; m < 4; ++m) { const int row = row0 + ai * 128 + m * 16;
                const float* xr = (u.pm < 32 ? xlat + (size_t)row * DM : xctx + (size_t)(row - MLAT) * DM) + col0; float* vr = V + (size_t)row * DM + col0;
#pragma unroll
                for (int bj = 0; bj < 2; ++bj)
#pragma unroll
                    for (int n = 0; n < 2; ++n) { const pg8::f32x4 xv = *(const pg8::f32x4*)(xr + bj * 128 + n * 16);
                        *(pg8::f32x4*)(vr + bj * 128 + n * 16) = xv * ALPHA + gv[bj][n] * acc[ai][bj][m][n]; } }
    }
};
struct EpiSwiglu {
    static constexpr bool PERM = true, AFTER_DRAIN = false;
    bf16* O;
    __device__ __forceinline__ void operator()(const pg8::f32x4 (&acc)[2][2][4][2], const pg8::Unit& u, int wr, int wc, int fr, int fq) const {
        const int row0 = u.pm * 256 + wr * 64 + fr, col0 = u.pn * 128 + wc * 32 + 8 * fq;
#pragma unroll
        for (int ai = 0; ai < 2; ++ai)
#pragma unroll
            for (int m = 0; m < 4; ++m) { const int row = row0 + ai * 128 + m * 16;
                pg8::f32x4 a0, a1;
#pragma unroll
                for (int j = 0; j < 4; ++j) { const float g0 = acc[ai][0][m][0][j], g1 = acc[ai][0][m][1][j];
                    a0[j] = g0 * fast_sigmoid(g0) * acc[ai][1][m][0][j]; a1[j] = g1 * fast_sigmoid(g1) * acc[ai][1][m][1][j]; }
                pg8::u32x4 w; w.x = pg8::cvt_pk_bf16(a0[0], a0[1]); w.y = pg8::cvt_pk_bf16(a0[2], a0[3]); w.z = pg8::cvt_pk_bf16(a1[0], a1[1]); w.w = pg8::cvt_pk_bf16(a1[2], a1[3]);
                *(pg8::u32x4*)(O + (size_t)row * DFF + col0) = w; }
    }
};

__device__ __forceinline__ void transpose_item(const float* W, int N, int k0, int n0, bf16* WT, int ldk, int drow0, float colscale, const float* rowscale, LAS float* scr, int lane) {
#pragma unroll 8
    for (int i = 0; i < 32; ++i) { const int kk = 2 * i + (lane >> 5); float v = W[(size_t)(k0 + kk) * N + n0 + (lane & 31)]; if (rowscale) v *= rowscale[k0 + kk]; scr[kk * 33 + (lane & 31)] = v * colscale; }
    LDS_WAIT(); asm volatile("" ::: "memory");
    const int c = lane & 7;
#pragma unroll
    for (int j = 0; j < 4; ++j) { const int n = (lane >> 3) + 8 * j; const LAS float* s = scr + (8 * c) * 33 + n;
        v4u o; o.x = pk2(s[0 * 33], s[1 * 33]); o.y = pk2(s[2 * 33], s[3 * 33]); o.z = pk2(s[4 * 33], s[5 * 33]); o.w = pk2(s[6 * 33], s[7 * 33]);
        *(GAS v4u*)(WT + (size_t)(drow0 + n) * ldk + k0 + 8 * c) = o; }
    LDS_WAIT(); asm volatile("" ::: "memory");
}
constexpr int IT_IN = 32 * (NPROJ_SRC / 32), IT_GO = 32 * 64, IT_PO = 16 * 64, IT_OUT = 32 * 64, IT_FI = 32 * (NFFI / 32), IT_FO = (DFF / 64) * 64, IT_PG = 128, IT_ZIN = 224, IT_ZPG = 1024;
constexpr int IT_LAYER = IT_IN + IT_GO + IT_PO + IT_OUT + IT_FI + IT_FO + IT_PG + IT_ZIN + IT_ZPG;
constexpr int IT_MOD = DEPTH * 48 * 8;
__device__ __forceinline__ void phase_prologue_a(const Frame& F, const Params& p) {
    LAS float* scr = (LAS float*)(F.lds + F.wave * 16384);
    for (int it = F.gw; it < IT_MOD; it += F.NGW) {
        const int l = it / 384, r = it % 384, nb = r / 8, kb = r % 8, k0 = 256 * kb, n0 = 256 * nb + 4 * F.lane;
#pragma unroll
        for (int j = 0; j < 4; ++j) { const int k = k0 + F.lane + 64 * j;
            const float c0 = p.c[k], c1 = p.c[DM + k], c2 = p.c_ctx[k];
            scr[(F.lane + 64 * j) * 3 + 0] = c0 / (1.0f + expf(-c0)); scr[(F.lane + 64 * j) * 3 + 1] = c1 / (1.0f + expf(-c1)); scr[(F.lane + 64 * j) * 3 + 2] = c2 / (1.0f + expf(-c2)); }
        LDS_WAIT(); asm volatile("" ::: "memory");
        f32x4 a0 = {0.f, 0.f, 0.f, 0.f}, a1 = a0, a2 = a0;
        const float* wp = p.w_ada + ((size_t)l * DM + k0) * NMODV + n0;
#pragma unroll 8
        for (int kk = 0; kk < 256; ++kk) { const f32x4 w = *(const GAS f32x4*)(wp + (size_t)kk * NMODV); const float s0 = scr[kk * 3], s1 = scr[kk * 3 + 1], s2 = scr[kk * 3 + 2];
            a0 += w * s0; a1 += w * s1; a2 += w * s2; }
        float* mp = (float*)(p.ws + WS_MODP) + ((size_t)(l * 8 + kb) * 3) * NMODV + n0;
        *(GAS f32x4*)(mp) = a0; *(GAS f32x4*)(mp + NMODV) = a1; *(GAS f32x4*)(mp + 2 * NMODV) = a2;
        LDS_WAIT(); asm volatile("" ::: "memory");
    }
    for (int it = F.gw; it < DEPTH * IT_LAYER; it += F.NGW) {
        const int l = it / IT_LAYER; int r = it % IT_LAYER;
        if (r < IT_IN) { const int nblk = NPROJ_SRC / 32, kb = r / nblk, n0 = 32 * (r % nblk);
            int drow; float cs = 1.0f;
            if (n0 < 6144) { drow = n0; if (n0 < 1024) cs = 0.0625f; } else if (n0 < 6176) drow = CA + (n0 - 6144); else if (n0 < 7200) drow = CP + (n0 - 6176); else drow = CBG + (n0 - 7200);
            transpose_item(p.w_in + (size_t)l * DM * NPROJ_SRC, NPROJ_SRC, 64 * kb, n0, wlayer(p, l, WO_IN), DM, drow, cs, nullptr, scr, F.lane); continue; } r -= IT_IN;
        if (r < IT_GO) { transpose_item(p.w_go + (size_t)l * DM * DM, DM, 64 * (r / 64), 32 * (r % 64), wlayer(p, l, WO_GO), DM, 32 * (r % 64), 1.0f, nullptr, scr, F.lane); continue; } r -= IT_GO;
        if (r < IT_PO) { transpose_item(p.w_po + (size_t)l * DPOOL * DM, DM, 64 * (r / 64), 32 * (r % 64), wlayer(p, l, WO_PO), DPOOL, 32 * (r % 64), 1.0f, p.pool_scale + (size_t)l * DPOOL, scr, F.lane); continue; } r -= IT_PO;
        if (r < IT_OUT) { transpose_item(p.w_out + (size_t)l * DM * DM, DM, 64 * (r / 64), 32 * (r % 64), wlayer(p, l, WO_OUT), DM, 32 * (r % 64), 1.0f, nullptr, scr, F.lane); continue; } r -= IT_OUT;
        if (r < IT_FI) { const int nblk = NFFI / 32, kb = r / nblk, n0 = 32 * (r % nblk), up = n0 >= DFF ? 1 : 0, ch = n0 - up * DFF;
            transpose_item(p.w_fi + (size_t)l * DM * NFFI, NFFI, 64 * kb, n0, wlayer(p, l, WO_FI), DM, 256 * (ch / 128) + 128 * up + (ch % 128), 1.0f, nullptr, scr, F.lane); continue; } r -= IT_FI;
        if (r < IT_FO) { transpose_item(p.w_fo + (size_t)l * DFF * DM, DM, 64 * (r / 64), 32 * (r % 64), wlayer(p, l, WO_FO), DFF, 32 * (r % 64), 1.0f, nullptr, scr, F.lane); continue; } r -= IT_FO;
        if (r < IT_PG) { const int g = r / 32, q = r % 32;
            transpose_item(p.w_pg + ((size_t)l * 4 + g) * 256 * 256, 256, 64 * (q / 8), 32 * (q % 8), wlayer(p, l, WO_PG) + 256 * g, 1024, 256 * g + 32 * (q % 8), 1.0f, nullptr, scr, F.lane); continue; } r -= IT_PG;
        if (r < IT_ZIN) { GAS v4u* zp = (GAS v4u*)(wlayer(p, l, WO_IN) + (size_t)(NPROJ_SRC + r) * DM);
#pragma unroll
            for (int j = 0; j < 4; ++j) zp[F.lane + 64 * j] = (v4u){0u, 0u, 0u, 0u};
            continue; } r -= IT_ZIN;
        { GAS v4u* zp = (GAS v4u*)(wlayer(p, l, WO_PG) + (size_t)r * 1024); const int g = r >> 8;
#pragma unroll
          for (int j = 0; j < 2; ++j) { const int ch = F.lane + 64 * j; if ((ch >> 5) != g) zp[ch] = (v4u){0u, 0u, 0u, 0u}; } }
    }
}
__device__ __forceinline__ void phase_prologue_b(const Frame& F, const Params& p) {
    const float* MP = (const float*)(p.ws + WS_MODP); float* MO = (float*)(p.ws + WS_MOD);
    for (int e = F.vcu * NTHREADS + F.tid; e < DEPTH * 3 * NMODV; e += F.G * NTHREADS) { const int l = e / (3 * NMODV), r = e % (3 * NMODV), n = r % NMODV;
        float s = p.b_ada[(size_t)l * NMODV + n];
#pragma unroll
        for (int kb = 0; kb < 8; ++kb) s += MP[((size_t)(l * 8 + kb) * 3) * NMODV + r];
        MO[e] = s; }
    LAS float* sm = (LAS float*)F.lds;
    for (int e = F.tid; e < 3 * 2 * DM; e += NTHREADS) { const int mi = e / (2 * DM), r = e % (2 * DM);
        float s = p.b_ada[r];
#pragma unroll
        for (int kb = 0; kb < 8; ++kb) s += MP[((size_t)kb * 3 + mi) * NMODV + r];
        sm[e] = s; }
    __syncthreads();
    bf16* H = (bf16*)(p.ws + WS_H);
    for (int row = F.gw; row < MTOT; row += F.NGW) { const int mi = mod_index(row);
        const float* xr = row < MLAT ? p.x + (size_t)row * DM : p.ctx + (size_t)(row - MLAT) * DM;
        const LAS float* sh = sm + mi * 2 * DM; const LAS float* sc = sh + DM;
        GAS unsigned long long* o8 = (GAS unsigned long long*)(H + (size_t)row * DM) + F.lane;
#pragma unroll
        for (int j = 0; j < 8; ++j) { const int c = 4 * F.lane + 256 * j; const f32x4 v = *(const GAS f32x4*)(xr + c);
            const float y0 = v.x * (1.0f + sc[c]) + sh[c], y1 = v.y * (1.0f + sc[c + 1]) + sh[c + 1], y2 = v.z * (1.0f + sc[c + 2]) + sh[c + 2], y3 = v.w * (1.0f + sc[c + 3]) + sh[c + 3];
            o8[64 * j] = (unsigned long long)pk2(y0, y1) | ((unsigned long long)pk2(y2, y3) << 32); } }
    __syncthreads();
}
__device__ __forceinline__ void phase_ln(const Frame& F, const Params& p, int l, int sub, int M) {
    const float* V = (const float*)(p.ws + WS_V); float* X = (float*)(p.ws + WS_X); bf16* H = (bf16*)(p.ws + WS_H);
    const float* gain = (sub == 0 ? p.ln1g : p.ln2g) + (size_t)l * DM; const float* bias = (sub == 0 ? p.ln1b : p.ln2b) + (size_t)l * DM;
    const bool last = (sub == 1 && l == DEPTH - 1);
    const int lm = sub == 0 ? l : l + 1, wsh = sub == 0 ? 3 : 0, wsc = sub == 0 ? 4 : 1;
    for (int row = F.gw; row < M; row += F.NGW) {
        const GAS f32x4* vr = (const GAS f32x4*)(V + (size_t)row * DM) + F.lane;
        f32x4 v[8]; float s = 0.f;
#pragma unroll
        for (int j = 0; j < 8; ++j) { v[j] = vr[64 * j]; s += (v[j].x + v[j].y) + (v[j].z + v[j].w); }
        const float mean = wave_sum(s) * (1.f / DM); float s2 = 0.f;
#pragma unroll
        for (int j = 0; j < 8; ++j) { v[j] = v[j] - mean; s2 += (v[j].x * v[j].x + v[j].y * v[j].y) + (v[j].z * v[j].z + v[j].w * v[j].w); }
        const float rstd = 1.f / sqrtf(wave_sum(s2) * (1.f / DM) + LN_EPS);
#pragma unroll
        for (int j = 0; j < 8; ++j) { const int c = 4 * F.lane + 256 * j; const f32x4 g = *(const GAS f32x4*)(gain + c), b = *(const GAS f32x4*)(bias + c); v[j] = v[j] * rstd * g + b; }
        if (last) { GAS f32x4* o = (GAS f32x4*)(p.out + (size_t)row * DM) + F.lane;
#pragma unroll
            for (int j = 0; j < 8; ++j) o[64 * j] = v[j];
        } else {
            GAS f32x4* xo = (GAS f32x4*)(X + (size_t)row * DM) + F.lane;
            const int mi = mod_index(row); const float* sh = modv(p, lm, mi, wsh); const float* sc = modv(p, lm, mi, wsc);
            GAS unsigned long long* o8 = (GAS unsigned long long*)(H + (size_t)row * DM) + F.lane;
#pragma unroll
            for (int j = 0; j < 8; ++j) { const int c = 4 * F.lane + 256 * j; xo[64 * j] = v[j];
                const f32x4 a = *(const GAS f32x4*)(sc + c), b = *(const GAS f32x4*)(sh + c); const f32x4 y = v[j] * (a + 1.0f) + b;
                o8[64 * j] = (unsigned long long)pk2(y.x, y.y) | ((unsigned long long)pk2(y.z, y.w) << 32); } }
    }
}
__device__ __forceinline__ void phase_pool(const Frame& F, const Params& p, int pass) {
    const bf16* PROJ = (const bf16*)(p.ws + WS_PROJ); float* HM = (float*)(p.ws + WS_HM); bf16* T = (bf16*)(p.ws + WS_T);
    for (int task = F.gw; task < MTOT * 8; task += F.NGW) { const int row = task >> 3, cb = task & 7, c = cb * 128 + 2 * F.lane, g = cb >> 1, w = 2 << g, lo = w >> 1, hi = w - lo - 1;
        int idx, n, stride;
        if (row < MLAT) { const int t = row & (SEQ - 1); if (pass == 0) { idx = t & 63; n = 64; stride = 1; } else { idx = t >> 6; n = 64; stride = 64; } }
        else { const int t = (row - MLAT) & (CTXL - 1); idx = t; n = (pass == 0) ? CTXL : 1; stride = 1; if (pass == 1) idx = 0; }
        const int lower = max(idx - lo, 0), upper = min(idx + hi + 1, n);
        float s0 = 0.f, s1 = 0.f;
        if (pass == 0) { for (int q = lower; q < upper; ++q) { const unsigned wv = *(const GAS unsigned*)(PROJ + (size_t)(row + (q - idx) * stride) * NPROJ + CP + c); s0 += bflo(wv); s1 += bfhi(wv); } }
        else { for (int q = lower; q < upper; ++q) { const f32x2g hv = *(const GAS f32x2g*)(HM + (size_t)(row + (q - idx) * stride) * DPOOL + c); s0 += hv.x; s1 += hv.y; } }
        const float inv = 1.0f / (float)(upper - lower); s0 *= inv; s1 *= inv;
        if (pass == 0) { *(GAS f32x2g*)(HM + (size_t)row * DPOOL + c) = (f32x2g){s0, s1}; }
        else { const unsigned wv = *(const GAS unsigned*)(PROJ + (size_t)row * NPROJ + CP + c); *(GAS unsigned*)(T + (size_t)row * DPOOL + c) = pk2(s0 - bflo(wv), s1 - bfhi(wv)); }
    }
}
__device__ __forceinline__ float log_sigmoid_f(float z) { return fminf(z, 0.f) - log1pf(expf(-fabsf(z))); }
__device__ __forceinline__ void phase_la(const Frame& F, const Params& p, int l) {
    const bf16* PROJ = (const bf16*)(p.ws + WS_PROJ); float* LA = (float*)(p.ws + WS_LA);
    for (int task = F.gw; task < MTOT * 2; task += F.NGW) { const int row = task >> 1, dir = task & 1;
        const bf16* ap = PROJ + (size_t)row * NPROJ + CA + dir * 16; float a[16];
#pragma unroll
        for (int r = 0; r < 16; ++r) a[r] = bf2f(ap[r]);
        const float* wu = p.w_dup + ((size_t)l * 2 + dir) * RANK * 1024; const float* bu = p.b_dup + ((size_t)l * 2 + dir) * 1024;
#pragma unroll
        for (int j = 0; j < 4; ++j) { const int d = 4 * F.lane + 256 * j; f32x4 z = *(const GAS f32x4*)(bu + d);
#pragma unroll
            for (int r = 0; r < 16; ++r) z += *(const GAS f32x4*)(wu + (size_t)r * 1024 + d) * a[r];
            f32x4 o; o.x = log_sigmoid_f(z.x) * 0.0625f; o.y = log_sigmoid_f(z.y) * 0.0625f; o.z = log_sigmoid_f(z.z) * 0.0625f; o.w = log_sigmoid_f(z.w) * 0.0625f;
            *(GAS f32x4*)(LA + ((size_t)dir * MTOT + row) * 1024 + d) = o; } }
}
__device__ __forceinline__ void phase_gla_naive(const Frame& F, const Params& p) {
    const bf16* PROJ = (const bf16*)(p.ws + WS_PROJ); const float* LA = (const float*)(p.ws + WS_LA); float* O = (float*)(p.ws + WS_O);
    for (int it = F.gw; it < NBATCH * NH * HV; it += F.NGW) { const int b = it >> 11, h = (it >> 9) & 3, vcol = it & 511;
        for (int dir = 0; dir < 2; ++dir) {
            float S0 = 0.f, S1 = 0.f, S2 = 0.f, S3 = 0.f;
#pragma unroll 4
            for (int step = 0; step < CTXL + SEQ; ++step) {
                int row; if (step < CTXL) { const int t = dir ? CTXL - 1 - step : step; row = MLAT + b * CTXL + t; } else { const int s2 = step - CTXL; const int t = dir ? SEQ - 1 - s2 : s2; row = b * SEQ + t; }
                const bf16* pr = PROJ + (size_t)row * NPROJ;
                const u32x2g qw = *(const GAS u32x2g*)(pr + CQ + h * HK + 4 * F.lane), kw = *(const GAS u32x2g*)(pr + CK + h * HK + 4 * F.lane);
                const f32x4 la = *(const GAS f32x4*)(LA + ((size_t)dir * MTOT + row) * 1024 + h * HK + 4 * F.lane);
                const float vv = bf2f(pr[CV + h * HV + vcol]);
                S0 = expf(la.x) * S0 + bflo(kw.x) * vv; S1 = expf(la.y) * S1 + bfhi(kw.x) * vv; S2 = expf(la.z) * S2 + bflo(kw.y) * vv; S3 = expf(la.w) * S3 + bfhi(kw.y) * vv;
                const float part = wave_sum((bflo(qw.x) * S0 + bfhi(qw.x) * S1) + (bflo(qw.y) * S2 + bfhi(qw.y) * S3));
                if (F.lane == 0) { float* op = O + (size_t)row * DM + h * HV + vcol; *op = dir ? *op + part : part; }
            }
        }
    }
}
template <int NO> __device__ __forceinline__ void phase_gout(const Frame& F, const Params& p, int l, int M) {
    const bf16* PROJ = (const bf16*)(p.ws + WS_PROJ); const float* O = (const float*)(p.ws + WS_O); bf16* A = (bf16*)(p.ws + WS_AGLA);
    const float* gain = p.gla_gain + (size_t)l * DM;
    for (int task = F.gw; task < M * NH; task += F.NGW) { const int row = task >> 2, h = task & 3, c = h * HV + 8 * F.lane;
        f32x4 o0 = *(const GAS f32x4*)(O + (size_t)row * DM + c), o1 = *(const GAS f32x4*)(O + (size_t)row * DM + c + 4);
        if (NO == 2) { o0 += *(const GAS f32x4*)(O + (size_t)(MTOT + row) * DM + c); o1 += *(const GAS f32x4*)(O + (size_t)(MTOT + row) * DM + c + 4); }
        const float ss = wave_sum((o0.x * o0.x + o0.y * o0.y) + (o0.z * o0.z + o0.w * o0.w) + (o1.x * o1.x + o1.y * o1.y) + (o1.z * o1.z + o1.w * o1.w));
        const float r = 1.0f / sqrtf(ss * (1.0f / HV) + RMS_EPS);
        const f32x4 g0 = *(const GAS f32x4*)(gain + c), g1 = *(const GAS f32x4*)(gain + c + 4);
        const v4u gw = *(const GAS v4u*)(PROJ + (size_t)row * NPROJ + CG + c);
        v4u w; w.x = pk2(o0.x * r * g0.x * bflo(gw.x), o0.y * r * g0.y * bfhi(gw.x)); w.y = pk2(o0.z * r * g0.z * bflo(gw.y), o0.w * r * g0.w * bfhi(gw.y));
        w.z = pk2(o1.x * r * g1.x * bflo(gw.z), o1.y * r * g1.y * bfhi(gw.z)); w.w = pk2(o1.z * r * g1.z * bflo(gw.w), o1.w * r * g1.w * bfhi(gw.w));
        *(GAS v4u*)(A + (size_t)row * DM + c) = w; }
}

enum { PH_PRO_A = 0, PH_PRO_B, PH_WIN, PH_LA, PH_GLA, PH_GOUT, PH_POOL0, PH_POOL1, PH_PGRP, PH_PPO, PH_GO, PH_WOUT, PH_LN0, PH_FFI, PH_FFO, PH_LN1, PH_COUNT };

template <int PH> __device__ __forceinline__ void run_phase(const Frame& F0, const Params& p0, int l) {
    Frame F = F0; asm volatile("" : "+v"(F.tid));
    F.lane = F.tid & 63; F.wave = __builtin_amdgcn_readfirstlane(F.tid >> 6); F.gw = F.vcu * NWAVES + F.wave;
    Params p = p0; asm volatile("" : "+s"(p.ws));
    const int M = (l == DEPTH - 1) ? MLAT : MTOT;
    bf16* H = (bf16*)(p.ws + WS_H); bf16* PROJ = (bf16*)(p.ws + WS_PROJ); bf16* ACT = (bf16*)(p.ws + WS_ACT); float* X = (float*)(p.ws + WS_X); float* V = (float*)(p.ws + WS_V);
    bf16* AGLA = (bf16*)(p.ws + WS_AGLA); bf16* T = (bf16*)(p.ws + WS_T); bf16* U = (bf16*)(p.ws + WS_U); float* TEMP = (float*)(p.ws + WS_TEMP); bf16* MRG = (bf16*)(p.ws + WS_MRG);
    pg8::StaticOrder S;
    if constexpr (PH == PH_PRO_A) phase_prologue_a(F, p);
    if constexpr (PH == PH_PRO_B) phase_prologue_b(F, p);
    if constexpr (PH == PH_WIN) { pg8::Gemm g{H, wlayer(p, l, WO_IN), MTOT, NPROJ, DM}; S.init(MTOT, NPROJ, F.G, (int)blockIdx.x); EpiProj E{PROJ};
        pg8::gemm_phase<EpiProj, pg8::StaticOrder, true, true>(F.lds, g, S, E); }
    if constexpr (PH == PH_LA) phase_la(F, p, l);
    if constexpr (PH == PH_GLA) phase_gla_naive(F, p);
    if constexpr (PH == PH_GOUT) phase_gout<1>(F, p, l, M);
    if constexpr (PH == PH_POOL0) phase_pool(F, p, 0);
    if constexpr (PH == PH_POOL1) phase_pool(F, p, 1);
    if constexpr (PH == PH_PGRP) { pg8::Gemm g{T, wlayer(p, l, WO_PG), M, 1024, 1024}; S.init(M, 1024, F.G, (int)blockIdx.x); EpiBf16Plain E{U, 1024};
        pg8::gemm_phase<EpiBf16Plain, pg8::StaticOrder, true, true>(F.lds, g, S, E); }
    if constexpr (PH == PH_PPO) { pg8::Gemm g{U, wlayer(p, l, WO_PO), M, DM, DPOOL}; S.init(M, DM, F.G, (int)blockIdx.x); EpiGateTemp E{TEMP, PROJ};
        pg8::gemm_phase<EpiGateTemp, pg8::StaticOrder, true, true>(F.lds, g, S, E); }
    if constexpr (PH == PH_GO) { pg8::Gemm g{AGLA, wlayer(p, l, WO_GO), M, DM, DM}; S.init(M, DM, F.G, (int)blockIdx.x); EpiMerge E{MRG, TEMP, PROJ};
        pg8::gemm_phase<EpiMerge, pg8::StaticOrder, true, true>(F.lds, g, S, E); }
    if constexpr (PH == PH_WOUT) { pg8::Gemm g{MRG, wlayer(p, l, WO_OUT), M, DM, DM}; S.init(M, DM, F.G, (int)blockIdx.x);
        EpiResid E{V, l == 0 ? p.x : X, l == 0 ? p.ctx : X + (size_t)MLAT * DM, modv(p, l, 0, 2)};
        pg8::gemm_phase<EpiResid, pg8::StaticOrder, true, true>(F.lds, g, S, E); }
    if constexpr (PH == PH_LN0) phase_ln(F, p, l, 0, M);
    if constexpr (PH == PH_FFI) { pg8::Gemm g{H, wlayer(p, l, WO_FI), M, NFFI, DM}; S.init(M, NFFI, F.G, (int)blockIdx.x); EpiSwiglu E{ACT};
        pg8::gemm_phase<EpiSwiglu, pg8::StaticOrder, true, true>(F.lds, g, S, E); }
    if constexpr (PH == PH_FFO) { pg8::Gemm g{ACT, wlayer(p, l, WO_FO), M, DM, DFF}; S.init(M, DM, F.G, (int)blockIdx.x);
        EpiResid E{V, X, X + (size_t)MLAT * DM, modv(p, l, 0, 5)};
        pg8::gemm_phase<EpiResid, pg8::StaticOrder, true, true>(F.lds, g, S, E); }
    if constexpr (PH == PH_LN1) phase_ln(F, p, l, 1, M);
}
__device__ __forceinline__ Frame make_frame(unsigned char* lds) {
    Frame F; F.lds = (LAS unsigned char*)lds; F.tid = threadIdx.x; F.lane = F.tid & 63; F.wave = __builtin_amdgcn_readfirstlane(F.tid >> 6);
    F.G = gridDim.x; const int bx = blockIdx.x; F.vcu = (F.G % 8 == 0) ? (bx % 8) * (F.G / 8) + bx / 8 : bx; F.gw = F.vcu * NWAVES + F.wave; F.NGW = F.G * NWAVES;
    return F;
}

constexpr int CW_BAR = 4096;
#define PHASE(ph, l) do { run_phase<ph>(F, p, (l)); xcd_barrier(bar); } while (0)
__global__ void __launch_bounds__(NTHREADS, 2) k_mega(Params p) {
    extern __shared__ __attribute__((aligned(16))) unsigned char lds[];
    const Frame F = make_frame(lds);
    for (int u = F.tid; u < (LDS_BYTES - RING_BYTES) / 4; u += NTHREADS) ((LAS unsigned*)(F.lds + RING_BYTES))[u] = 0u;
    __syncthreads();
    const XcdBarrier bar = xcd_barrier_post((unsigned*)(p.ws + WS_CTL) + CW_BAR, (volatile LAS unsigned*)(F.lds + MISC_OFF) + 8);
    PHASE(PH_PRO_A, 0);
    PHASE(PH_PRO_B, 0);
    for (int l = 0; l < DEPTH; ++l) {
        PHASE(PH_WIN, l);
        PHASE(PH_LA, l);
        PHASE(PH_GLA, l);
        PHASE(PH_GOUT, l);
        PHASE(PH_POOL0, l);
        PHASE(PH_POOL1, l);
        PHASE(PH_PGRP, l);
        PHASE(PH_PPO, l);
        PHASE(PH_GO, l);
        PHASE(PH_WOUT, l);
        PHASE(PH_LN0, l);
        PHASE(PH_FFI, l);
        PHASE(PH_FFO, l);
        if (l < DEPTH - 1) PHASE(PH_LN1, l); else run_phase<PH_LN1>(F, p, l);
    }
}

extern "C" void kernel_launch(void* const* d_in, const int* in_sizes, int n_in, void* d_out, int out_size, void* d_ws, size_t ws_size, hipStream_t stream) {
    static int grid = 0;
    if (grid == 0) {
        if (n_in != 21 || out_size != MLAT * DM || ws_size < WS_END) { fprintf(stderr, "kernel_launch: unexpected problem (n_in %d, out %d, ws %zu, need %zu)\n", n_in, out_size, ws_size, (size_t)WS_END); grid = -1; return; }
        int dev = 0, cus = 0, per_cu = 0;
        if (hipGetDevice(&dev) != hipSuccess || hipDeviceGetAttribute(&cus, hipDeviceAttributeMultiprocessorCount, dev) != hipSuccess) { grid = -1; return; }
        if (hipFuncSetAttribute((const void*)k_mega, hipFuncAttributeMaxDynamicSharedMemorySize, LDS_BYTES) != hipSuccess) { fprintf(stderr, "kernel_launch: hipFuncSetAttribute failed\n"); grid = -1; return; }
        if (hipOccupancyMaxActiveBlocksPerMultiprocessor(&per_cu, (const void*)k_mega, NTHREADS, LDS_BYTES) != hipSuccess || per_cu < 1) fprintf(stderr, "kernel_launch: occupancy query reports %d workgroups per CU\n", per_cu);
        (void)hipGetLastError();
        grid = cus;
    }
    if (grid < 0) return;
    (void)hipMemsetAsync((char*)d_ws + WS_CTL, 0, CTL_BYTES, stream);
    Params p{};
    const float** pp = (const float**)&p;
    for (int i = 0; i < 21; ++i) pp[i] = (const float*)d_in[i];
    p.out = (float*)d_out; p.ws = (unsigned char*)d_ws; p.layer = 0; p.pad = 0;
    hipLaunchKernelGGL(k_mega, dim3(grid), dim3(NTHREADS), LDS_BYTES, stream, p);
}
```

```cpp
#include <hip/hip_runtime.h>
#include <cstdio>
#include <cstdint>
namespace pg8 {
#define PG8_LAS __attribute__((address_space(3)))
typedef unsigned short bf16_t;
typedef short bf16x8 __attribute__((ext_vector_type(8)));
typedef float f32x4 __attribute__((ext_vector_type(4)));
typedef unsigned u32x4 __attribute__((ext_vector_type(4)));
constexpr int BM = 256, BK = 64, HALF = 128, HTB = HALF * BK * 2  , STAGE_BYTES = 8 * HTB, NXCD = 8, WGM = 8;

__host__ __device__ __forceinline__ int lds_byte(int r, int c) { const int st = (r >> 4) * 2 + (c >> 5), rr = r & 15, cc = c & 31, ob = rr * 64 + cc * 2; return st * 1024 + (ob ^ (((ob >> 9) & 1) << 5)); }
__host__ __device__ __forceinline__ void stage_rc(int b, int& R, int& C) { const int st = b / 1024, sb = b % 1024, swz = sb ^ (((sb >> 9) & 1) << 5); R = (st >> 1) * 16 + swz / 64; C = (st & 1) * 32 + (swz % 64) / 2; }
__host__ __device__ __forceinline__ int perm32(int rho) { const int n = rho >> 4, i = rho & 15; return 8 * (i >> 2) + 4 * n + (i & 3); }

struct Unit { int pm, pn; };
struct Gemm { const bf16_t* A; const bf16_t* Bt; int M, N, K; };

struct StaticOrder {
    int nM, nN, nwg, G, c;
    __host__ __device__ void init(int M, int N, int G_, int c_) { nM = M / BM; nN = N / BM; nwg = nM * nN; G = G_; c = c_; }
    __host__ __device__ bool next(int i, Unit& u) const {
        const long L = (long)i * G + c; if (L >= nwg) return false;
        int wgid = (int)L; { const int q = nwg / NXCD, r = nwg % NXCD, xcd = wgid % NXCD, off = wgid / NXCD; wgid = (xcd < r ? xcd * (q + 1) : r * (q + 1) + (xcd - r) * q) + off; }
        const int nig = WGM * nN, gid = wgid / nig, fm = gid * WGM, gsz = (nM - fm) < WGM ? (nM - fm) : WGM;
        u.pm = fm + ((wgid % nig) % gsz); u.pn = (wgid % nig) / gsz; return true;
    }
    __device__ __forceinline__ void a_ready(const Unit&) const {}
    __device__ __forceinline__ void done(const Unit&) const {}
};
__device__ __forceinline__ unsigned cvt_pk_bf16(float lo, float hi) { unsigned r; asm volatile("v_cvt_pk_bf16_f32 %0, %1, %2" : "=v"(r) : "v"(lo), "v"(hi)); return r; }
template <class Epi, class Sched, bool ALIGN_EPI = false, bool SP2 = false>
__device__ __forceinline__ void gemm_phase(PG8_LAS unsigned char* lds, const Gemm g, const Sched& S, const Epi& E) {
    int tid_ = threadIdx.x; asm volatile("" : "+v"(tid_));
    const int tid = tid_, wid = __builtin_amdgcn_readfirstlane(tid >> 6), lane = tid & 63, wr = wid >> 2, wc = wid & 3, fr = lane & 15, fq = lane >> 4;
    const int K = g.K, nt = K / BK;
    unsigned voffA[2], voffB[2];
#pragma unroll
    for (int i = 0; i < 2; ++i) { int R, C; stage_rc(tid * 16 + i * 8192, R, C); const int Rb = Epi::PERM ? ((R & ~31) + perm32(R & 31)) : R;
        voffA[i] = (unsigned)(R * K + C) * 2u; voffB[i] = (unsigned)(Rb * K + C) * 2u; }
    const size_t kstep = (size_t)(BK * 2);
    const size_t hstep = (size_t)HALF * K * 2;
    const size_t tstep = 2 * hstep;
    const unsigned ldsw = (unsigned)wid * 1024u;
    const int aoff = lds_byte(wr * 64 + fr, fq * 8), boff = lds_byte(wc * 32 + fr, fq * 8);
#define PG8_SA(b, h) (((b) * 2 + (h)) * HTB)
#define PG8_SB(b, h) ((4 + (b) * 2 + (h)) * HTB)
#define PG8_STAGE(bufoff, gbase, voff) do { _Pragma("unroll") for (int _i = 0; _i < 2; ++_i) \
        __builtin_amdgcn_global_load_lds((const unsigned*)((const char*)(gbase) + (voff)[_i]), (PG8_LAS unsigned*)(lds + (bufoff) + ldsw + _i * 8192), 16, 0, 0); } while (0)
#define PG8_LDA(dst, b, h) do { _Pragma("unroll") for (int m = 0; m < 4; ++m) _Pragma("unroll") for (int k = 0; k < 2; ++k) dst[m][k] = *(const PG8_LAS bf16x8*)(lds + PG8_SA(b, h) + aoff + m * 2048 + k * 1024); } while (0)
#define PG8_LDB(dst, b, h) do { _Pragma("unroll") for (int n = 0; n < 2; ++n) _Pragma("unroll") for (int k = 0; k < 2; ++k) dst[n][k] = *(const PG8_LAS bf16x8*)(lds + PG8_SB(b, h) + boff + n * 2048 + k * 1024); } while (0)
#define PG8_MMA(ai, bj, At, Bt) do { __builtin_amdgcn_s_setprio(1); _Pragma("unroll") for (int m = 0; m < 4; ++m) _Pragma("unroll") for (int n = 0; n < 2; ++n) _Pragma("unroll") for (int k = 0; k < 2; ++k) \
        acc[ai][bj][m][n] = __builtin_amdgcn_mfma_f32_16x16x32_bf16(Bt[n][k], At[m][k], acc[ai][bj][m][n], 0, 0, 0); __builtin_amdgcn_s_setprio(0); } while (0)
#define PG8_WAIT_V(n) asm volatile("s_waitcnt vmcnt(" #n ")" ::: "memory")
#define PG8_WAIT_L(n) asm volatile("s_waitcnt lgkmcnt(" #n ")" ::: "memory")
#define PG8_BAR __builtin_amdgcn_s_barrier()
#define PG8_SCHED __builtin_amdgcn_sched_barrier(0)
    Unit cur, nxt; int ui = 0;
    if (!S.next(0, cur)) return;
    f32x4 acc[2][2][4][2];
#pragma unroll
    for (int a = 0; a < 2; ++a)
#pragma unroll
        for (int b = 0; b < 2; ++b)
#pragma unroll
            for (int m = 0; m < 4; ++m)
#pragma unroll
                for (int n = 0; n < 2; ++n) acc[a][b][m][n] = (f32x4){0.f, 0.f, 0.f, 0.f};
    bf16x8 At[4][2], B0[2][2], B1[2][2];
    const char* cA = (const char*)g.A + (size_t)cur.pm * tstep; const char* cB = (const char*)g.Bt + (size_t)cur.pn * tstep;
    S.a_ready(cur);
    if constexpr (SP2) {
        PG8_STAGE(PG8_SB(0, 0), cB, voffB); PG8_STAGE(PG8_SB(0, 1), cB + hstep, voffB); PG8_STAGE(PG8_SA(0, 0), cA, voffA); PG8_STAGE(PG8_SA(0, 1), cA + hstep, voffA);
        if (wr == 1) PG8_BAR;
        PG8_WAIT_V(2); PG8_BAR;
        PG8_STAGE(PG8_SB(1, 0), cB + kstep, voffB); PG8_STAGE(PG8_SA(1, 0), cA + kstep, voffA); PG8_STAGE(PG8_SB(1, 1), cB + hstep + kstep, voffB);
        PG8_WAIT_V(6); PG8_BAR;
    } else {
        PG8_STAGE(PG8_SB(0, 0), cB, voffB); PG8_STAGE(PG8_SA(0, 0), cA, voffA); PG8_STAGE(PG8_SB(0, 1), cB + hstep, voffB); PG8_STAGE(PG8_SA(0, 1), cA + hstep, voffA);
        if (wr == 1) PG8_BAR;
        PG8_WAIT_V(4); PG8_BAR;
        PG8_STAGE(PG8_SB(1, 0), cB + kstep, voffB); PG8_STAGE(PG8_SA(1, 0), cA + kstep, voffA); PG8_STAGE(PG8_SB(1, 1), cB + hstep + kstep, voffB);
        PG8_WAIT_V(6); PG8_BAR;
    }
    for (;;) {
        const bool has_next = S.next(ui + 1, nxt);
        const char* nA = has_next ? (const char*)g.A + (size_t)nxt.pm * tstep : cA; const char* nB = has_next ? (const char*)g.Bt + (size_t)nxt.pn * tstep : cB;
        for (int t = 0; t < nt; t += 2) {
            const bool last = (t == nt - 2);
            const char* a1 = cA + (size_t)(t + 1) * kstep;
            const char* a2 = last ? nA : cA + (size_t)(t + 2) * kstep; const char* b2 = last ? nB : cB + (size_t)(t + 2) * kstep;
            const char* a3 = a2 + kstep; const char* b3 = b2 + kstep;
            if (last && has_next) S.a_ready(nxt);
            if constexpr (SP2) {
            PG8_LDB(B0, 0, 0); PG8_LDB(B1, 0, 1); PG8_SCHED; PG8_LDA(At, 0, 0); PG8_STAGE(PG8_SA(1, 1), a1 + hstep, voffA);
            PG8_WAIT_V(8); PG8_WAIT_L(0); PG8_BAR; PG8_MMA(0, 0, At, B0); PG8_MMA(0, 1, At, B1); PG8_BAR; PG8_SCHED;
            PG8_LDA(At, 0, 1); PG8_STAGE(PG8_SB(0, 0), b2, voffB); PG8_STAGE(PG8_SB(0, 1), b2 + hstep, voffB); PG8_STAGE(PG8_SA(0, 0), a2, voffA);
            PG8_WAIT_V(8); PG8_WAIT_L(0); PG8_BAR; PG8_MMA(1, 0, At, B0); PG8_MMA(1, 1, At, B1); PG8_BAR; PG8_SCHED;
            PG8_LDB(B0, 1, 0); PG8_LDB(B1, 1, 1); PG8_SCHED; PG8_LDA(At, 1, 0); PG8_STAGE(PG8_SA(0, 1), a2 + hstep, voffA);
            PG8_WAIT_V(8); PG8_WAIT_L(0); PG8_BAR; PG8_MMA(0, 0, At, B0); PG8_MMA(0, 1, At, B1); PG8_BAR; PG8_SCHED;
            PG8_LDA(At, 1, 1); PG8_STAGE(PG8_SB(1, 0), b3, voffB); PG8_STAGE(PG8_SB(1, 1), b3 + hstep, voffB); PG8_STAGE(PG8_SA(1, 0), a3, voffA);
            PG8_WAIT_V(8); PG8_WAIT_L(0); PG8_BAR; PG8_MMA(1, 0, At, B0); PG8_MMA(1, 1, At, B1); PG8_BAR; PG8_SCHED;
            } else {
            PG8_LDB(B0, 0, 0); PG8_SCHED; PG8_LDA(At, 0, 0); PG8_STAGE(PG8_SA(1, 1), a1 + hstep, voffA);
            PG8_WAIT_L(8); PG8_BAR; PG8_WAIT_L(0); PG8_MMA(0, 0, At, B0); PG8_BAR; PG8_SCHED;
            PG8_LDB(B1, 0, 1); PG8_STAGE(PG8_SB(0, 0), b2, voffB);
            PG8_BAR; PG8_WAIT_L(0); PG8_MMA(0, 1, At, B1); PG8_BAR;
            PG8_LDA(At, 0, 1); PG8_STAGE(PG8_SA(0, 0), a2, voffA);
            PG8_BAR; PG8_WAIT_L(0); PG8_MMA(1, 0, At, B0); PG8_BAR; PG8_SCHED;
            PG8_STAGE(PG8_SB(0, 1), b2 + hstep, voffB);
            PG8_WAIT_V(6); PG8_BAR; PG8_MMA(1, 1, At, B1); PG8_BAR;
            PG8_LDB(B0, 1, 0); PG8_SCHED; PG8_LDA(At, 1, 0); PG8_STAGE(PG8_SA(0, 1), a2 + hstep, voffA);
            PG8_WAIT_L(8); PG8_BAR; PG8_WAIT_L(0); PG8_MMA(0, 0, At, B0); PG8_BAR; PG8_SCHED;
            PG8_LDB(B1, 1, 1); PG8_STAGE(PG8_SB(1, 0), b3, voffB);
            PG8_BAR; PG8_WAIT_L(0); PG8_MMA(0, 1, At, B1); PG8_BAR;
            PG8_LDA(At, 1, 1); PG8_STAGE(PG8_SA(1, 0), a3, voffA);
            PG8_BAR; PG8_WAIT_L(0); PG8_MMA(1, 0, At, B0); PG8_BAR; PG8_SCHED;
            PG8_STAGE(PG8_SB(1, 1), b3 + hstep, voffB);
            PG8_WAIT_V(6); PG8_BAR; PG8_MMA(1, 1, At, B1); PG8_BAR;
            }
        }
        if constexpr (ALIGN_EPI) { if (wr == 0) PG8_BAR; }
        if constexpr (!Epi::AFTER_DRAIN) { E(acc, cur, wr, wc, fr, fq); S.done(cur); }
        if (!has_next) break;
#pragma unroll
        for (int a = 0; a < 2; ++a)
#pragma unroll
            for (int b = 0; b < 2; ++b)
#pragma unroll
                for (int m = 0; m < 4; ++m)
#pragma unroll
                    for (int n = 0; n < 2; ++n) acc[a][b][m][n] = (f32x4){0.f, 0.f, 0.f, 0.f};
        cur = nxt; cA = nA; cB = nB; ++ui;
        if constexpr (ALIGN_EPI) { if (wr == 1) PG8_BAR; }
    }
    PG8_WAIT_V(0);
    if constexpr (!ALIGN_EPI) { if (wr == 0) PG8_BAR; }
    PG8_BAR;
    if constexpr (Epi::AFTER_DRAIN) { E.fused(acc, cur, wr, wc, fr, fq, lds, wid, lane); S.done(cur); }
#undef PG8_SA
#undef PG8_SB
#undef PG8_STAGE
#undef PG8_LDA
#undef PG8_LDB
#undef PG8_MMA
#undef PG8_WAIT_V
#undef PG8_WAIT_L
#undef PG8_BAR
#undef PG8_SCHED
}
}
#define GAS __attribute__((address_space(1)))
#define LAS __attribute__((address_space(3)))
typedef unsigned short bf16;
typedef unsigned v4u __attribute__((ext_vector_type(4)));
typedef float f32x4 __attribute__((ext_vector_type(4)));
typedef short bf16x8 __attribute__((ext_vector_type(8)));
typedef GAS unsigned gu32;
typedef GAS unsigned long long gu64;
#define RLX_AGENT __ATOMIC_RELAXED, __HIP_MEMORY_SCOPE_AGENT
#define LDS_WAIT() asm volatile("s_waitcnt lgkmcnt(0)" ::: "memory")
#define VM_WAIT() asm volatile("s_waitcnt vmcnt(0)" ::: "memory")
__device__ __forceinline__ unsigned long long rt() { return __builtin_amdgcn_s_memrealtime(); }
__device__ __forceinline__ unsigned f2bf(float f) { unsigned u = __builtin_bit_cast(unsigned, f); return (u + 0x7fffu + ((u >> 16) & 1u)) >> 16; }
__device__ __forceinline__ unsigned pk2(float lo, float hi) { return f2bf(lo) | (f2bf(hi) << 16); }

#define XB_TMO      128
#define XB_XCNT(j)  (256  + 64 * (j))
#define XB_XSUB(j)  (1280 + 64 * (j))
#define XB_XGEN(j)  (2304 + 64 * (j))
#define XB_TOP      3328
#define XB_TOPGEN   3392
#define XCD_BAR_WORDS 3456
#define XB_SPIN_CAP (1u << 18)

__device__ __forceinline__ unsigned xb_ld(unsigned* p)              { return __hip_atomic_load(p, __ATOMIC_RELAXED, __HIP_MEMORY_SCOPE_AGENT); }
__device__ __forceinline__ unsigned xb_add(unsigned* p, unsigned v) { return __hip_atomic_fetch_add(p, v, __ATOMIC_RELAXED, __HIP_MEMORY_SCOPE_AGENT); }
__device__ __forceinline__ unsigned xb_xcc_id() { return (unsigned)__builtin_amdgcn_s_getreg((3 << 11) | 20) & 0xFu; }
#define XB_SPIN(cond, bar) do { unsigned _sp = 0; while (cond) { __builtin_amdgcn_s_sleep(1); \
    if ((++_sp & 255u) == 0u) { if (xb_ld(&(bar)[XB_TMO])) break; if (_sp > XB_SPIN_CAP) { atomicAdd(&(bar)[XB_TMO], 1u); break; } } } } while (0)

struct XcdBarrier {
    unsigned* bar; unsigned x;
    volatile LAS unsigned* st;
};

__device__ __forceinline__ XcdBarrier xcd_barrier_post(unsigned* bar, volatile LAS unsigned* st) {
    XcdBarrier b; b.bar = bar; b.x = xb_xcc_id(); b.st = st;
    if (threadIdx.x == 0) (void)xb_add(&bar[XB_XCNT(b.x)], 1u);
    return b;
}
__device__ __forceinline__ void xcd_barrier_complete(unsigned* bar, unsigned x, unsigned& nloc, unsigned& nx) {
    const unsigned G = gridDim.x * gridDim.y * gridDim.z;
    unsigned sum, cnt, mine, sp = 0u;
    for (;;) {
        sum = 0u; cnt = 0u; mine = 0u;
#pragma unroll
        for (unsigned j = 0; j < 16; ++j) { const unsigned c = xb_ld(&bar[XB_XCNT(j)]); sum += c; cnt += (c > 0u) ? 1u : 0u; mine = (j == x) ? c : mine; }
        if (sum == G) break;
        __builtin_amdgcn_s_sleep(1);
        if ((++sp & 255u) == 0u) { if (xb_ld(&bar[XB_TMO])) break; if (sp > XB_SPIN_CAP) { atomicAdd(&bar[XB_TMO], 1u); break; } }
    }
    nloc = mine > 0u ? mine : 1u; nx = cnt > 0u ? cnt : 1u;
}

__device__ __forceinline__ void xcd_barrier(const XcdBarrier& b) {
    asm volatile("s_waitcnt vmcnt(0)" ::: "memory");
    __syncthreads();
    if (threadIdx.x == 0) {
        unsigned* bar = b.bar;
        __builtin_amdgcn_s_waitcnt(0);
        unsigned nloc = b.st[0], nx = b.st[1];
        if (nloc == 0u) { xcd_barrier_complete(bar, b.x, nloc, nx); b.st[0] = nloc; b.st[1] = nx; }
        const unsigned old = xb_add(&bar[XB_XSUB(b.x)], 1u);
        const unsigned gen = old / nloc;
        if (old + 1u == (gen + 1u) * nloc) {
            __builtin_amdgcn_fence(__ATOMIC_RELEASE, "agent");
            asm volatile("s_waitcnt vmcnt(0)" ::: "memory");
            const unsigned og = xb_add(&bar[XB_TOP], 1u);
            const unsigned tg = og / nx;
            if (og + 1u == (tg + 1u) * nx) xb_add(&bar[XB_TOPGEN], 1u);
            else XB_SPIN(xb_ld(&bar[XB_TOPGEN]) == tg, bar);
            __builtin_amdgcn_fence(__ATOMIC_ACQUIRE, "agent");
            xb_add(&bar[XB_XGEN(b.x)], 1u);
            asm volatile("s_waitcnt vmcnt(0)" ::: "memory");
        } else {
            XB_SPIN(xb_ld(&bar[XB_XGEN(b.x)]) == gen, bar);
            __builtin_amdgcn_fence(__ATOMIC_ACQUIRE, "agent");
            asm volatile("s_waitcnt vmcnt(0)" ::: "memory");
        }
    }
    __syncthreads();
}

constexpr int DM = 2048, NBATCH = 2, SEQ = 4096, DEPTH = 4, CTXL = 256;
constexpr int NH = 4, HK = 256, HV = 512, RANK = 16;
constexpr int DPOOL = 1024, DFF = 5632, NMODV = 6 * DM;
constexpr int MLAT = NBATCH * SEQ, MCTX = NBATCH * CTXL, MTOT = MLAT + MCTX;
constexpr int NPROJ = 11520, NPROJ_SRC = 11296, NFFI = 2 * DFF;
constexpr int CQ = 0, CK = 1024, CV = 2048, CG = 4096, CP = 6144, CBG = 7168, CBP = 9216, CA = 11264;
constexpr float ALPHA = 1.6817928305074290f;
constexpr float LN_EPS = 1e-5f, RMS_EPS = 1e-6f;
constexpr int NWAVES = 8, NTHREADS = 512;
constexpr int LDS_BYTES = 147456;
constexpr int RING_BYTES = 131072, MISC_OFF = RING_BYTES + 320;

constexpr size_t al256(size_t x) { return (x + 255) & ~(size_t)255; }
constexpr size_t WS_CTL = 0, CTL_BYTES = 1u << 20;
constexpr size_t SZ_MODP = (size_t)DEPTH * 8 * 3 * NMODV * 4, SZ_MOD = (size_t)DEPTH * 3 * NMODV * 4;
constexpr size_t WS_MODP = WS_CTL + CTL_BYTES, WS_MOD = al256(WS_MODP + SZ_MODP), WS_W = al256(WS_MOD + SZ_MOD);
constexpr size_t WO_IN = 0, SZ_IN = (size_t)NPROJ * DM * 2;
constexpr size_t WO_GO = WO_IN + SZ_IN, SZ_GO = (size_t)DM * DM * 2;
constexpr size_t WO_PG = WO_GO + SZ_GO, SZ_PG = (size_t)1024 * 1024 * 2;
constexpr size_t WO_PO = WO_PG + SZ_PG, SZ_PO = (size_t)DM * 1024 * 2;
constexpr size_t WO_OUT = WO_PO + SZ_PO, SZ_OUT = (size_t)DM * DM * 2;
constexpr size_t WO_FI = WO_OUT + SZ_OUT, SZ_FI = (size_t)NFFI * DM * 2;
constexpr size_t WO_FO = WO_FI + SZ_FI, SZ_FO = (size_t)DM * DFF * 2;
constexpr size_t W_LAYER = WO_FO + SZ_FO;
constexpr size_t WS_X = al256(WS_W + DEPTH * W_LAYER), SZ_X = (size_t)MTOT * DM * 4;
constexpr size_t WS_V = WS_X + SZ_X;
constexpr size_t WS_H = WS_V + SZ_X, SZ_H = (size_t)MTOT * DM * 2;
constexpr size_t WS_PROJ = WS_H + SZ_H, SZ_PROJ = (size_t)MTOT * NPROJ * 2;
constexpr size_t WS_ACT = WS_PROJ;
constexpr int NCG = MTOT / 64;
constexpr size_t WS_LA = WS_PROJ + SZ_PROJ, SZ_LA = (size_t)2 * MTOT * 1024 * 4;
constexpr size_t WS_QI = WS_LA, SZ_QI = (size_t)2 * MTOT * 1024 * 2;
constexpr size_t WS_KST = WS_QI + SZ_QI, SZ_KST = (size_t)2 * NCG * 4 * 256 * 64 * 2;
constexpr size_t WS_PM = WS_KST + SZ_KST, SZ_PM = (size_t)2 * NCG * 4 * 64 * 64 * 2;
constexpr size_t WS_DCB = WS_PM + SZ_PM, SZ_DCB = (size_t)2 * NCG * 4 * 256 * 4;
constexpr size_t WS_VT = WS_DCB + SZ_DCB, SZ_VT = (size_t)NCG * 4 * 512 * 64 * 2;
constexpr size_t WS_GLAEND = WS_VT + SZ_VT;
static_assert(WS_GLAEND >= WS_LA + SZ_LA, "overlay");
constexpr size_t WS_O = WS_GLAEND, SZ_O = (size_t)MTOT * DM * 4;
constexpr size_t WS_AGLA = WS_O + 2 * SZ_O;
constexpr size_t WS_HM = WS_AGLA + SZ_H, SZ_HM = (size_t)MTOT * 1024 * 4;
constexpr size_t WS_T = WS_HM + SZ_HM, SZ_T = (size_t)MTOT * 1024 * 2;
constexpr size_t WS_U = WS_T + SZ_T;
constexpr size_t WS_TEMP = WS_U + SZ_T;
constexpr size_t WS_MRG = WS_TEMP + SZ_X;
constexpr size_t WS_END = WS_MRG + SZ_H;

struct Params {
    const float *x, *c, *ctx, *c_ctx, *w_ada, *b_ada, *w_in, *w_dup, *b_dup, *gla_gain, *w_pg, *pool_scale, *w_go, *w_po, *w_out, *ln1g, *ln1b, *w_fi, *w_fo, *ln2g, *ln2b;
    float* out; unsigned char* ws; int layer; int pad;
};
typedef float f32x2g __attribute__((ext_vector_type(2)));
typedef unsigned u32x2g __attribute__((ext_vector_type(2)));
struct Frame { LAS unsigned char* lds; int tid, lane, wave, vcu, G, gw, NGW; };

__device__ __forceinline__ bf16* wlayer(const Params& p, int l, size_t off) { return (bf16*)(p.ws + WS_W + (size_t)l * W_LAYER + off); }
__device__ __forceinline__ const float* modv(const Params& p, int l, int mi, int which) { return (const float*)(p.ws + WS_MOD) + ((size_t)l * 3 + mi) * NMODV + (size_t)which * DM; }
__device__ __forceinline__ float bf2f(unsigned short b) { return __builtin_bit_cast(float, (unsigned)b << 16); }
__device__ __forceinline__ float bflo(unsigned w) { return __builtin_bit_cast(float, w << 16); }
__device__ __forceinline__ float bfhi(unsigned w) { return __builtin_bit_cast(float, w & 0xffff0000u); }
__device__ __forceinline__ float fast_sigmoid(float x) { return __builtin_amdgcn_rcpf(1.0f + __expf(-x)); }
__device__ __forceinline__ float wave_sum(float v) {
#pragma unroll
    for (int o = 1; o < 64; o <<= 1) v += __shfl_xor(v, o);
    return v;
}
__device__ __forceinline__ int mod_index(int row) { return row < SEQ ? 0 : (row < MLAT ? 1 : 2); }

struct EpiProj {
    static constexpr bool PERM = true, AFTER_DRAIN = false;
    bf16* O;
    __device__ __forceinline__ void operator()(const pg8::f32x4 (&acc)[2][2][4][2], const pg8::Unit& u, int wr, int wc, int fr, int fq) const {
        const int row0 = u.pm * 256 + wr * 64 + fr, col0 = u.pn * 256 + wc * 32 + 8 * fq;
        const int mode = (u.pn >= 16 && u.pn < 24) ? 1 : ((u.pn >= 28 && u.pn < 44) ? 2 : 0);
#pragma unroll
        for (int ai = 0; ai < 2; ++ai)
#pragma unroll
            for (int m = 0; m < 4; ++m) { bf16* rowp = O + (size_t)(row0 + ai * 128 + m * 16) * NPROJ + col0;
#pragma unroll
                for (int bj = 0; bj < 2; ++bj) { pg8::f32x4 v0 = acc[ai][bj][m][0], v1 = acc[ai][bj][m][1];
                    if (mode != 0) {
#pragma unroll
                        for (int j = 0; j < 4; ++j) { const float s0 = fast_sigmoid(v0[j]), s1 = fast_sigmoid(v1[j]); v0[j] = (mode == 1) ? v0[j] * s0 : s0; v1[j] = (mode == 1) ? v1[j] * s1 : s1; } }
                    pg8::u32x4 w; w.x = pg8::cvt_pk_bf16(v0[0], v0[1]); w.y = pg8::cvt_pk_bf16(v0[2], v0[3]); w.z = pg8::cvt_pk_bf16(v1[0], v1[1]); w.w = pg8::cvt_pk_bf16(v1[2], v1[3]);
                    *(pg8::u32x4*)(rowp + bj * 128) = w; } }
    }
};
struct EpiBf16Plain {
    static constexpr bool PERM = true, AFTER_DRAIN = false;
    bf16* O; int ldc;
    __device__ __forceinline__ void operator()(const pg8::f32x4 (&acc)[2][2][4][2], const pg8::Unit& u, int wr, int wc, int fr, int fq) const {
        const int row0 = u.pm * 256 + wr * 64 + fr, col0 = u.pn * 256 + wc * 32 + 8 * fq;
#pragma unroll
        for (int ai = 0; ai < 2; ++ai)
#pragma unroll
            for (int m = 0; m < 4; ++m) { bf16* rowp = O + (size_t)(row0 + ai * 128 + m * 16) * ldc + col0;
#pragma unroll
                for (int bj = 0; bj < 2; ++bj) { const pg8::f32x4 v0 = acc[ai][bj][m][0], v1 = acc[ai][bj][m][1];
                    pg8::u32x4 w; w.x = pg8::cvt_pk_bf16(v0[0], v0[1]); w.y = pg8::cvt_pk_bf16(v0[2], v0[3]); w.z = pg8::cvt_pk_bf16(v1[0], v1[1]); w.w = pg8::cvt_pk_bf16(v1[2], v1[3]);
                    *(pg8::u32x4*)(rowp + bj * 128) = w; } }
    }
};
struct EpiGateTemp {
    static constexpr bool PERM = true, AFTER_DRAIN = false;
    float* T; const bf16* PROJ;
    __device__ __forceinline__ void operator()(const pg8::f32x4 (&acc)[2][2][4][2], const pg8::Unit& u, int wr, int wc, int fr, int fq) const {
        const int row0 = u.pm * 256 + wr * 64 + fr, col0 = u.pn * 256 + wc * 32 + 8 * fq;
#pragma unroll
        for (int ai = 0; ai < 2; ++ai)
#pragma unroll
            for (int m = 0; m < 4; ++m) { const int row = row0 + ai * 128 + m * 16;
#pragma unroll
                for (int bj = 0; bj < 2; ++bj) { const int c = col0 + bj * 128;
                    const pg8::u32x4 gw = *(const pg8::u32x4*)(PROJ + (size_t)row * NPROJ + CBP + c);
                    pg8::f32x4 v0 = acc[ai][bj][m][0], v1 = acc[ai][bj][m][1];
                    v0[0] *= bflo(gw.x); v0[1] *= bfhi(gw.x); v0[2] *= bflo(gw.y); v0[3] *= bfhi(gw.y);
                    v1[0] *= bflo(gw.z); v1[1] *= bfhi(gw.z); v1[2] *= bflo(gw.w); v1[3] *= bfhi(gw.w);
                    float* tp = T + (size_t)row * DM + c; *(pg8::f32x4*)tp = v0; *(pg8::f32x4*)(tp + 4) = v1; } }
    }
};
struct EpiMerge {
    static constexpr bool PERM = true, AFTER_DRAIN = false;
    bf16* O; const float* T; const bf16* PROJ;
    __device__ __forceinline__ void operator()(const pg8::f32x4 (&acc)[2][2][4][2], const pg8::Unit& u, int wr, int wc, int fr, int fq) const {
        const int row0 = u.pm * 256 + wr * 64 + fr, col0 = u.pn * 256 + wc * 32 + 8 * fq;
#pragma unroll
        for (int ai = 0; ai < 2; ++ai)
#pragma unroll
            for (int m = 0; m < 4; ++m) { const int row = row0 + ai * 128 + m * 16;
#pragma unroll
                for (int bj = 0; bj < 2; ++bj) { const int c = col0 + bj * 128;
                    const pg8::u32x4 gw = *(const pg8::u32x4*)(PROJ + (size_t)row * NPROJ + CBG + c);
                    const float* tp = T + (size_t)row * DM + c; const pg8::f32x4 t0 = *(const pg8::f32x4*)tp, t1 = *(const pg8::f32x4*)(tp + 4);
                    pg8::f32x4 v0 = acc[ai][bj][m][0], v1 = acc[ai][bj][m][1];
                    v0[0] = v0[0] * bflo(gw.x) + t0[0]; v0[1] = v0[1] * bfhi(gw.x) + t0[1]; v0[2] = v0[2] * bflo(gw.y) + t0[2]; v0[3] = v0[3] * bfhi(gw.y) + t0[3];
                    v1[0] = v1[0] * bflo(gw.z) + t1[0]; v1[1] = v1[1] * bfhi(gw.z) + t1[1]; v1[2] = v1[2] * bflo(gw.w) + t1[2]; v1[3] = v1[3] * bfhi(gw.w) + t1[3];
                    pg8::u32x4 w; w.x = pg8::cvt_pk_bf16(v0[0], v0[1]); w.y = pg8::cvt_pk_bf16(v0[2], v0[3]); w.z = pg8::cvt_pk_bf16(v1[0], v1[1]); w.w = pg8::cvt_pk_bf16(v1[2], v1[3]);
                    *(pg8::u32x4*)(O + (size_t)row * DM + c) = w; } }
    }
};
struct EpiResid {
    static constexpr bool PERM = false, AFTER_DRAIN = false;
    float* V; const float* xlat; const float* xctx; const float* gt0;
    __device__ __forceinline__ void operator()(const pg8::f32x4 (&acc)[2][2][4][2], const pg8::Unit& u, int wr, int wc, int fr, int fq) const {
        const int row0 = u.pm * 256 + wr * 64 + fr, col0 = u.pn * 256 + wc * 32 + 4 * fq;
        const int mi = u.pm < 16 ? 0 : (u.pm < 32 ? 1 : 2);
        const float* gt = gt0 + (size_t)mi * NMODV + col0;
        pg8::f32x4 gv[2][2];
#pragma unroll
        for (int bj = 0; bj < 2; ++bj)
#pragma unroll
            for (int n = 0; n < 2; ++n) gv[bj][n] = *(const pg8::f32x4*)(gt + bj * 128 + n * 16);
#pragma unroll
        for (int ai = 0; ai < 2; ++ai)
#pragma unroll
            for (int m = 0; m < 4; ++m) { const int row = row0 + ai * 128 + m * 16;
                const float* xr = (u.pm < 32 ? xlat + (size_t)row * DM : xctx + (size_t)(row - MLAT) * DM) + col0; float* vr = V + (size_t)row * DM + col0;
#pragma unroll
                for (int bj = 0; bj < 2; ++bj)
#pragma unroll
                    for (int n = 0; n < 2; ++n) { const pg8::f32x4 xv = *(const pg8::f32x4*)(xr + bj * 128 + n * 16);
                        *(pg8::f32x4*)(vr + bj * 128 + n * 16) = xv * ALPHA + gv[bj][n] * acc[ai][bj][m][n]; } }
    }
};
struct EpiSwiglu {
    static constexpr bool PERM = true, AFTER_DRAIN = false;
    bf16* O;
    __device__ __forceinline__ void operator()(const pg8::f32x4 (&acc)[2][2][4][2], const pg8::Unit& u, int wr, int wc, int fr, int fq) const {
        const int row0 = u.pm * 256 + wr * 64 + fr, col0 = u.pn * 128 + wc * 32 + 8 * fq;
#pragma unroll
        for (int ai = 0; ai < 2; ++ai)
#pragma unroll
            for (int m = 0; m < 4; ++m) { const int row = row0 + ai * 128 + m * 16;
                pg8::f32x4 a0, a1;
#pragma unroll
                for (int j = 0; j < 4; ++j) { const float g0 = acc[ai][0][m][0][j], g1 = acc[ai][0][m][1][j];
                    a0[j] = g0 * fast_sigmoid(g0) * acc[ai][1][m][0][j]; a1[j] = g1 * fast_sigmoid(g1) * acc[ai][1][m][1][j]; }
                pg8::u32x4 w; w.x = pg8::cvt_pk_bf16(a0[0], a0[1]); w.y = pg8::cvt_pk_bf16(a0[2], a0[3]); w.z = pg8::cvt_pk_bf16(a1[0], a1[1]); w.w = pg8::cvt_pk_bf16(a1[2], a1[3]);
                *(pg8::u32x4*)(O + (size_t)row * DFF + col0) = w; }
    }
};

__device__ __forceinline__ void transpose_item(const float* W, int N, int k0, int n0, bf16* WT, int ldk, int drow0, float colscale, const float* rowscale, LAS float* scr, int lane) {
#pragma unroll 8
    for (int i = 0; i < 32; ++i) { const int kk = 2 * i + (lane >> 5); float v = W[(size_t)(k0 + kk) * N + n0 + (lane & 31)]; if (rowscale) v *= rowscale[k0 + kk]; scr[kk * 33 + (lane & 31)] = v * colscale; }
    LDS_WAIT(); asm volatile("" ::: "memory");
    const int c = lane & 7;
#pragma unroll
    for (int j = 0; j < 4; ++j) { const int n = (lane >> 3) + 8 * j; const LAS float* s = scr + (8 * c) * 33 + n;
        v4u o; o.x = pk2(s[0 * 33], s[1 * 33]); o.y = pk2(s[2 * 33], s[3 * 33]); o.z = pk2(s[4 * 33], s[5 * 33]); o.w = pk2(s[6 * 33], s[7 * 33]);
        *(GAS v4u*)(WT + (size_t)(drow0 + n) * ldk + k0 + 8 * c) = o; }
    LDS_WAIT(); asm volatile("" ::: "memory");
}
constexpr int IT_IN = 32 * (NPROJ_SRC / 32), IT_GO = 32 * 64, IT_PO = 16 * 64, IT_OUT = 32 * 64, IT_FI = 32 * (NFFI / 32), IT_FO = (DFF / 64) * 64, IT_PG = 128, IT_ZIN = 224, IT_ZPG = 1024;
constexpr int IT_LAYER = IT_IN + IT_GO + IT_PO + IT_OUT + IT_FI + IT_FO + IT_PG + IT_ZIN + IT_ZPG;
constexpr int IT_MOD = DEPTH * 48 * 8;
__device__ __forceinline__ void phase_prologue_a(const Frame& F, const Params& p) {
    LAS float* scr = (LAS float*)(F.lds + F.wave * 16384);
    for (int it = F.gw; it < IT_MOD; it += F.NGW) {
        const int l = it / 384, r = it % 384, nb = r / 8, kb = r % 8, k0 = 256 * kb, n0 = 256 * nb + 4 * F.lane;
#pragma unroll
        for (int j = 0; j < 4; ++j) { const int k = k0 + F.lane + 64 * j;
            const float c0 = p.c[k], c1 = p.c[DM + k], c2 = p.c_ctx[k];
            scr[(F.lane + 64 * j) * 3 + 0] = c0 / (1.0f + expf(-c0)); scr[(F.lane + 64 * j) * 3 + 1] = c1 / (1.0f + expf(-c1)); scr[(F.lane + 64 * j) * 3 + 2] = c2 / (1.0f + expf(-c2)); }
        LDS_WAIT(); asm volatile("" ::: "memory");
        f32x4 a0 = {0.f, 0.f, 0.f, 0.f}, a1 = a0, a2 = a0;
        const float* wp = p.w_ada + ((size_t)l * DM + k0) * NMODV + n0;
#pragma unroll 8
        for (int kk = 0; kk < 256; ++kk) { const f32x4 w = *(const GAS f32x4*)(wp + (size_t)kk * NMODV); const float s0 = scr[kk * 3], s1 = scr[kk * 3 + 1], s2 = scr[kk * 3 + 2];
            a0 += w * s0; a1 += w * s1; a2 += w * s2; }
        float* mp = (float*)(p.ws + WS_MODP) + ((size_t)(l * 8 + kb) * 3) * NMODV + n0;
        *(GAS f32x4*)(mp) = a0; *(GAS f32x4*)(mp + NMODV) = a1; *(GAS f32x4*)(mp + 2 * NMODV) = a2;
        LDS_WAIT(); asm volatile("" ::: "memory");
    }
    for (int it = F.gw; it < DEPTH * IT_LAYER; it += F.NGW) {
        const int l = it / IT_LAYER; int r = it % IT_LAYER;
        if (r < IT_IN) { const int nblk = NPROJ_SRC / 32, kb = r / nblk, n0 = 32 * (r % nblk);
            int drow; float cs = 1.0f;
            if (n0 < 6144) { drow = n0; if (n0 < 1024) cs = 0.0625f; } else if (n0 < 6176) drow = CA + (n0 - 6144); else if (n0 < 7200) drow = CP + (n0 - 6176); else drow = CBG + (n0 - 7200);
            transpose_item(p.w_in + (size_t)l * DM * NPROJ_SRC, NPROJ_SRC, 64 * kb, n0, wlayer(p, l, WO_IN), DM, drow, cs, nullptr, scr, F.lane); continue; } r -= IT_IN;
        if (r < IT_GO) { transpose_item(p.w_go + (size_t)l * DM * DM, DM, 64 * (r / 64), 32 * (r % 64), wlayer(p, l, WO_GO), DM, 32 * (r % 64), 1.0f, nullptr, scr, F.lane); continue; } r -= IT_GO;
        if (r < IT_PO) { transpose_item(p.w_po + (size_t)l * DPOOL * DM, DM, 64 * (r / 64), 32 * (r % 64), wlayer(p, l, WO_PO), DPOOL, 32 * (r % 64), 1.0f, p.pool_scale + (size_t)l * DPOOL, scr, F.lane); continue; } r -= IT_PO;
        if (r < IT_OUT) { transpose_item(p.w_out + (size_t)l * DM * DM, DM, 64 * (r / 64), 32 * (r % 64), wlayer(p, l, WO_OUT), DM, 32 * (r % 64), 1.0f, nullptr, scr, F.lane); continue; } r -= IT_OUT;
        if (r < IT_FI) { const int nblk = NFFI / 32, kb = r / nblk, n0 = 32 * (r % nblk), up = n0 >= DFF ? 1 : 0, ch = n0 - up * DFF;
            transpose_item(p.w_fi + (size_t)l * DM * NFFI, NFFI, 64 * kb, n0, wlayer(p, l, WO_FI), DM, 256 * (ch / 128) + 128 * up + (ch % 128), 1.0f, nullptr, scr, F.lane); continue; } r -= IT_FI;
        if (r < IT_FO) { transpose_item(p.w_fo + (size_t)l * DFF * DM, DM, 64 * (r / 64), 32 * (r % 64), wlayer(p, l, WO_FO), DFF, 32 * (r % 64), 1.0f, nullptr, scr, F.lane); continue; } r -= IT_FO;
        if (r < IT_PG) { const int g = r / 32, q = r % 32;
            transpose_item(p.w_pg + ((size_t)l * 4 + g) * 256 * 256, 256, 64 * (q / 8), 32 * (q % 8), wlayer(p, l, WO_PG) + 256 * g, 1024, 256 * g + 32 * (q % 8), 1.0f, nullptr, scr, F.lane); continue; } r -= IT_PG;
        if (r < IT_ZIN) { GAS v4u* zp = (GAS v4u*)(wlayer(p, l, WO_IN) + (size_t)(NPROJ_SRC + r) * DM);
#pragma unroll
            for (int j = 0; j < 4; ++j) zp[F.lane + 64 * j] = (v4u){0u, 0u, 0u, 0u};
            continue; } r -= IT_ZIN;
        { GAS v4u* zp = (GAS v4u*)(wlayer(p, l, WO_PG) + (size_t)r * 1024); const int g = r >> 8;
#pragma unroll
          for (int j = 0; j < 2; ++j) { const int ch = F.lane + 64 * j; if ((ch >> 5) != g) zp[ch] = (v4u){0u, 0u, 0u, 0u}; } }
    }
}
__device__ __forceinline__ void phase_prologue_b(const Frame& F, const Params& p) {
    const float* MP = (const float*)(p.ws + WS_MODP); float* MO = (float*)(p.ws + WS_MOD);
    for (int e = F.vcu * NTHREADS + F.tid; e < DEPTH * 3 * NMODV; e += F.G * NTHREADS) { const int l = e / (3 * NMODV), r = e % (3 * NMODV), n = r % NMODV;
        float s = p.b_ada[(size_t)l * NMODV + n];
#pragma unroll
        for (int kb = 0; kb < 8; ++kb) s += MP[((size_t)(l * 8 + kb) * 3) * NMODV + r];
        MO[e] = s; }
    LAS float* sm = (LAS float*)F.lds;
    for (int e = F.tid; e < 3 * 2 * DM; e += NTHREADS) { const int mi = e / (2 * DM), r = e % (2 * DM);
        float s = p.b_ada[r];
#pragma unroll
        for (int kb = 0; kb < 8; ++kb) s += MP[((size_t)kb * 3 + mi) * NMODV + r];
        sm[e] = s; }
    __syncthreads();
    bf16* H = (bf16*)(p.ws + WS_H);
    for (int row = F.gw; row < MTOT; row += F.NGW) { const int mi = mod_index(row);
        const float* xr = row < MLAT ? p.x + (size_t)row * DM : p.ctx + (size_t)(row - MLAT) * DM;
        const LAS float* sh = sm + mi * 2 * DM; const LAS float* sc = sh + DM;
        GAS unsigned long long* o8 = (GAS unsigned long long*)(H + (size_t)row * DM) + F.lane;
#pragma unroll
        for (int j = 0; j < 8; ++j) { const int c = 4 * F.lane + 256 * j; const f32x4 v = *(const GAS f32x4*)(xr + c);
            const float y0 = v.x * (1.0f + sc[c]) + sh[c], y1 = v.y * (1.0f + sc[c + 1]) + sh[c + 1], y2 = v.z * (1.0f + sc[c + 2]) + sh[c + 2], y3 = v.w * (1.0f + sc[c + 3]) + sh[c + 3];
            o8[64 * j] = (unsigned long long)pk2(y0, y1) | ((unsigned long long)pk2(y2, y3) << 32); } }
    __syncthreads();
}
__device__ __forceinline__ void phase_ln(const Frame& F, const Params& p, int l, int sub, int M) {
    const float* V = (const float*)(p.ws + WS_V); float* X = (float*)(p.ws + WS_X); bf16* H = (bf16*)(p.ws + WS_H);
    const float* gain = (sub == 0 ? p.ln1g : p.ln2g) + (size_t)l * DM; const float* bias = (sub == 0 ? p.ln1b : p.ln2b) + (size_t)l * DM;
    const bool last = (sub == 1 && l == DEPTH - 1);
    const int lm = sub == 0 ? l : l + 1, wsh = sub == 0 ? 3 : 0, wsc = sub == 0 ? 4 : 1;
    for (int row = F.gw; row < M; row += F.NGW) {
        const GAS f32x4* vr = (const GAS f32x4*)(V + (size_t)row * DM) + F.lane;
        f32x4 v[8]; float s = 0.f;
#pragma unroll
        for (int j = 0; j < 8; ++j) { v[j] = vr[64 * j]; s += (v[j].x + v[j].y) + (v[j].z + v[j].w); }
        const float mean = wave_sum(s) * (1.f / DM); float s2 = 0.f;
#pragma unroll
        for (int j = 0; j < 8; ++j) { v[j] = v[j] - mean; s2 += (v[j].x * v[j].x + v[j].y * v[j].y) + (v[j].z * v[j].z + v[j].w * v[j].w); }
        const float rstd = 1.f / sqrtf(wave_sum(s2) * (1.f / DM) + LN_EPS);
#pragma unroll
        for (int j = 0; j < 8; ++j) { const int c = 4 * F.lane + 256 * j; const f32x4 g = *(const GAS f32x4*)(gain + c), b = *(const GAS f32x4*)(bias + c); v[j] = v[j] * rstd * g + b; }
        if (last) { GAS f32x4* o = (GAS f32x4*)(p.out + (size_t)row * DM) + F.lane;
#pragma unroll
            for (int j = 0; j < 8; ++j) o[64 * j] = v[j];
        } else {
            GAS f32x4* xo = (GAS f32x4*)(X + (size_t)row * DM) + F.lane;
            const int mi = mod_index(row); const float* sh = modv(p, lm, mi, wsh); const float* sc = modv(p, lm, mi, wsc);
            GAS unsigned long long* o8 = (GAS unsigned long long*)(H + (size_t)row * DM) + F.lane;
#pragma unroll
            for (int j = 0; j < 8; ++j) { const int c = 4 * F.lane + 256 * j; xo[64 * j] = v[j];
                const f32x4 a = *(const GAS f32x4*)(sc + c), b = *(const GAS f32x4*)(sh + c); const f32x4 y = v[j] * (a + 1.0f) + b;
                o8[64 * j] = (unsigned long long)pk2(y.x, y.y) | ((unsigned long long)pk2(y.z, y.w) << 32); } }
    }
}
__device__ __forceinline__ void phase_pool(const Frame& F, const Params& p, int pass) {
    const bf16* PROJ = (const bf16*)(p.ws + WS_PROJ); float* HM = (float*)(p.ws + WS_HM); bf16* T = (bf16*)(p.ws + WS_T);
    for (int task = F.gw; task < MTOT * 8; task += F.NGW) { const int row = task >> 3, cb = task & 7, c = cb * 128 + 2 * F.lane, g = cb >> 1, w = 2 << g, lo = w >> 1, hi = w - lo - 1;
        int idx, n, stride;
        if (row < MLAT) { const int t = row & (SEQ - 1); if (pass == 0) { idx = t & 63; n = 64; stride = 1; } else { idx = t >> 6; n = 64; stride = 64; } }
        else { const int t = (row - MLAT) & (CTXL - 1); idx = t; n = (pass == 0) ? CTXL : 1; stride = 1; if (pass == 1) idx = 0; }
        const int lower = max(idx - lo, 0), upper = min(idx + hi + 1, n);
        float s0 = 0.f, s1 = 0.f;
        if (pass == 0) { for (int q = lower; q < upper; ++q) { const unsigned wv = *(const GAS unsigned*)(PROJ + (size_t)(row + (q - idx) * stride) * NPROJ + CP + c); s0 += bflo(wv); s1 += bfhi(wv); } }
        else { for (int q = lower; q < upper; ++q) { const f32x2g hv = *(const GAS f32x2g*)(HM + (size_t)(row + (q - idx) * stride) * DPOOL + c); s0 += hv.x; s1 += hv.y; } }
        const float inv = 1.0f / (float)(upper - lower); s0 *= inv; s1 *= inv;
        if (pass == 0) { *(GAS f32x2g*)(HM + (size_t)row * DPOOL + c) = (f32x2g){s0, s1}; }
        else { const unsigned wv = *(const GAS unsigned*)(PROJ + (size_t)row * NPROJ + CP + c); *(GAS unsigned*)(T + (size_t)row * DPOOL + c) = pk2(s0 - bflo(wv), s1 - bfhi(wv)); }
    }
}
__device__ __forceinline__ float log_sigmoid_f(float z) { return fminf(z, 0.f) - log1pf(expf(-fabsf(z))); }
__device__ __forceinline__ void phase_la(const Frame& F, const Params& p, int l) {
    const bf16* PROJ = (const bf16*)(p.ws + WS_PROJ); float* LA = (float*)(p.ws + WS_LA);
    for (int task = F.gw; task < MTOT * 2; task += F.NGW) { const int row = task >> 1, dir = task & 1;
        const bf16* ap = PROJ + (size_t)row * NPROJ + CA + dir * 16; float a[16];
#pragma unroll
        for (int r = 0; r < 16; ++r) a[r] = bf2f(ap[r]);
        const float* wu = p.w_dup + ((size_t)l * 2 + dir) * RANK * 1024; const float* bu = p.b_dup + ((size_t)l * 2 + dir) * 1024;
#pragma unroll
        for (int j = 0; j < 4; ++j) { const int d = 4 * F.lane + 256 * j; f32x4 z = *(const GAS f32x4*)(bu + d);
#pragma unroll
            for (int r = 0; r < 16; ++r) z += *(const GAS f32x4*)(wu + (size_t)r * 1024 + d) * a[r];
            f32x4 o; o.x = log_sigmoid_f(z.x) * 0.0625f; o.y = log_sigmoid_f(z.y) * 0.0625f; o.z = log_sigmoid_f(z.z) * 0.0625f; o.w = log_sigmoid_f(z.w) * 0.0625f;
            *(GAS f32x4*)(LA + ((size_t)dir * MTOT + row) * 1024 + d) = o; } }
}
__device__ __forceinline__ void phase_gla_naive(const Frame& F, const Params& p) {
    const bf16* PROJ = (const bf16*)(p.ws + WS_PROJ); const float* LA = (const float*)(p.ws + WS_LA); float* O = (float*)(p.ws + WS_O);
    for (int it = F.gw; it < NBATCH * NH * HV; it += F.NGW) { const int b = it >> 11, h = (it >> 9) & 3, vcol = it & 511;
        for (int dir = 0; dir < 2; ++dir) {
            float S0 = 0.f, S1 = 0.f, S2 = 0.f, S3 = 0.f;
#pragma unroll 4
            for (int step = 0; step < CTXL + SEQ; ++step) {
                int row; if (step < CTXL) { const int t = dir ? CTXL - 1 - step : step; row = MLAT + b * CTXL + t; } else { const int s2 = step - CTXL; const int t = dir ? SEQ - 1 - s2 : s2; row = b * SEQ + t; }
                const bf16* pr = PROJ + (size_t)row * NPROJ;
                const u32x2g qw = *(const GAS u32x2g*)(pr + CQ + h * HK + 4 * F.lane), kw = *(const GAS u32x2g*)(pr + CK + h * HK + 4 * F.lane);
                const f32x4 la = *(const GAS f32x4*)(LA + ((size_t)dir * MTOT + row) * 1024 + h * HK + 4 * F.lane);
                const float vv = bf2f(pr[CV + h * HV + vcol]);
                S0 = expf(la.x) * S0 + bflo(kw.x) * vv; S1 = expf(la.y) * S1 + bfhi(kw.x) * vv; S2 = expf(la.z) * S2 + bflo(kw.y) * vv; S3 = expf(la.w) * S3 + bfhi(kw.y) * vv;
                const float part = wave_sum((bflo(qw.x) * S0 + bfhi(qw.x) * S1) + (bflo(qw.y) * S2 + bfhi(qw.y) * S3));
                if (F.lane == 0) { float* op = O + (size_t)row * DM + h * HV + vcol; *op = dir ? *op + part : part; }
            }
        }
    }
}
template <int NO> __device__ __forceinline__ void phase_gout(const Frame& F, const Params& p, int l, int M) {
    const bf16* PROJ = (const bf16*)(p.ws + WS_PROJ); const float* O = (const float*)(p.ws + WS_O); bf16* A = (bf16*)(p.ws + WS_AGLA);
    const float* gain = p.gla_gain + (size_t)l * DM;
    for (int task = F.gw; task < M * NH; task += F.NGW) { const int row = task >> 2, h = task & 3, c = h * HV + 8 * F.lane;
        f32x4 o0 = *(const GAS f32x4*)(O + (size_t)row * DM + c), o1 = *(const GAS f32x4*)(O + (size_t)row * DM + c + 4);
        if (NO == 2) { o0 += *(const GAS f32x4*)(O + (size_t)(MTOT + row) * DM + c); o1 += *(const GAS f32x4*)(O + (size_t)(MTOT + row) * DM + c + 4); }
        const float ss = wave_sum((o0.x * o0.x + o0.y * o0.y) + (o0.z * o0.z + o0.w * o0.w) + (o1.x * o1.x + o1.y * o1.y) + (o1.z * o1.z + o1.w * o1.w));
        const float r = 1.0f / sqrtf(ss * (1.0f / HV) + RMS_EPS);
        const f32x4 g0 = *(const GAS f32x4*)(gain + c), g1 = *(const GAS f32x4*)(gain + c + 4);
        const v4u gw = *(const GAS v4u*)(PROJ + (size_t)row * NPROJ + CG + c);
        v4u w; w.x = pk2(o0.x * r * g0.x * bflo(gw.x), o0.y * r * g0.y * bfhi(gw.x)); w.y = pk2(o0.z * r * g0.z * bflo(gw.y), o0.w * r * g0.w * bfhi(gw.y));
        w.z = pk2(o1.x * r * g1.x * bflo(gw.z), o1.y * r * g1.y * bfhi(gw.z)); w.w = pk2(o1.z * r * g1.z * bflo(gw.w), o1.w * r * g1.w * bfhi(gw.w));
        *(GAS v4u*)(A + (size_t)row * DM + c) = w; }
}

typedef float f32x16 __attribute__((ext_vector_type(16)));
__device__ __forceinline__ int swap23(int d) { return (d & ~12) | ((d & 4) << 1) | ((d & 8) >> 1); }
constexpr int PREP_ROW = 528;
constexpr int PREP_QS = 0, PREP_KS = 64 * PREP_ROW, PREP_AL = 2 * 64 * PREP_ROW, PREP_TOT = PREP_AL + 4096;
constexpr int N_PREP_A = NCG * 4 * 2, N_PREP_V = NCG * 4;
constexpr int VT_ROW = 1040;

__device__ __forceinline__ void phase_gla_prep(const Frame& F, const Params& p, int l) {
    const bf16* PROJ = (const bf16*)(p.ws + WS_PROJ);
    bf16* QI = (bf16*)(p.ws + WS_QI); bf16* KST = (bf16*)(p.ws + WS_KST); bf16* PM = (bf16*)(p.ws + WS_PM); float* DCB = (float*)(p.ws + WS_DCB); bf16* VT = (bf16*)(p.ws + WS_VT);
    for (int item = F.vcu; item < N_PREP_A + N_PREP_V; item += F.G) {
        if (item < N_PREP_A) {
            const int cg = item >> 3, h = (item >> 1) & 3, dir = item & 1, r0 = cg * 64;
            LAS float* AL = (LAS float*)(F.lds + PREP_AL); LAS float* TOT = (LAS float*)(F.lds + PREP_TOT);
            LAS unsigned short* QS = (LAS unsigned short*)(F.lds + PREP_QS); LAS unsigned short* KS = (LAS unsigned short*)(F.lds + PREP_KS);
            { const int j = F.tid >> 3, r2 = (F.tid & 7) * 2; const unsigned w = *(const GAS unsigned*)(PROJ + (size_t)(r0 + j) * NPROJ + CA + dir * 16 + r2); AL[j * 16 + r2] = bflo(w); AL[j * 16 + r2 + 1] = bfhi(w); }
            const int d = F.tid & 255, jh = F.tid >> 8;
            float w[16];
#pragma unroll
            for (int r = 0; r < 16; ++r) w[r] = p.w_dup[(((size_t)l * 2 + dir) * RANK + r) * 1024 + h * HK + d];
            const float bz = p.b_dup[((size_t)l * 2 + dir) * 1024 + h * HK + d];
            __syncthreads();
            float ex[32]; float run = 0.f;
#pragma unroll
            for (int jo = 0; jo < 32; ++jo) { const LAS f32x4* a = (const LAS f32x4*)(AL + (jh * 32 + jo) * 16); float z = bz;
#pragma unroll
                for (int r4 = 0; r4 < 4; ++r4) { const f32x4 av = a[r4]; z += av.x * w[4 * r4] + av.y * w[4 * r4 + 1] + av.z * w[4 * r4 + 2] + av.w * w[4 * r4 + 3]; }
                ex[jo] = run; run += log_sigmoid_f(z) * 0.0625f; }
            TOT[jh * 256 + d] = run;
            __syncthreads();
            const float t0 = TOT[d], t1 = TOT[256 + d], tot = run;
            const float first = dir ? t1 : t0;
            const float last = t0 + t1;
            const float off = (jh == dir) ? 0.f : first;
            const float Eref = __expf(first), Elr = __expf(last - first);
            const size_t gi = ((size_t)dir * NCG + cg) * 4 + h;
            if (jh == 0) DCB[gi * 256 + d] = __expf(last);
            unsigned kpack[16];
            const int dq = (d & ~15) + swap23(d & 15);
#pragma unroll
            for (int jo = 0; jo < 32; ++jo) { const int j = jh * 32 + jo;
                const float incl = (jo < 31) ? ex[(jo + 1) & 31] : tot;
                const float cum = (dir ? (tot - ex[jo]) : incl) + off;
                const float x = cum - first, e1 = __expf(x), e2 = __expf(-x);
                const bf16* pr = PROJ + (size_t)(r0 + j) * NPROJ;
                const float q = bf2f(pr[CQ + h * HK + d]), k = bf2f(pr[CK + h * HK + d]);
                const float qin = q * e1, kin = k * e2;
                QS[j * (PREP_ROW / 2) + d] = (unsigned short)f2bf(qin); KS[j * (PREP_ROW / 2) + d] = (unsigned short)f2bf(kin);
                QI[((size_t)dir * MTOT + r0 + j) * 1024 + h * HK + dq] = (bf16)f2bf(qin * Eref);
                const unsigned kb = f2bf(kin * Elr); if (jo & 1) kpack[jo >> 1] |= kb << 16; else kpack[jo >> 1] = kb; }
            { GAS v4u* kp = (GAS v4u*)(KST + (gi * 256 + d) * 64 + jh * 32);
#pragma unroll
              for (int c = 0; c < 4; ++c) kp[c] = (v4u){kpack[4 * c], kpack[4 * c + 1], kpack[4 * c + 2], kpack[4 * c + 3]}; }
            __syncthreads();
            { const int ti = F.wave >> 1, fr = F.lane & 15, fq = F.lane >> 4;
#pragma unroll
              for (int q2 = 0; q2 < 2; ++q2) { const int tj = (F.wave & 1) * 2 + q2; f32x4 acc = {0.f, 0.f, 0.f, 0.f};
#pragma unroll
                for (int ks = 0; ks < 8; ++ks) { const bf16x8 a = *(const LAS bf16x8*)(F.lds + PREP_KS + (16 * tj + fr) * PREP_ROW + (32 * ks + 8 * fq) * 2);
                    const bf16x8 bq = *(const LAS bf16x8*)(F.lds + PREP_QS + (16 * ti + fr) * PREP_ROW + (32 * ks + 8 * fq) * 2);
                    acc = __builtin_amdgcn_mfma_f32_16x16x32_bf16(a, bq, acc, 0, 0, 0); }
                const int i = 16 * ti + fr, j0 = 16 * tj + 4 * fq; float v[4];
#pragma unroll
                for (int reg = 0; reg < 4; ++reg) { const int j = j0 + reg; const bool keep = dir ? (j >= i) : (j <= i); v[reg] = keep ? acc[reg] : 0.f; }
                *(GAS u32x2g*)(PM + (gi * 64 + i) * 64 + j0) = (u32x2g){pk2(v[0], v[1]), pk2(v[2], v[3])}; } }
            __syncthreads();
        } else {
            const int it = item - N_PREP_A, cg = it >> 2, h = it & 3, r0 = cg * 64;
#pragma unroll
            for (int k = 0; k < 8; ++k) { const int id = F.tid + NTHREADS * k, row = id >> 6, c = id & 63;
                const v4u x = *(const GAS v4u*)(PROJ + (size_t)(r0 + row) * NPROJ + CV + h * HV + 8 * c); *(LAS v4u*)(F.lds + row * VT_ROW + 16 * c) = x; }
            __syncthreads();
#pragma unroll
            for (int k = 0; k < 8; ++k) { const int id = F.tid + NTHREADS * k, v = id & 511, jb = id >> 9; unsigned e[8];
#pragma unroll
                for (int jj = 0; jj < 8; ++jj) e[jj] = *(const LAS unsigned short*)(F.lds + (8 * jb + jj) * VT_ROW + 2 * v);
                *(GAS v4u*)(VT + (((size_t)cg * 4 + h) * 512 + v) * 64 + 8 * jb) = (v4u){e[0] | (e[1] << 16), e[2] | (e[3] << 16), e[4] | (e[5] << 16), e[6] | (e[7] << 16)}; }
            __syncthreads();
        }
    }
}

#define MFMA32(a, b, c) __builtin_amdgcn_mfma_f32_32x32x16_bf16((a), (b), (c), 0, 0, 0)
__device__ __forceinline__ bf16x8 pack_step(const f32x16& x, int s) {
    v4u pk;
    asm volatile("v_cvt_pk_bf16_f32 %0, %4, %5\n\tv_cvt_pk_bf16_f32 %1, %6, %7\n\tv_cvt_pk_bf16_f32 %2, %8, %9\n\tv_cvt_pk_bf16_f32 %3, %10, %11\n\ts_nop 1"
                 : "=&v"(pk[0]), "=&v"(pk[1]), "=&v"(pk[2]), "=&v"(pk[3])
                 : "v"(x[8 * s]), "v"(x[8 * s + 1]), "v"(x[8 * s + 2]), "v"(x[8 * s + 3]), "v"(x[8 * s + 4]), "v"(x[8 * s + 5]), "v"(x[8 * s + 6]), "v"(x[8 * s + 7]));
    return __builtin_bit_cast(bf16x8, pk);
}
constexpr int SC_RING = 0, SC_EX = 65536, SC_EXSZ = 13312, SC_OST = SC_EX + 2 * SC_EXSZ;
static_assert(SC_OST + 8192 <= RING_BYTES, "scan LDS map");
__device__ __forceinline__ void glds16(const unsigned char* ws, unsigned off, LAS unsigned char* l) { __builtin_amdgcn_global_load_lds((const unsigned*)(ws + off), (LAS unsigned*)l, 16, 0, 0); }
__device__ __forceinline__ int scan_chunk(int n, int b, int dir) { n = n > 67 ? 67 : n; return n < 4 ? 128 + 4 * b + (dir ? 3 - n : n) : 64 * b + (dir ? 67 - n : n - 4); }
#define SC_WAIT_V(n) asm volatile("s_waitcnt vmcnt(" #n ")" ::: "memory")
#define SC_FENCE() asm volatile("" ::: "memory")

__device__ __forceinline__ void phase_gla_scan(const Frame& F, const Params& p) {
    if (F.wave != 0) return;
    const int item = F.vcu; if (item >= 256) return;
    const int g16 = item >> 4, vs = item & 15, b = g16 >> 3, h = (g16 >> 1) & 3, dir = g16 & 1;
    const int lane = F.lane, r = lane & 31, hh = lane >> 5;
    LAS unsigned char* lds = F.lds; const unsigned char* ws = p.ws;
    const unsigned QI0 = (unsigned)(WS_QI + ((size_t)dir * MTOT * 1024 + h * HK) * 2), KST0 = (unsigned)(WS_KST + ((size_t)dir * NCG * 4 + h) * 32768);
    const unsigned PM0 = (unsigned)(WS_PM + ((size_t)dir * NCG * 4 + h) * 8192), DC0 = (unsigned)(WS_DCB + ((size_t)dir * NCG * 4 + h) * 1024), VT0 = (unsigned)(WS_VT + ((size_t)h * 512 + vs * 32) * 128);
    const unsigned O0 = (unsigned)(WS_O + ((size_t)dir * MTOT * DM + h * HV + vs * 32) * 4);
    const unsigned qoff0 = (unsigned)((lane >> 2) * 2048 + 16 * ((lane & 3) ^ ((lane >> 4) & 3)));
    const unsigned koffe = (unsigned)((lane >> 3) * 128 + 16 * ((lane & 7) ^ ((lane >> 4) & 3))), koffo = (unsigned)((lane >> 3) * 128 + 16 * ((lane & 7) ^ (((lane >> 4) & 3) + 4)));
    const unsigned doff = (unsigned)lane * 16u;
    const int xq = (r >> 2) & 3, xk = (r >> 1) & 7;
#define SC_ISSUE_S(cgx, t) do { const unsigned qb_ = QI0 + (unsigned)(cgx) * 131072u + (t) * 64, kb_ = KST0 + (unsigned)(cgx) * 131072u + (t) * 4096; \
        _Pragma("unroll") for (int k_ = 0; k_ < 4; ++k_) glds16(ws, qb_ + k_ * 32768 + qoff0, lds + SC_RING + (t) * 8192 + k_ * 1024); \
        _Pragma("unroll") for (int k_ = 0; k_ < 4; ++k_) glds16(ws, kb_ + k_ * 1024 + ((k_ & 1) ? koffo : koffe), lds + SC_RING + (t) * 8192 + 4096 + k_ * 1024); } while (0)
#define SC_ISSUE_E(cgx, par) do { LAS unsigned char* e_ = lds + SC_EX + (par) * SC_EXSZ; const unsigned pb_ = PM0 + (unsigned)(cgx) * 32768u, vb_ = VT0 + (unsigned)(cgx) * 262144u, db_ = DC0 + (unsigned)(cgx) * 4096u; \
        _Pragma("unroll") for (int k_ = 0; k_ < 8; ++k_) glds16(ws, pb_ + k_ * 1024 + ((k_ & 1) ? koffo : koffe), e_ + k_ * 1024); \
        _Pragma("unroll") for (int k_ = 0; k_ < 4; ++k_) glds16(ws, vb_ + k_ * 1024 + ((k_ & 1) ? koffo : koffe), e_ + 8192 + k_ * 1024); \
        glds16(ws, db_ + doff, e_ + 12288); } while (0)
    f32x16 S[8], o0, o1;
#pragma unroll
    for (int t = 0; t < 8; ++t)
#pragma unroll
        for (int i = 0; i < 16; ++i) S[t][i] = 0.f;
#pragma unroll
    for (int i = 0; i < 16; ++i) { o0[i] = 0.f; o1[i] = 0.f; }
#define SC_DSTAGE(t, E) do { const LAS unsigned char* sl_ = lds + SC_RING + (t) * 8192; \
        { const bf16x8 qa00 = *(const LAS bf16x8*)(sl_ + r * 64 + 16 * ((0 + hh) ^ xq)), qa01 = *(const LAS bf16x8*)(sl_ + r * 64 + 16 * ((2 + hh) ^ xq)); \
          const bf16x8 qa10 = *(const LAS bf16x8*)(sl_ + (32 + r) * 64 + 16 * ((0 + hh) ^ xq)), qa11 = *(const LAS bf16x8*)(sl_ + (32 + r) * 64 + 16 * ((2 + hh) ^ xq)); \
          const bf16x8 sp0 = pack_step(S[t], 0), sp1 = pack_step(S[t], 1); \
          o0 = MFMA32(qa00, sp0, o0); o1 = MFMA32(qa10, sp0, o1); o0 = MFMA32(qa01, sp1, o0); o1 = MFMA32(qa11, sp1, o1); } \
        SC_FENCE(); \
        _Pragma("unroll") for (int g = 0; g < 4; ++g) { const f32x4 dc_ = *(const LAS f32x4*)((E) + 12288 + (32 * (t) + 8 * g + 4 * hh) * 4); \
            S[t][4 * g] *= dc_.x; S[t][4 * g + 1] *= dc_.y; S[t][4 * g + 2] *= dc_.z; S[t][4 * g + 3] *= dc_.w; } \
        SC_FENCE(); \
        _Pragma("unroll") for (int s4 = 0; s4 < 4; ++s4) { const bf16x8 ka_ = *(const LAS bf16x8*)(sl_ + 4096 + r * 128 + 16 * ((2 * s4 + hh) ^ xk)); const bf16x8 vb_ = *(const LAS bf16x8*)((E) + 8192 + r * 128 + 16 * ((2 * s4 + hh) ^ xk)); S[t] = MFMA32(ka_, vb_, S[t]); } \
        SC_FENCE(); } while (0)

    int cg = scan_chunk(0, b, dir);
    SC_ISSUE_E(cg, 0); SC_ISSUE_S(cg, 0); SC_ISSUE_S(cg, 1); SC_ISSUE_S(cg, 2); SC_ISSUE_S(cg, 3);
    for (int n = 0; n < 68; ++n) {
        const int par = n & 1, cgn = scan_chunk(n + 1, b, dir);
        const LAS unsigned char* E = lds + SC_EX + par * SC_EXSZ;
        SC_ISSUE_S(cg, 4); SC_WAIT_V(32);
        SC_DSTAGE(0, E);
        SC_ISSUE_S(cg, 5); SC_WAIT_V(32); SC_DSTAGE(1, E);
        SC_ISSUE_S(cg, 6); SC_WAIT_V(32); SC_DSTAGE(2, E);
        SC_ISSUE_S(cg, 7); SC_WAIT_V(32); SC_DSTAGE(3, E);
        SC_ISSUE_E(cgn, par ^ 1); SC_WAIT_V(37); SC_DSTAGE(4, E);
        SC_ISSUE_S(cgn, 0); SC_WAIT_V(37); SC_DSTAGE(5, E);
        SC_ISSUE_S(cgn, 1); SC_WAIT_V(37); SC_DSTAGE(6, E);
        SC_ISSUE_S(cgn, 2); SC_WAIT_V(37); SC_DSTAGE(7, E);
        SC_ISSUE_S(cgn, 3);
#pragma unroll
        for (int s4 = 0; s4 < 4; ++s4) { const bf16x8 pa0 = *(const LAS bf16x8*)(E + r * 128 + 16 * ((2 * s4 + hh) ^ xk)), pa1 = *(const LAS bf16x8*)(E + (32 + r) * 128 + 16 * ((2 * s4 + hh) ^ xk));
            const bf16x8 vb = *(const LAS bf16x8*)(E + 8192 + r * 128 + 16 * ((2 * s4 + hh) ^ xk)); o0 = MFMA32(pa0, vb, o0); o1 = MFMA32(pa1, vb, o1); }
        SC_FENCE();
        { LAS float* ost = (LAS float*)(lds + SC_OST);
#pragma unroll
          for (int i = 0; i < 16; ++i) { const int row = 8 * (i >> 2) + 4 * hh + (i & 3); ost[row * 32 + r] = o0[i]; ost[(32 + row) * 32 + r] = o1[i]; o0[i] = 0.f; o1[i] = 0.f; }
          asm volatile("s_waitcnt lgkmcnt(0)" ::: "memory");
          const unsigned ob = O0 + (unsigned)cg * (64u * DM * 4u) + (unsigned)((lane >> 3) * (DM * 4) + 16 * (lane & 7));
#pragma unroll
          for (int k = 0; k < 8; ++k) { const f32x4 v = *(const LAS f32x4*)(ost + (8 * k + (lane >> 3)) * 32 + 4 * (lane & 7)); *(GAS f32x4*)(ws + ob + (unsigned)(k * 8 * DM * 4)) = v; }
          asm volatile("s_waitcnt lgkmcnt(0)" ::: "memory"); }
        cg = cgn;
    }
    SC_WAIT_V(0);
#undef SC_ISSUE_S
#undef SC_ISSUE_E
#undef SC_DSTAGE
}

enum { PH_PRO_A = 0, PH_PRO_B, PH_WIN, PH_LA, PH_GLA, PH_GOUT, PH_POOL0, PH_POOL1, PH_PGRP, PH_PPO, PH_GO, PH_WOUT, PH_LN0, PH_FFI, PH_FFO, PH_LN1, PH_COUNT };

template <int PH> __device__ __forceinline__ void run_phase(const Frame& F0, const Params& p0, int l) {
    Frame F = F0; asm volatile("" : "+v"(F.tid));
    F.lane = F.tid & 63; F.wave = __builtin_amdgcn_readfirstlane(F.tid >> 6); F.gw = F.vcu * NWAVES + F.wave;
    Params p = p0; asm volatile("" : "+s"(p.ws));
    const int M = (l == DEPTH - 1) ? MLAT : MTOT;
    bf16* H = (bf16*)(p.ws + WS_H); bf16* PROJ = (bf16*)(p.ws + WS_PROJ); bf16* ACT = (bf16*)(p.ws + WS_ACT); float* X = (float*)(p.ws + WS_X); float* V = (float*)(p.ws + WS_V);
    bf16* AGLA = (bf16*)(p.ws + WS_AGLA); bf16* T = (bf16*)(p.ws + WS_T); bf16* U = (bf16*)(p.ws + WS_U); float* TEMP = (float*)(p.ws + WS_TEMP); bf16* MRG = (bf16*)(p.ws + WS_MRG);
    pg8::StaticOrder S;
    if constexpr (PH == PH_PRO_A) phase_prologue_a(F, p);
    if constexpr (PH == PH_PRO_B) phase_prologue_b(F, p);
    if constexpr (PH == PH_WIN) { pg8::Gemm g{H, wlayer(p, l, WO_IN), MTOT, NPROJ, DM}; S.init(MTOT, NPROJ, F.G, (int)blockIdx.x); EpiProj E{PROJ};
        pg8::gemm_phase<EpiProj, pg8::StaticOrder, true, true>(F.lds, g, S, E); }
    if constexpr (PH == PH_LA) phase_gla_prep(F, p, l);
    if constexpr (PH == PH_GLA) phase_gla_scan(F, p);
    if constexpr (PH == PH_GOUT) phase_gout<2>(F, p, l, M);
    if constexpr (PH == PH_POOL0) phase_pool(F, p, 0);
    if constexpr (PH == PH_POOL1) phase_pool(F, p, 1);
    if constexpr (PH == PH_PGRP) { pg8::Gemm g{T, wlayer(p, l, WO_PG), M, 1024, 1024}; S.init(M, 1024, F.G, (int)blockIdx.x); EpiBf16Plain E{U, 1024};
        pg8::gemm_phase<EpiBf16Plain, pg8::StaticOrder, true, true>(F.lds, g, S, E); }
    if constexpr (PH == PH_PPO) { pg8::Gemm g{U, wlayer(p, l, WO_PO), M, DM, DPOOL}; S.init(M, DM, F.G, (int)blockIdx.x); EpiGateTemp E{TEMP, PROJ};
        pg8::gemm_phase<EpiGateTemp, pg8::StaticOrder, true, true>(F.lds, g, S, E); }
    if constexpr (PH == PH_GO) { pg8::Gemm g{AGLA, wlayer(p, l, WO_GO), M, DM, DM}; S.init(M, DM, F.G, (int)blockIdx.x); EpiMerge E{MRG, TEMP, PROJ};
        pg8::gemm_phase<EpiMerge, pg8::StaticOrder, true, true>(F.lds, g, S, E); }
    if constexpr (PH == PH_WOUT) { pg8::Gemm g{MRG, wlayer(p, l, WO_OUT), M, DM, DM}; S.init(M, DM, F.G, (int)blockIdx.x);
        EpiResid E{V, l == 0 ? p.x : X, l == 0 ? p.ctx : X + (size_t)MLAT * DM, modv(p, l, 0, 2)};
        pg8::gemm_phase<EpiResid, pg8::StaticOrder, true, true>(F.lds, g, S, E); }
    if constexpr (PH == PH_LN0) phase_ln(F, p, l, 0, M);
    if constexpr (PH == PH_FFI) { pg8::Gemm g{H, wlayer(p, l, WO_FI), M, NFFI, DM}; S.init(M, NFFI, F.G, (int)blockIdx.x); EpiSwiglu E{ACT};
        pg8::gemm_phase<EpiSwiglu, pg8::StaticOrder, true, true>(F.lds, g, S, E); }
    if constexpr (PH == PH_FFO) { pg8::Gemm g{ACT, wlayer(p, l, WO_FO), M, DM, DFF}; S.init(M, DM, F.G, (int)blockIdx.x);
        EpiResid E{V, X, X + (size_t)MLAT * DM, modv(p, l, 0, 5)};
        pg8::gemm_phase<EpiResid, pg8::StaticOrder, true, true>(F.lds, g, S, E); }
    if constexpr (PH == PH_LN1) phase_ln(F, p, l, 1, M);
}
__device__ __forceinline__ Frame make_frame(unsigned char* lds) {
    Frame F; F.lds = (LAS unsigned char*)lds; F.tid = threadIdx.x; F.lane = F.tid & 63; F.wave = __builtin_amdgcn_readfirstlane(F.tid >> 6);
    F.G = gridDim.x; const int bx = blockIdx.x; F.vcu = (F.G % 8 == 0) ? (bx % 8) * (F.G / 8) + bx / 8 : bx; F.gw = F.vcu * NWAVES + F.wave; F.NGW = F.G * NWAVES;
    return F;
}

constexpr int CW_BAR = 4096;
#define PHASE(ph, l) do { run_phase<ph>(F, p, (l)); xcd_barrier(bar); } while (0)
__global__ void __launch_bounds__(NTHREADS, 2) k_mega(Params p) {
    extern __shared__ __attribute__((aligned(16))) unsigned char lds[];
    const Frame F = make_frame(lds);
    for (int u = F.tid; u < (LDS_BYTES - RING_BYTES) / 4; u += NTHREADS) ((LAS unsigned*)(F.lds + RING_BYTES))[u] = 0u;
    __syncthreads();
    const XcdBarrier bar = xcd_barrier_post((unsigned*)(p.ws + WS_CTL) + CW_BAR, (volatile LAS unsigned*)(F.lds + MISC_OFF) + 8);
    PHASE(PH_PRO_A, 0);
    PHASE(PH_PRO_B, 0);
    for (int l = 0; l < DEPTH; ++l) {
        PHASE(PH_WIN, l);
        PHASE(PH_LA, l);
        PHASE(PH_GLA, l);
        PHASE(PH_GOUT, l);
        PHASE(PH_POOL0, l);
        PHASE(PH_POOL1, l);
        PHASE(PH_PGRP, l);
        PHASE(PH_PPO, l);
        PHASE(PH_GO, l);
        PHASE(PH_WOUT, l);
        PHASE(PH_LN0, l);
        PHASE(PH_FFI, l);
        PHASE(PH_FFO, l);
        if (l < DEPTH - 1) PHASE(PH_LN1, l); else run_phase<PH_LN1>(F, p, l);
    }
}

extern "C" void kernel_launch(void* const* d_in, const int* in_sizes, int n_in, void* d_out, int out_size, void* d_ws, size_t ws_size, hipStream_t stream) {
    static int grid = 0;
    if (grid == 0) {
        if (n_in != 21 || out_size != MLAT * DM || ws_size < WS_END) { fprintf(stderr, "kernel_launch: unexpected problem (n_in %d, out %d, ws %zu, need %zu)\n", n_in, out_size, ws_size, (size_t)WS_END); grid = -1; return; }
        int dev = 0, cus = 0, per_cu = 0;
        if (hipGetDevice(&dev) != hipSuccess || hipDeviceGetAttribute(&cus, hipDeviceAttributeMultiprocessorCount, dev) != hipSuccess) { grid = -1; return; }
        if (hipFuncSetAttribute((const void*)k_mega, hipFuncAttributeMaxDynamicSharedMemorySize, LDS_BYTES) != hipSuccess) { fprintf(stderr, "kernel_launch: hipFuncSetAttribute failed\n"); grid = -1; return; }
        if (hipOccupancyMaxActiveBlocksPerMultiprocessor(&per_cu, (const void*)k_mega, NTHREADS, LDS_BYTES) != hipSuccess || per_cu < 1) fprintf(stderr, "kernel_launch: occupancy query reports %d workgroups per CU\n", per_cu);
        (void)hipGetLastError();
        grid = cus;
    }
    if (grid < 0) return;
    (void)hipMemsetAsync((char*)d_ws + WS_CTL, 0, CTL_BYTES, stream);
    Params p{};
    const float** pp = (const float**)&p;
    for (int i = 0; i < 21; ++i) pp[i] = (const float*)d_in[i];
    p.out = (float*)d_out; p.ws = (unsigned char*)d_ws; p.layer = 0; p.pad = 0;
    hipLaunchKernelGGL(k_mega, dim3(grid), dim3(NTHREADS), LDS_BYTES, stream, p);
}
```

```cpp
#include <hip/hip_runtime.h>
#include <cstdio>
#include <cstdint>
namespace pg8 {
#define PG8_LAS __attribute__((address_space(3)))
typedef unsigned short bf16_t;
typedef short bf16x8 __attribute__((ext_vector_type(8)));
typedef float f32x4 __attribute__((ext_vector_type(4)));
typedef unsigned u32x4 __attribute__((ext_vector_type(4)));
constexpr int BM = 256, BK = 64, HALF = 128, HTB = HALF * BK * 2  , STAGE_BYTES = 8 * HTB, NXCD = 8, WGM = 8;

__host__ __device__ __forceinline__ int lds_byte(int r, int c) { const int st = (r >> 4) * 2 + (c >> 5), rr = r & 15, cc = c & 31, ob = rr * 64 + cc * 2; return st * 1024 + (ob ^ (((ob >> 9) & 1) << 5)); }
__host__ __device__ __forceinline__ void stage_rc(int b, int& R, int& C) { const int st = b / 1024, sb = b % 1024, swz = sb ^ (((sb >> 9) & 1) << 5); R = (st >> 1) * 16 + swz / 64; C = (st & 1) * 32 + (swz % 64) / 2; }
__host__ __device__ __forceinline__ int perm32(int rho) { const int n = rho >> 4, i = rho & 15; return 8 * (i >> 2) + 4 * n + (i & 3); }

struct Unit { int pm, pn; };
struct Gemm { const bf16_t* A; const bf16_t* Bt; int M, N, K; };

struct StaticOrder {
    int nM, nN, nwg, G, c;
    __host__ __device__ void init(int M, int N, int G_, int c_) { nM = M / BM; nN = N / BM; nwg = nM * nN; G = G_; c = c_; }
    __host__ __device__ bool next(int i, Unit& u) const {
        const long L = (long)i * G + c; if (L >= nwg) return false;
        int wgid = (int)L; { const int q = nwg / NXCD, r = nwg % NXCD, xcd = wgid % NXCD, off = wgid / NXCD; wgid = (xcd < r ? xcd * (q + 1) : r * (q + 1) + (xcd - r) * q) + off; }
        const int nig = WGM * nN, gid = wgid / nig, fm = gid * WGM, gsz = (nM - fm) < WGM ? (nM - fm) : WGM;
        u.pm = fm + ((wgid % nig) % gsz); u.pn = (wgid % nig) / gsz; return true;
    }
    __device__ __forceinline__ void a_ready(const Unit&) const {}
    __device__ __forceinline__ void done(const Unit&) const {}
};
__device__ __forceinline__ unsigned cvt_pk_bf16(float lo, float hi) { unsigned r; asm volatile("v_cvt_pk_bf16_f32 %0, %1, %2" : "=v"(r) : "v"(lo), "v"(hi)); return r; }
template <class Epi, class Sched, bool ALIGN_EPI = false, bool SP2 = false>
__device__ __forceinline__ void gemm_phase(PG8_LAS unsigned char* lds, const Gemm g, const Sched& S, const Epi& E) {
    int tid_ = threadIdx.x; asm volatile("" : "+v"(tid_));
    const int tid = tid_, wid = __builtin_amdgcn_readfirstlane(tid >> 6), lane = tid & 63, wr = wid >> 2, wc = wid & 3, fr = lane & 15, fq = lane >> 4;
    const int K = g.K, nt = K / BK;
    unsigned voffA[2], voffB[2];
#pragma unroll
    for (int i = 0; i < 2; ++i) { int R, C; stage_rc(tid * 16 + i * 8192, R, C); const int Rb = Epi::PERM ? ((R & ~31) + perm32(R & 31)) : R;
        voffA[i] = (unsigned)(R * K + C) * 2u; voffB[i] = (unsigned)(Rb * K + C) * 2u; }
    const size_t kstep = (size_t)(BK * 2);
    const size_t hstep = (size_t)HALF * K * 2;
    const size_t tstep = 2 * hstep;
    const unsigned ldsw = (unsigned)wid * 1024u;
    const int aoff = lds_byte(wr * 64 + fr, fq * 8), boff = lds_byte(wc * 32 + fr, fq * 8);
#define PG8_SA(b, h) (((b) * 2 + (h)) * HTB)
#define PG8_SB(b, h) ((4 + (b) * 2 + (h)) * HTB)
#define PG8_STAGE(bufoff, gbase, voff) do { _Pragma("unroll") for (int _i = 0; _i < 2; ++_i) \
        __builtin_amdgcn_global_load_lds((const unsigned*)((const char*)(gbase) + (voff)[_i]), (PG8_LAS unsigned*)(lds + (bufoff) + ldsw + _i * 8192), 16, 0, 0); } while (0)
#define PG8_LDA(dst, b, h) do { _Pragma("unroll") for (int m = 0; m < 4; ++m) _Pragma("unroll") for (int k = 0; k < 2; ++k) dst[m][k] = *(const PG8_LAS bf16x8*)(lds + PG8_SA(b, h) + aoff + m * 2048 + k * 1024); } while (0)
#define PG8_LDB(dst, b, h) do { _Pragma("unroll") for (int n = 0; n < 2; ++n) _Pragma("unroll") for (int k = 0; k < 2; ++k) dst[n][k] = *(const PG8_LAS bf16x8*)(lds + PG8_SB(b, h) + boff + n * 2048 + k * 1024); } while (0)
#define PG8_MMA(ai, bj, At, Bt) do { __builtin_amdgcn_s_setprio(1); _Pragma("unroll") for (int m = 0; m < 4; ++m) _Pragma("unroll") for (int n = 0; n < 2; ++n) _Pragma("unroll") for (int k = 0; k < 2; ++k) \
        acc[ai][bj][m][n] = __builtin_amdgcn_mfma_f32_16x16x32_bf16(Bt[n][k], At[m][k], acc[ai][bj][m][n], 0, 0, 0); __builtin_amdgcn_s_setprio(0); } while (0)
#define PG8_WAIT_V(n) asm volatile("s_waitcnt vmcnt(" #n ")" ::: "memory")
#define PG8_WAIT_L(n) asm volatile("s_waitcnt lgkmcnt(" #n ")" ::: "memory")
#define PG8_BAR __builtin_amdgcn_s_barrier()
#define PG8_SCHED __builtin_amdgcn_sched_barrier(0)
    Unit cur, nxt; int ui = 0;
    if (!S.next(0, cur)) return;
    f32x4 acc[2][2][4][2];
#pragma unroll
    for (int a = 0; a < 2; ++a)
#pragma unroll
        for (int b = 0; b < 2; ++b)
#pragma unroll
            for (int m = 0; m < 4; ++m)
#pragma unroll
                for (int n = 0; n < 2; ++n) acc[a][b][m][n] = (f32x4){0.f, 0.f, 0.f, 0.f};
    bf16x8 At[4][2], B0[2][2], B1[2][2];
    const char* cA = (const char*)g.A + (size_t)cur.pm * tstep; const char* cB = (const char*)g.Bt + (size_t)cur.pn * tstep;
    S.a_ready(cur);
    if constexpr (SP2) {
        PG8_STAGE(PG8_SB(0, 0), cB, voffB); PG8_STAGE(PG8_SB(0, 1), cB + hstep, voffB); PG8_STAGE(PG8_SA(0, 0), cA, voffA); PG8_STAGE(PG8_SA(0, 1), cA + hstep, voffA);
        if (wr == 1) PG8_BAR;
        PG8_WAIT_V(2); PG8_BAR;
        PG8_STAGE(PG8_SB(1, 0), cB + kstep, voffB); PG8_STAGE(PG8_SA(1, 0), cA + kstep, voffA); PG8_STAGE(PG8_SB(1, 1), cB + hstep + kstep, voffB);
        PG8_WAIT_V(6); PG8_BAR;
    } else {
        PG8_STAGE(PG8_SB(0, 0), cB, voffB); PG8_STAGE(PG8_SA(0, 0), cA, voffA); PG8_STAGE(PG8_SB(0, 1), cB + hstep, voffB); PG8_STAGE(PG8_SA(0, 1), cA + hstep, voffA);
        if (wr == 1) PG8_BAR;
        PG8_WAIT_V(4); PG8_BAR;
        PG8_STAGE(PG8_SB(1, 0), cB + kstep, voffB); PG8_STAGE(PG8_SA(1, 0), cA + kstep, voffA); PG8_STAGE(PG8_SB(1, 1), cB + hstep + kstep, voffB);
        PG8_WAIT_V(6); PG8_BAR;
    }
    for (;;) {
        const bool has_next = S.next(ui + 1, nxt);
        const char* nA = has_next ? (const char*)g.A + (size_t)nxt.pm * tstep : cA; const char* nB = has_next ? (const char*)g.Bt + (size_t)nxt.pn * tstep : cB;
        for (int t = 0; t < nt; t += 2) {
            const bool last = (t == nt - 2);
            const char* a1 = cA + (size_t)(t + 1) * kstep;
            const char* a2 = last ? nA : cA + (size_t)(t + 2) * kstep; const char* b2 = last ? nB : cB + (size_t)(t + 2) * kstep;
            const char* a3 = a2 + kstep; const char* b3 = b2 + kstep;
            if (last && has_next) S.a_ready(nxt);
            if constexpr (SP2) {
            PG8_LDB(B0, 0, 0); PG8_LDB(B1, 0, 1); PG8_SCHED; PG8_LDA(At, 0, 0); PG8_STAGE(PG8_SA(1, 1), a1 + hstep, voffA);
            PG8_WAIT_V(8); PG8_WAIT_L(0); PG8_BAR; PG8_MMA(0, 0, At, B0); PG8_MMA(0, 1, At, B1); PG8_BAR; PG8_SCHED;
            PG8_LDA(At, 0, 1); PG8_STAGE(PG8_SB(0, 0), b2, voffB); PG8_STAGE(PG8_SB(0, 1), b2 + hstep, voffB); PG8_STAGE(PG8_SA(0, 0), a2, voffA);
            PG8_WAIT_V(8); PG8_WAIT_L(0); PG8_BAR; PG8_MMA(1, 0, At, B0); PG8_MMA(1, 1, At, B1); PG8_BAR; PG8_SCHED;
            PG8_LDB(B0, 1, 0); PG8_LDB(B1, 1, 1); PG8_SCHED; PG8_LDA(At, 1, 0); PG8_STAGE(PG8_SA(0, 1), a2 + hstep, voffA);
            PG8_WAIT_V(8); PG8_WAIT_L(0); PG8_BAR; PG8_MMA(0, 0, At, B0); PG8_MMA(0, 1, At, B1); PG8_BAR; PG8_SCHED;
            PG8_LDA(At, 1, 1); PG8_STAGE(PG8_SB(1, 0), b3, voffB); PG8_STAGE(PG8_SB(1, 1), b3 + hstep, voffB); PG8_STAGE(PG8_SA(1, 0), a3, voffA);
            PG8_WAIT_V(8); PG8_WAIT_L(0); PG8_BAR; PG8_MMA(1, 0, At, B0); PG8_MMA(1, 1, At, B1); PG8_BAR; PG8_SCHED;
            } else {
            PG8_LDB(B0, 0, 0); PG8_SCHED; PG8_LDA(At, 0, 0); PG8_STAGE(PG8_SA(1, 1), a1 + hstep, voffA);
            PG8_WAIT_L(8); PG8_BAR; PG8_WAIT_L(0); PG8_MMA(0, 0, At, B0); PG8_BAR; PG8_SCHED;
            PG8_LDB(B1, 0, 1); PG8_STAGE(PG8_SB(0, 0), b2, voffB);
            PG8_BAR; PG8_WAIT_L(0); PG8_MMA(0, 1, At, B1); PG8_BAR;
            PG8_LDA(At, 0, 1); PG8_STAGE(PG8_SA(0, 0), a2, voffA);
            PG8_BAR; PG8_WAIT_L(0); PG8_MMA(1, 0, At, B0); PG8_BAR; PG8_SCHED;
            PG8_STAGE(PG8_SB(0, 1), b2 + hstep, voffB);
            PG8_WAIT_V(6); PG8_BAR; PG8_MMA(1, 1, At, B1); PG8_BAR;
            PG8_LDB(B0, 1, 0); PG8_SCHED; PG8_LDA(At, 1, 0); PG8_STAGE(PG8_SA(0, 1), a2 + hstep, voffA);
            PG8_WAIT_L(8); PG8_BAR; PG8_WAIT_L(0); PG8_MMA(0, 0, At, B0); PG8_BAR; PG8_SCHED;
            PG8_LDB(B1, 1, 1); PG8_STAGE(PG8_SB(1, 0), b3, voffB);
            PG8_BAR; PG8_WAIT_L(0); PG8_MMA(0, 1, At, B1); PG8_BAR;
            PG8_LDA(At, 1, 1); PG8_STAGE(PG8_SA(1, 0), a3, voffA);
            PG8_BAR; PG8_WAIT_L(0); PG8_MMA(1, 0, At, B0); PG8_BAR; PG8_SCHED;
            PG8_STAGE(PG8_SB(1, 1), b3 + hstep, voffB);
            PG8_WAIT_V(6); PG8_BAR; PG8_MMA(1, 1, At, B1); PG8_BAR;
            }
        }
        if constexpr (ALIGN_EPI) { if (wr == 0) PG8_BAR; }
        if constexpr (!Epi::AFTER_DRAIN) { E(acc, cur, wr, wc, fr, fq); S.done(cur); }
        if (!has_next) break;
#pragma unroll
        for (int a = 0; a < 2; ++a)
#pragma unroll
            for (int b = 0; b < 2; ++b)
#pragma unroll
                for (int m = 0; m < 4; ++m)
#pragma unroll
                    for (int n = 0; n < 2; ++n) acc[a][b][m][n] = (f32x4){0.f, 0.f, 0.f, 0.f};
        cur = nxt; cA = nA; cB = nB; ++ui;
        if constexpr (ALIGN_EPI) { if (wr == 1) PG8_BAR; }
    }
    PG8_WAIT_V(0);
    if constexpr (!ALIGN_EPI) { if (wr == 0) PG8_BAR; }
    PG8_BAR;
    if constexpr (Epi::AFTER_DRAIN) { E.fused(acc, cur, wr, wc, fr, fq, lds, wid, lane); S.done(cur); }
#undef PG8_SA
#undef PG8_SB
#undef PG8_STAGE
#undef PG8_LDA
#undef PG8_LDB
#undef PG8_MMA
#undef PG8_WAIT_V
#undef PG8_WAIT_L
#undef PG8_BAR
#undef PG8_SCHED
}
}
#define GAS __attribute__((address_space(1)))
#define LAS __attribute__((address_space(3)))
typedef unsigned short bf16;
typedef unsigned v4u __attribute__((ext_vector_type(4)));
typedef float f32x4 __attribute__((ext_vector_type(4)));
typedef short bf16x8 __attribute__((ext_vector_type(8)));
typedef GAS unsigned gu32;
typedef GAS unsigned long long gu64;
#define RLX_AGENT __ATOMIC_RELAXED, __HIP_MEMORY_SCOPE_AGENT
#define LDS_WAIT() asm volatile("s_waitcnt lgkmcnt(0)" ::: "memory")
#define VM_WAIT() asm volatile("s_waitcnt vmcnt(0)" ::: "memory")
__device__ __forceinline__ unsigned long long rt() { return __builtin_amdgcn_s_memrealtime(); }
__device__ __forceinline__ unsigned f2bf(float f) { unsigned u = __builtin_bit_cast(unsigned, f); return (u + 0x7fffu + ((u >> 16) & 1u)) >> 16; }
__device__ __forceinline__ unsigned pk2(float lo, float hi) { return f2bf(lo) | (f2bf(hi) << 16); }

#define XB_TMO      128
#define XB_XCNT(j)  (256  + 64 * (j))
#define XB_XSUB(j)  (1280 + 64 * (j))
#define XB_XGEN(j)  (2304 + 64 * (j))
#define XB_TOP      3328
#define XB_TOPGEN   3392
#define XCD_BAR_WORDS 3456
#define XB_SPIN_CAP (1u << 18)

__device__ __forceinline__ unsigned xb_ld(unsigned* p)              { return __hip_atomic_load(p, __ATOMIC_RELAXED, __HIP_MEMORY_SCOPE_AGENT); }
__device__ __forceinline__ unsigned xb_add(unsigned* p, unsigned v) { return __hip_atomic_fetch_add(p, v, __ATOMIC_RELAXED, __HIP_MEMORY_SCOPE_AGENT); }
__device__ __forceinline__ unsigned xb_xcc_id() { return (unsigned)__builtin_amdgcn_s_getreg((3 << 11) | 20) & 0xFu; }
#define XB_SPIN(cond, bar) do { unsigned _sp = 0; while (cond) { __builtin_amdgcn_s_sleep(1); \
    if ((++_sp & 255u) == 0u) { if (xb_ld(&(bar)[XB_TMO])) break; if (_sp > XB_SPIN_CAP) { atomicAdd(&(bar)[XB_TMO], 1u); break; } } } } while (0)

struct XcdBarrier {
    unsigned* bar; unsigned x;
    volatile LAS unsigned* st;
};

__device__ __forceinline__ XcdBarrier xcd_barrier_post(unsigned* bar, volatile LAS unsigned* st) {
    XcdBarrier b; b.bar = bar; b.x = xb_xcc_id(); b.st = st;
    if (threadIdx.x == 0) (void)xb_add(&bar[XB_XCNT(b.x)], 1u);
    return b;
}
__device__ __forceinline__ void xcd_barrier_complete(unsigned* bar, unsigned x, unsigned& nloc, unsigned& nx) {
    const unsigned G = gridDim.x * gridDim.y * gridDim.z;
    unsigned sum, cnt, mine, sp = 0u;
    for (;;) {
        sum = 0u; cnt = 0u; mine = 0u;
#pragma unroll
        for (unsigned j = 0; j < 16; ++j) { const unsigned c = xb_ld(&bar[XB_XCNT(j)]); sum += c; cnt += (c > 0u) ? 1u : 0u; mine = (j == x) ? c : mine; }
        if (sum == G) break;
        __builtin_amdgcn_s_sleep(1);
        if ((++sp & 255u) == 0u) { if (xb_ld(&bar[XB_TMO])) break; if (sp > XB_SPIN_CAP) { atomicAdd(&bar[XB_TMO], 1u); break; } }
    }
    nloc = mine > 0u ? mine : 1u; nx = cnt > 0u ? cnt : 1u;
}

__device__ __forceinline__ void xcd_barrier(const XcdBarrier& b) {
    asm volatile("s_waitcnt vmcnt(0)" ::: "memory");
    __syncthreads();
    if (threadIdx.x == 0) {
        unsigned* bar = b.bar;
        __builtin_amdgcn_s_waitcnt(0);
        unsigned nloc = b.st[0], nx = b.st[1];
        if (nloc == 0u) { xcd_barrier_complete(bar, b.x, nloc, nx); b.st[0] = nloc; b.st[1] = nx; }
        const unsigned old = xb_add(&bar[XB_XSUB(b.x)], 1u);
        const unsigned gen = old / nloc;
        if (old + 1u == (gen + 1u) * nloc) {
            __builtin_amdgcn_fence(__ATOMIC_RELEASE, "agent");
            asm volatile("s_waitcnt vmcnt(0)" ::: "memory");
            const unsigned og = xb_add(&bar[XB_TOP], 1u);
            const unsigned tg = og / nx;
            if (og + 1u == (tg + 1u) * nx) xb_add(&bar[XB_TOPGEN], 1u);
            else XB_SPIN(xb_ld(&bar[XB_TOPGEN]) == tg, bar);
            __builtin_amdgcn_fence(__ATOMIC_ACQUIRE, "agent");
            xb_add(&bar[XB_XGEN(b.x)], 1u);
            asm volatile("s_waitcnt vmcnt(0)" ::: "memory");
        } else {
            XB_SPIN(xb_ld(&bar[XB_XGEN(b.x)]) == gen, bar);
            __builtin_amdgcn_fence(__ATOMIC_ACQUIRE, "agent");
            asm volatile("s_waitcnt vmcnt(0)" ::: "memory");
        }
    }
    __syncthreads();
}

constexpr int DM = 2048, NBATCH = 2, SEQ = 4096, DEPTH = 4, CTXL = 256;
constexpr int NH = 4, HK = 256, HV = 512, RANK = 16;
constexpr int DPOOL = 1024, DFF = 5632, NMODV = 6 * DM;
constexpr int MLAT = NBATCH * SEQ, MCTX = NBATCH * CTXL, MTOT = MLAT + MCTX;
constexpr int NPROJ = 11520, NPROJ_SRC = 11296, NFFI = 2 * DFF;
constexpr int CQ = 0, CK = 1024, CV = 2048, CG = 4096, CP = 6144, CBG = 7168, CBP = 9216, CA = 11264;
constexpr float ALPHA = 1.6817928305074290f;
constexpr float LN_EPS = 1e-5f, RMS_EPS = 1e-6f;
constexpr int NWAVES = 8, NTHREADS = 512;
constexpr int LDS_BYTES = 147456;
constexpr int RING_BYTES = 131072, MISC_OFF = RING_BYTES + 320;

constexpr size_t al256(size_t x) { return (x + 255) & ~(size_t)255; }
constexpr size_t WS_CTL = 0, CTL_BYTES = 1u << 20;
constexpr size_t SZ_MODP = (size_t)DEPTH * 8 * 3 * NMODV * 4, SZ_MOD = (size_t)DEPTH * 3 * NMODV * 4;
constexpr size_t WS_MODP = WS_CTL + CTL_BYTES, WS_MOD = al256(WS_MODP + SZ_MODP), WS_W = al256(WS_MOD + SZ_MOD);
constexpr size_t WO_IN = 0, SZ_IN = (size_t)NPROJ * DM * 2;
constexpr size_t WO_GO = WO_IN + SZ_IN, SZ_GO = (size_t)DM * DM * 2;
constexpr size_t WO_PG = WO_GO + SZ_GO, SZ_PG = (size_t)1024 * 1024 * 2;
constexpr size_t WO_PO = WO_PG + SZ_PG, SZ_PO = (size_t)DM * 1024 * 2;
constexpr size_t WO_OUT = WO_PO + SZ_PO, SZ_OUT = (size_t)DM * DM * 2;
constexpr size_t WO_FI = WO_OUT + SZ_OUT, SZ_FI = (size_t)NFFI * DM * 2;
constexpr size_t WO_FO = WO_FI + SZ_FI, SZ_FO = (size_t)DM * DFF * 2;
constexpr size_t W_LAYER = WO_FO + SZ_FO;
constexpr size_t WS_X = al256(WS_W + DEPTH * W_LAYER), SZ_X = (size_t)MTOT * DM * 4;
constexpr size_t WS_V = WS_X + SZ_X;
constexpr size_t WS_H = WS_V + SZ_X, SZ_H = (size_t)MTOT * DM * 2;
constexpr size_t WS_PROJ = WS_H + SZ_H, SZ_PROJ = (size_t)MTOT * NPROJ * 2;
constexpr size_t WS_ACT = WS_PROJ;
constexpr int NCG = MTOT / 64;
constexpr size_t WS_LA = WS_PROJ + SZ_PROJ, SZ_LA = (size_t)2 * MTOT * 1024 * 4;
constexpr size_t WS_QI = WS_LA, SZ_QI = (size_t)2 * MTOT * 1024 * 2;
constexpr size_t WS_KST = WS_QI + SZ_QI, SZ_KST = (size_t)2 * NCG * 4 * 256 * 64 * 2;
constexpr size_t WS_PM = WS_KST + SZ_KST, SZ_PM = (size_t)2 * NCG * 4 * 64 * 64 * 2;
constexpr size_t WS_DCB = WS_PM + SZ_PM, SZ_DCB = (size_t)2 * NCG * 4 * 256 * 4;
constexpr size_t WS_VT = WS_DCB + SZ_DCB, SZ_VT = (size_t)NCG * 4 * 512 * 64 * 2;
constexpr size_t WS_GLAEND = WS_VT + SZ_VT;
static_assert(WS_GLAEND >= WS_LA + SZ_LA, "overlay");
constexpr size_t WS_O = WS_GLAEND, SZ_O = (size_t)MTOT * DM * 4;
constexpr size_t WS_AGLA = WS_O + 2 * SZ_O;
constexpr size_t WS_HM = WS_AGLA + SZ_H, SZ_HM = (size_t)MTOT * 1024 * 4;
constexpr size_t WS_T = WS_HM + SZ_HM, SZ_T = (size_t)MTOT * 1024 * 2;
constexpr size_t WS_U = WS_T + SZ_T;
constexpr size_t WS_TEMP = WS_U + SZ_T;
constexpr size_t WS_MRG = WS_TEMP + SZ_X;
constexpr size_t WS_END = WS_MRG + SZ_H;

struct Params {
    const float *x, *c, *ctx, *c_ctx, *w_ada, *b_ada, *w_in, *w_dup, *b_dup, *gla_gain, *w_pg, *pool_scale, *w_go, *w_po, *w_out, *ln1g, *ln1b, *w_fi, *w_fo, *ln2g, *ln2b;
    float* out; unsigned char* ws; int layer; int pad;
};
typedef float f32x2g __attribute__((ext_vector_type(2)));
typedef unsigned u32x2g __attribute__((ext_vector_type(2)));
struct Frame { LAS unsigned char* lds; int tid, lane, wave, vcu, G, gw, NGW; };

__device__ __forceinline__ bf16* wlayer(const Params& p, int l, size_t off) { return (bf16*)(p.ws + WS_W + (size_t)l * W_LAYER + off); }
__device__ __forceinline__ const float* modv(const Params& p, int l, int mi, int which) { return (const float*)(p.ws + WS_MOD) + ((size_t)l * 3 + mi) * NMODV + (size_t)which * DM; }
__device__ __forceinline__ float bf2f(unsigned short b) { return __builtin_bit_cast(float, (unsigned)b << 16); }
__device__ __forceinline__ float bflo(unsigned w) { return __builtin_bit_cast(float, w << 16); }
__device__ __forceinline__ float bfhi(unsigned w) { return __builtin_bit_cast(float, w & 0xffff0000u); }
__device__ __forceinline__ float fast_sigmoid(float x) { return __builtin_amdgcn_rcpf(1.0f + __expf(-x)); }
__device__ __forceinline__ float wave_sum(float v) {
#pragma unroll
    for (int o = 1; o < 64; o <<= 1) v += __shfl_xor(v, o);
    return v;
}
__device__ __forceinline__ int mod_index(int row) { return row < SEQ ? 0 : (row < MLAT ? 1 : 2); }

struct EpiProj {
    static constexpr bool PERM = true, AFTER_DRAIN = false;
    bf16* O;
    __device__ __forceinline__ void operator()(const pg8::f32x4 (&acc)[2][2][4][2], const pg8::Unit& u, int wr, int wc, int fr, int fq) const {
        const int row0 = u.pm * 256 + wr * 64 + fr, col0 = u.pn * 256 + wc * 32 + 8 * fq;
        const int mode = (u.pn >= 16 && u.pn < 24) ? 1 : ((u.pn >= 28 && u.pn < 44) ? 2 : 0);
#pragma unroll
        for (int ai = 0; ai < 2; ++ai)
#pragma unroll
            for (int m = 0; m < 4; ++m) { bf16* rowp = O + (size_t)(row0 + ai * 128 + m * 16) * NPROJ + col0;
#pragma unroll
                for (int bj = 0; bj < 2; ++bj) { pg8::f32x4 v0 = acc[ai][bj][m][0], v1 = acc[ai][bj][m][1];
                    if (mode != 0) {
#pragma unroll
                        for (int j = 0; j < 4; ++j) { const float s0 = fast_sigmoid(v0[j]), s1 = fast_sigmoid(v1[j]); v0[j] = (mode == 1) ? v0[j] * s0 : s0; v1[j] = (mode == 1) ? v1[j] * s1 : s1; } }
                    pg8::u32x4 w; w.x = pg8::cvt_pk_bf16(v0[0], v0[1]); w.y = pg8::cvt_pk_bf16(v0[2], v0[3]); w.z = pg8::cvt_pk_bf16(v1[0], v1[1]); w.w = pg8::cvt_pk_bf16(v1[2], v1[3]);
                    *(pg8::u32x4*)(rowp + bj * 128) = w; } }
    }
};
struct EpiBf16Plain {
    static constexpr bool PERM = true, AFTER_DRAIN = false;
    bf16* O; int ldc;
    __device__ __forceinline__ void operator()(const pg8::f32x4 (&acc)[2][2][4][2], const pg8::Unit& u, int wr, int wc, int fr, int fq) const {
        const int row0 = u.pm * 256 + wr * 64 + fr, col0 = u.pn * 256 + wc * 32 + 8 * fq;
#pragma unroll
        for (int ai = 0; ai < 2; ++ai)
#pragma unroll
            for (int m = 0; m < 4; ++m) { bf16* rowp = O + (size_t)(row0 + ai * 128 + m * 16) * ldc + col0;
#pragma unroll
                for (int bj = 0; bj < 2; ++bj) { const pg8::f32x4 v0 = acc[ai][bj][m][0], v1 = acc[ai][bj][m][1];
                    pg8::u32x4 w; w.x = pg8::cvt_pk_bf16(v0[0], v0[1]); w.y = pg8::cvt_pk_bf16(v0[2], v0[3]); w.z = pg8::cvt_pk_bf16(v1[0], v1[1]); w.w = pg8::cvt_pk_bf16(v1[2], v1[3]);
                    *(pg8::u32x4*)(rowp + bj * 128) = w; } }
    }
};
struct EpiGateTemp {
    static constexpr bool PERM = true, AFTER_DRAIN = false;
    float* T; const bf16* PROJ;
    __device__ __forceinline__ void operator()(const pg8::f32x4 (&acc)[2][2][4][2], const pg8::Unit& u, int wr, int wc, int fr, int fq) const {
        const int row0 = u.pm * 256 + wr * 64 + fr, col0 = u.pn * 256 + wc * 32 + 8 * fq;
#pragma unroll
        for (int ai = 0; ai < 2; ++ai)
#pragma unroll
            for (int m = 0; m < 4; ++m) { const int row = row0 + ai * 128 + m * 16;
#pragma unroll
                for (int bj = 0; bj < 2; ++bj) { const int c = col0 + bj * 128;
                    const pg8::u32x4 gw = *(const pg8::u32x4*)(PROJ + (size_t)row * NPROJ + CBP + c);
                    pg8::f32x4 v0 = acc[ai][bj][m][0], v1 = acc[ai][bj][m][1];
                    v0[0] *= bflo(gw.x); v0[1] *= bfhi(gw.x); v0[2] *= bflo(gw.y); v0[3] *= bfhi(gw.y);
                    v1[0] *= bflo(gw.z); v1[1] *= bfhi(gw.z); v1[2] *= bflo(gw.w); v1[3] *= bfhi(gw.w);
                    float* tp = T + (size_t)row * DM + c; *(pg8::f32x4*)tp = v0; *(pg8::f32x4*)(tp + 4) = v1; } }
    }
    __device__ __forceinline__ void small(int row, int col, pg8::f32x4 v) const {
        const u32x2g gw = *(const u32x2g*)(PROJ + (size_t)row * NPROJ + CBP + col);
        v[0] *= bflo(gw.x); v[1] *= bfhi(gw.x); v[2] *= bflo(gw.y); v[3] *= bfhi(gw.y); *(pg8::f32x4*)(T + (size_t)row * DM + col) = v; }
};
struct EpiMerge {
    static constexpr bool PERM = true, AFTER_DRAIN = false;
    bf16* O; const float* T; const bf16* PROJ;
    __device__ __forceinline__ void operator()(const pg8::f32x4 (&acc)[2][2][4][2], const pg8::Unit& u, int wr, int wc, int fr, int fq) const {
        const int row0 = u.pm * 256 + wr * 64 + fr, col0 = u.pn * 256 + wc * 32 + 8 * fq;
#pragma unroll
        for (int ai = 0; ai < 2; ++ai)
#pragma unroll
            for (int m = 0; m < 4; ++m) { const int row = row0 + ai * 128 + m * 16;
#pragma unroll
                for (int bj = 0; bj < 2; ++bj) { const int c = col0 + bj * 128;
                    const pg8::u32x4 gw = *(const pg8::u32x4*)(PROJ + (size_t)row * NPROJ + CBG + c);
                    const float* tp = T + (size_t)row * DM + c; const pg8::f32x4 t0 = *(const pg8::f32x4*)tp, t1 = *(const pg8::f32x4*)(tp + 4);
                    pg8::f32x4 v0 = acc[ai][bj][m][0], v1 = acc[ai][bj][m][1];
                    v0[0] = v0[0] * bflo(gw.x) + t0[0]; v0[1] = v0[1] * bfhi(gw.x) + t0[1]; v0[2] = v0[2] * bflo(gw.y) + t0[2]; v0[3] = v0[3] * bfhi(gw.y) + t0[3];
                    v1[0] = v1[0] * bflo(gw.z) + t1[0]; v1[1] = v1[1] * bfhi(gw.z) + t1[1]; v1[2] = v1[2] * bflo(gw.w) + t1[2]; v1[3] = v1[3] * bfhi(gw.w) + t1[3];
                    pg8::u32x4 w; w.x = pg8::cvt_pk_bf16(v0[0], v0[1]); w.y = pg8::cvt_pk_bf16(v0[2], v0[3]); w.z = pg8::cvt_pk_bf16(v1[0], v1[1]); w.w = pg8::cvt_pk_bf16(v1[2], v1[3]);
                    *(pg8::u32x4*)(O + (size_t)row * DM + c) = w; } }
    }
    __device__ __forceinline__ void small(int row, int col, pg8::f32x4 v) const {
        const u32x2g gw = *(const u32x2g*)(PROJ + (size_t)row * NPROJ + CBG + col); const pg8::f32x4 t = *(const pg8::f32x4*)(T + (size_t)row * DM + col);
        v[0] = v[0] * bflo(gw.x) + t[0]; v[1] = v[1] * bfhi(gw.x) + t[1]; v[2] = v[2] * bflo(gw.y) + t[2]; v[3] = v[3] * bfhi(gw.y) + t[3];
        *(u32x2g*)(O + (size_t)row * DM + col) = (u32x2g){pg8::cvt_pk_bf16(v[0], v[1]), pg8::cvt_pk_bf16(v[2], v[3])}; }
};
struct EpiResid {
    static constexpr bool PERM = false, AFTER_DRAIN = false;
    float* V; const float* xlat; const float* xctx; const float* gt0;
    __device__ __forceinline__ void operator()(const pg8::f32x4 (&acc)[2][2][4][2], const pg8::Unit& u, int wr, int wc, int fr, int fq) const {
        const int row0 = u.pm * 256 + wr * 64 + fr, col0 = u.pn * 256 + wc * 32 + 4 * fq;
        const int mi = u.pm < 16 ? 0 : (u.pm < 32 ? 1 : 2);
        const float* gt = gt0 + (size_t)mi * NMODV + col0;
        pg8::f32x4 gv[2][2];
#pragma unroll
        for (int bj = 0; bj < 2; ++bj)
#pragma unroll
            for (int n = 0; n < 2; ++n) gv[bj][n] = *(const pg8::f32x4*)(gt + bj * 128 + n * 16);
#pragma unroll
        for (int ai = 0; ai < 2; ++ai)
#pragma unroll
            for (int m = 0; m < 4; ++m) { const int row = row0 + ai * 128 + m * 16;
                const float* xr = (u.pm < 32 ? xlat + (size_t)row * DM : xctx + (size_t)(row - MLAT) * DM) + col0; float* vr = V + (size_t)row * DM + col0;
#pragma unroll
                for (int bj = 0; bj < 2; ++bj)
#pragma unroll
                    for (int n = 0; n < 2; ++n) { const pg8::f32x4 xv = *(const pg8::f32x4*)(xr + bj * 128 + n * 16);
                        *(pg8::f32x4*)(vr + bj * 128 + n * 16) = xv * ALPHA + gv[bj][n] * acc[ai][bj][m][n]; } }
    }
    __device__ __forceinline__ void small(int row, int col, pg8::f32x4 v) const {
        const pg8::f32x4 g = *(const pg8::f32x4*)(gt0 + (size_t)2 * NMODV + col), xv = *(const pg8::f32x4*)(xctx + (size_t)(row - MLAT) * DM + col);
        *(pg8::f32x4*)(V + (size_t)row * DM + col) = xv * ALPHA + g * v; }
};
struct EpiSwiglu {
    static constexpr bool PERM = true, AFTER_DRAIN = false;
    bf16* O;
    __device__ __forceinline__ void operator()(const pg8::f32x4 (&acc)[2][2][4][2], const pg8::Unit& u, int wr, int wc, int fr, int fq) const {
        const int row0 = u.pm * 256 + wr * 64 + fr, col0 = u.pn * 128 + wc * 32 + 8 * fq;
#pragma unroll
        for (int ai = 0; ai < 2; ++ai)
#pragma unroll
            for (int m = 0; m < 4; ++m) { const int row = row0 + ai * 128 + m * 16;
                pg8::f32x4 a0, a1;
#pragma unroll
                for (int j = 0; j < 4; ++j) { const float g0 = acc[ai][0][m][0][j], g1 = acc[ai][0][m][1][j];
                    a0[j] = g0 * fast_sigmoid(g0) * acc[ai][1][m][0][j]; a1[j] = g1 * fast_sigmoid(g1) * acc[ai][1][m][1][j]; }
                pg8::u32x4 w; w.x = pg8::cvt_pk_bf16(a0[0], a0[1]); w.y = pg8::cvt_pk_bf16(a0[2], a0[3]); w.z = pg8::cvt_pk_bf16(a1[0], a1[1]); w.w = pg8::cvt_pk_bf16(a1[2], a1[3]);
                *(pg8::u32x4*)(O + (size_t)row * DFF + col0) = w; }
    }
};

template <class Epi> __device__ __forceinline__ void small_gemm_ctx(const Frame& F, const bf16* A, const bf16* Bt, int K, const Epi& E) {
    const int c = (int)blockIdx.x; if (c >= 256) return;
    const int rb = MLAT + 64 * (c >> 5), cb = 64 * (c & 31);
    const int fr = F.lane & 15, fq = F.lane >> 4, kw = K >> 3;
    f32x4 acc[4][4];
#pragma unroll
    for (int m = 0; m < 4; ++m)
#pragma unroll
        for (int n = 0; n < 4; ++n) acc[m][n] = (f32x4){0.f, 0.f, 0.f, 0.f};
    const bf16* ap = A + (size_t)(rb + fr) * K + F.wave * kw + 8 * fq; const bf16* bp = Bt + (size_t)(cb + fr) * K + F.wave * kw + 8 * fq;
#pragma unroll 2
    for (int ks = 0; ks < kw; ks += 32) { bf16x8 a[4], b[4];
#pragma unroll
        for (int m = 0; m < 4; ++m) { a[m] = *(const GAS bf16x8*)(ap + (size_t)m * 16 * K + ks); b[m] = *(const GAS bf16x8*)(bp + (size_t)m * 16 * K + ks); }
#pragma unroll
        for (int m = 0; m < 4; ++m)
#pragma unroll
            for (int n = 0; n < 4; ++n) acc[m][n] = __builtin_amdgcn_mfma_f32_16x16x32_bf16(a[m], b[n], acc[m][n], 0, 0, 0); }
    LAS float* part = (LAS float*)F.lds + F.wave * 4096;
#pragma unroll
    for (int m = 0; m < 4; ++m)
#pragma unroll
        for (int n = 0; n < 4; ++n)
#pragma unroll
            for (int reg = 0; reg < 4; ++reg) part[(16 * m + 4 * fq + reg) * 64 + 16 * n + fr] = acc[m][n][reg];
    __syncthreads();
#pragma unroll
    for (int q = 0; q < 2; ++q) { const int idx = F.tid * 2 + q, row = idx >> 4, col = (idx & 15) * 4; f32x4 s = {0.f, 0.f, 0.f, 0.f};
#pragma unroll
        for (int w = 0; w < 8; ++w) s += *(const LAS f32x4*)((LAS float*)F.lds + w * 4096 + row * 64 + col);
        E.small(rb + row, cb + col, s); }
    __syncthreads();
}
__device__ __forceinline__ void transpose_item(const float* W, int N, int k0, int n0, bf16* WT, int ldk, int drow0, float colscale, const float* rowscale, LAS float* scr, int lane) {
#pragma unroll 8
    for (int i = 0; i < 32; ++i) { const int kk = 2 * i + (lane >> 5); float v = W[(size_t)(k0 + kk) * N + n0 + (lane & 31)]; if (rowscale) v *= rowscale[k0 + kk]; scr[kk * 33 + (lane & 31)] = v * colscale; }
    LDS_WAIT(); asm volatile("" ::: "memory");
    const int c = lane & 7;
#pragma unroll
    for (int j = 0; j < 4; ++j) { const int n = (lane >> 3) + 8 * j; const LAS float* s = scr + (8 * c) * 33 + n;
        v4u o; o.x = pk2(s[0 * 33], s[1 * 33]); o.y = pk2(s[2 * 33], s[3 * 33]); o.z = pk2(s[4 * 33], s[5 * 33]); o.w = pk2(s[6 * 33], s[7 * 33]);
        *(GAS v4u*)(WT + (size_t)(drow0 + n) * ldk + k0 + 8 * c) = o; }
    LDS_WAIT(); asm volatile("" ::: "memory");
}
constexpr int IT_IN = 32 * (NPROJ_SRC / 32), IT_GO = 32 * 64, IT_PO = 16 * 64, IT_OUT = 32 * 64, IT_FI = 32 * (NFFI / 32), IT_FO = (DFF / 64) * 64, IT_PG = 128, IT_ZIN = 224, IT_ZPG = 1024;
constexpr int IT_LAYER = IT_IN + IT_GO + IT_PO + IT_OUT + IT_FI + IT_FO + IT_PG + IT_ZIN + IT_ZPG;
constexpr int IT_MOD = DEPTH * 48 * 8;
__device__ __forceinline__ void phase_prologue_a(const Frame& F, const Params& p) {
    LAS float* scr = (LAS float*)(F.lds + F.wave * 16384);
    for (int it = F.gw; it < IT_MOD; it += F.NGW) {
        const int l = it / 384, r = it % 384, nb = r / 8, kb = r % 8, k0 = 256 * kb, n0 = 256 * nb + 4 * F.lane;
#pragma unroll
        for (int j = 0; j < 4; ++j) { const int k = k0 + F.lane + 64 * j;
            const float c0 = p.c[k], c1 = p.c[DM + k], c2 = p.c_ctx[k];
            scr[(F.lane + 64 * j) * 3 + 0] = c0 / (1.0f + expf(-c0)); scr[(F.lane + 64 * j) * 3 + 1] = c1 / (1.0f + expf(-c1)); scr[(F.lane + 64 * j) * 3 + 2] = c2 / (1.0f + expf(-c2)); }
        LDS_WAIT(); asm volatile("" ::: "memory");
        f32x4 a0 = {0.f, 0.f, 0.f, 0.f}, a1 = a0, a2 = a0;
        const float* wp = p.w_ada + ((size_t)l * DM + k0) * NMODV + n0;
#pragma unroll 8
        for (int kk = 0; kk < 256; ++kk) { const f32x4 w = *(const GAS f32x4*)(wp + (size_t)kk * NMODV); const float s0 = scr[kk * 3], s1 = scr[kk * 3 + 1], s2 = scr[kk * 3 + 2];
            a0 += w * s0; a1 += w * s1; a2 += w * s2; }
        float* mp = (float*)(p.ws + WS_MODP) + ((size_t)(l * 8 + kb) * 3) * NMODV + n0;
        *(GAS f32x4*)(mp) = a0; *(GAS f32x4*)(mp + NMODV) = a1; *(GAS f32x4*)(mp + 2 * NMODV) = a2;
        LDS_WAIT(); asm volatile("" ::: "memory");
    }
    for (int it = F.gw; it < DEPTH * IT_LAYER; it += F.NGW) {
        const int l = it / IT_LAYER; int r = it % IT_LAYER;
        if (r < IT_IN) { const int nblk = NPROJ_SRC / 32, kb = r / nblk, n0 = 32 * (r % nblk);
            int drow; float cs = 1.0f;
            if (n0 < 6144) { drow = n0; if (n0 < 1024) cs = 0.0625f; } else if (n0 < 6176) drow = CA + (n0 - 6144); else if (n0 < 7200) drow = CP + (n0 - 6176); else drow = CBG + (n0 - 7200);
            transpose_item(p.w_in + (size_t)l * DM * NPROJ_SRC, NPROJ_SRC, 64 * kb, n0, wlayer(p, l, WO_IN), DM, drow, cs, nullptr, scr, F.lane); continue; } r -= IT_IN;
        if (r < IT_GO) { transpose_item(p.w_go + (size_t)l * DM * DM, DM, 64 * (r / 64), 32 * (r % 64), wlayer(p, l, WO_GO), DM, 32 * (r % 64), 1.0f, nullptr, scr, F.lane); continue; } r -= IT_GO;
        if (r < IT_PO) { transpose_item(p.w_po + (size_t)l * DPOOL * DM, DM, 64 * (r / 64), 32 * (r % 64), wlayer(p, l, WO_PO), DPOOL, 32 * (r % 64), 1.0f, p.pool_scale + (size_t)l * DPOOL, scr, F.lane); continue; } r -= IT_PO;
        if (r < IT_OUT) { transpose_item(p.w_out + (size_t)l * DM * DM, DM, 64 * (r / 64), 32 * (r % 64), wlayer(p, l, WO_OUT), DM, 32 * (r % 64), 1.0f, nullptr, scr, F.lane); continue; } r -= IT_OUT;
        if (r < IT_FI) { const int nblk = NFFI / 32, kb = r / nblk, n0 = 32 * (r % nblk), up = n0 >= DFF ? 1 : 0, ch = n0 - up * DFF;
            transpose_item(p.w_fi + (size_t)l * DM * NFFI, NFFI, 64 * kb, n0, wlayer(p, l, WO_FI), DM, 256 * (ch / 128) + 128 * up + (ch % 128), 1.0f, nullptr, scr, F.lane); continue; } r -= IT_FI;
        if (r < IT_FO) { transpose_item(p.w_fo + (size_t)l * DFF * DM, DM, 64 * (r / 64), 32 * (r % 64), wlayer(p, l, WO_FO), DFF, 32 * (r % 64), 1.0f, nullptr, scr, F.lane); continue; } r -= IT_FO;
        if (r < IT_PG) { const int g = r / 32, q = r % 32;
            transpose_item(p.w_pg + ((size_t)l * 4 + g) * 256 * 256, 256, 64 * (q / 8), 32 * (q % 8), wlayer(p, l, WO_PG) + 256 * g, 1024, 256 * g + 32 * (q % 8), 1.0f, nullptr, scr, F.lane); continue; } r -= IT_PG;
        if (r < IT_ZIN) { GAS v4u* zp = (GAS v4u*)(wlayer(p, l, WO_IN) + (size_t)(NPROJ_SRC + r) * DM);
#pragma unroll
            for (int j = 0; j < 4; ++j) zp[F.lane + 64 * j] = (v4u){0u, 0u, 0u, 0u};
            continue; } r -= IT_ZIN;
        { GAS v4u* zp = (GAS v4u*)(wlayer(p, l, WO_PG) + (size_t)r * 1024); const int g = r >> 8;
#pragma unroll
          for (int j = 0; j < 2; ++j) { const int ch = F.lane + 64 * j; if ((ch >> 5) != g) zp[ch] = (v4u){0u, 0u, 0u, 0u}; } }
    }
}
__device__ __forceinline__ void phase_prologue_b(const Frame& F, const Params& p) {
    const float* MP = (const float*)(p.ws + WS_MODP); float* MO = (float*)(p.ws + WS_MOD);
    for (int e = F.vcu * NTHREADS + F.tid; e < DEPTH * 3 * NMODV; e += F.G * NTHREADS) { const int l = e / (3 * NMODV), r = e % (3 * NMODV), n = r % NMODV;
        float s = p.b_ada[(size_t)l * NMODV + n];
#pragma unroll
        for (int kb = 0; kb < 8; ++kb) s += MP[((size_t)(l * 8 + kb) * 3) * NMODV + r];
        MO[e] = s; }
    LAS float* sm = (LAS float*)F.lds;
    for (int e = F.tid; e < 3 * 2 * DM; e += NTHREADS) { const int mi = e / (2 * DM), r = e % (2 * DM);
        float s = p.b_ada[r];
#pragma unroll
        for (int kb = 0; kb < 8; ++kb) s += MP[((size_t)kb * 3 + mi) * NMODV + r];
        sm[e] = s; }
    __syncthreads();
    bf16* H = (bf16*)(p.ws + WS_H);
    for (int row = F.gw; row < MTOT; row += F.NGW) { const int mi = mod_index(row);
        const float* xr = row < MLAT ? p.x + (size_t)row * DM : p.ctx + (size_t)(row - MLAT) * DM;
        const LAS float* sh = sm + mi * 2 * DM; const LAS float* sc = sh + DM;
        GAS unsigned long long* o8 = (GAS unsigned long long*)(H + (size_t)row * DM) + F.lane;
#pragma unroll
        for (int j = 0; j < 8; ++j) { const int c = 4 * F.lane + 256 * j; const f32x4 v = *(const GAS f32x4*)(xr + c);
            const float y0 = v.x * (1.0f + sc[c]) + sh[c], y1 = v.y * (1.0f + sc[c + 1]) + sh[c + 1], y2 = v.z * (1.0f + sc[c + 2]) + sh[c + 2], y3 = v.w * (1.0f + sc[c + 3]) + sh[c + 3];
            o8[64 * j] = (unsigned long long)pk2(y0, y1) | ((unsigned long long)pk2(y2, y3) << 32); } }
    __syncthreads();
}
__device__ __forceinline__ void phase_ln(const Frame& F, const Params& p, int l, int sub, int M) {
    const float* V = (const float*)(p.ws + WS_V); float* X = (float*)(p.ws + WS_X); bf16* H = (bf16*)(p.ws + WS_H);
    const float* gain = (sub == 0 ? p.ln1g : p.ln2g) + (size_t)l * DM; const float* bias = (sub == 0 ? p.ln1b : p.ln2b) + (size_t)l * DM;
    const bool last = (sub == 1 && l == DEPTH - 1);
    const int lm = sub == 0 ? l : l + 1, wsh = sub == 0 ? 3 : 0, wsc = sub == 0 ? 4 : 1;
    for (int row = F.gw; row < M; row += F.NGW) {
        const GAS f32x4* vr = (const GAS f32x4*)(V + (size_t)row * DM) + F.lane;
        f32x4 v[8]; float s = 0.f;
#pragma unroll
        for (int j = 0; j < 8; ++j) { v[j] = vr[64 * j]; s += (v[j].x + v[j].y) + (v[j].z + v[j].w); }
        const float mean = wave_sum(s) * (1.f / DM); float s2 = 0.f;
#pragma unroll
        for (int j = 0; j < 8; ++j) { v[j] = v[j] - mean; s2 += (v[j].x * v[j].x + v[j].y * v[j].y) + (v[j].z * v[j].z + v[j].w * v[j].w); }
        const float rstd = 1.f / sqrtf(wave_sum(s2) * (1.f / DM) + LN_EPS);
#pragma unroll
        for (int j = 0; j < 8; ++j) { const int c = 4 * F.lane + 256 * j; const f32x4 g = *(const GAS f32x4*)(gain + c), b = *(const GAS f32x4*)(bias + c); v[j] = v[j] * rstd * g + b; }
        if (last) { GAS f32x4* o = (GAS f32x4*)(p.out + (size_t)row * DM) + F.lane;
#pragma unroll
            for (int j = 0; j < 8; ++j) o[64 * j] = v[j];
        } else {
            GAS f32x4* xo = (GAS f32x4*)(X + (size_t)row * DM) + F.lane;
            const int mi = mod_index(row); const float* sh = modv(p, lm, mi, wsh); const float* sc = modv(p, lm, mi, wsc);
            GAS unsigned long long* o8 = (GAS unsigned long long*)(H + (size_t)row * DM) + F.lane;
#pragma unroll
            for (int j = 0; j < 8; ++j) { const int c = 4 * F.lane + 256 * j; xo[64 * j] = v[j];
                const f32x4 a = *(const GAS f32x4*)(sc + c), b = *(const GAS f32x4*)(sh + c); const f32x4 y = v[j] * (a + 1.0f) + b;
                o8[64 * j] = (unsigned long long)pk2(y.x, y.y) | ((unsigned long long)pk2(y.z, y.w) << 32); } }
    }
}
__device__ __forceinline__ void phase_pool(const Frame& F, const Params& p, int pass) {
    const bf16* PROJ = (const bf16*)(p.ws + WS_PROJ); float* HM = (float*)(p.ws + WS_HM); bf16* T = (bf16*)(p.ws + WS_T);
    for (int task = F.gw; task < MTOT * 8; task += F.NGW) { const int row = task >> 3, cb = task & 7, c = cb * 128 + 2 * F.lane, g = cb >> 1, w = 2 << g, lo = w >> 1, hi = w - lo - 1;
        int idx, n, stride;
        if (row < MLAT) { const int t = row & (SEQ - 1); if (pass == 0) { idx = t & 63; n = 64; stride = 1; } else { idx = t >> 6; n = 64; stride = 64; } }
        else { const int t = (row - MLAT) & (CTXL - 1); idx = t; n = (pass == 0) ? CTXL : 1; stride = 1; if (pass == 1) idx = 0; }
        const int lower = max(idx - lo, 0), upper = min(idx + hi + 1, n);
        float s0 = 0.f, s1 = 0.f;
        if (pass == 0) { for (int q = lower; q < upper; ++q) { const unsigned wv = *(const GAS unsigned*)(PROJ + (size_t)(row + (q - idx) * stride) * NPROJ + CP + c); s0 += bflo(wv); s1 += bfhi(wv); } }
        else { for (int q = lower; q < upper; ++q) { const f32x2g hv = *(const GAS f32x2g*)(HM + (size_t)(row + (q - idx) * stride) * DPOOL + c); s0 += hv.x; s1 += hv.y; } }
        const float inv = 1.0f / (float)(upper - lower); s0 *= inv; s1 *= inv;
        if (pass == 0) { *(GAS f32x2g*)(HM + (size_t)row * DPOOL + c) = (f32x2g){s0, s1}; }
        else { const unsigned wv = *(const GAS unsigned*)(PROJ + (size_t)row * NPROJ + CP + c); *(GAS unsigned*)(T + (size_t)row * DPOOL + c) = pk2(s0 - bflo(wv), s1 - bfhi(wv)); }
    }
}
__device__ __forceinline__ float log_sigmoid_f(float z) { return fminf(z, 0.f) - log1pf(expf(-fabsf(z))); }
__device__ __forceinline__ void phase_la(const Frame& F, const Params& p, int l) {
    const bf16* PROJ = (const bf16*)(p.ws + WS_PROJ); float* LA = (float*)(p.ws + WS_LA);
    for (int task = F.gw; task < MTOT * 2; task += F.NGW) { const int row = task >> 1, dir = task & 1;
        const bf16* ap = PROJ + (size_t)row * NPROJ + CA + dir * 16; float a[16];
#pragma unroll
        for (int r = 0; r < 16; ++r) a[r] = bf2f(ap[r]);
        const float* wu = p.w_dup + ((size_t)l * 2 + dir) * RANK * 1024; const float* bu = p.b_dup + ((size_t)l * 2 + dir) * 1024;
#pragma unroll
        for (int j = 0; j < 4; ++j) { const int d = 4 * F.lane + 256 * j; f32x4 z = *(const GAS f32x4*)(bu + d);
#pragma unroll
            for (int r = 0; r < 16; ++r) z += *(const GAS f32x4*)(wu + (size_t)r * 1024 + d) * a[r];
            f32x4 o; o.x = log_sigmoid_f(z.x) * 0.0625f; o.y = log_sigmoid_f(z.y) * 0.0625f; o.z = log_sigmoid_f(z.z) * 0.0625f; o.w = log_sigmoid_f(z.w) * 0.0625f;
            *(GAS f32x4*)(LA + ((size_t)dir * MTOT + row) * 1024 + d) = o; } }
}
__device__ __forceinline__ void phase_gla_naive(const Frame& F, const Params& p) {
    const bf16* PROJ = (const bf16*)(p.ws + WS_PROJ); const float* LA = (const float*)(p.ws + WS_LA); float* O = (float*)(p.ws + WS_O);
    for (int it = F.gw; it < NBATCH * NH * HV; it += F.NGW) { const int b = it >> 11, h = (it >> 9) & 3, vcol = it & 511;
        for (int dir = 0; dir < 2; ++dir) {
            float S0 = 0.f, S1 = 0.f, S2 = 0.f, S3 = 0.f;
#pragma unroll 4
            for (int step = 0; step < CTXL + SEQ; ++step) {
                int row; if (step < CTXL) { const int t = dir ? CTXL - 1 - step : step; row = MLAT + b * CTXL + t; } else { const int s2 = step - CTXL; const int t = dir ? SEQ - 1 - s2 : s2; row = b * SEQ + t; }
                const bf16* pr = PROJ + (size_t)row * NPROJ;
                const u32x2g qw = *(const GAS u32x2g*)(pr + CQ + h * HK + 4 * F.lane), kw = *(const GAS u32x2g*)(pr + CK + h * HK + 4 * F.lane);
                const f32x4 la = *(const GAS f32x4*)(LA + ((size_t)dir * MTOT + row) * 1024 + h * HK + 4 * F.lane);
                const float vv = bf2f(pr[CV + h * HV + vcol]);
                S0 = expf(la.x) * S0 + bflo(kw.x) * vv; S1 = expf(la.y) * S1 + bfhi(kw.x) * vv; S2 = expf(la.z) * S2 + bflo(kw.y) * vv; S3 = expf(la.w) * S3 + bfhi(kw.y) * vv;
                const float part = wave_sum((bflo(qw.x) * S0 + bfhi(qw.x) * S1) + (bflo(qw.y) * S2 + bfhi(qw.y) * S3));
                if (F.lane == 0) { float* op = O + (size_t)row * DM + h * HV + vcol; *op = dir ? *op + part : part; }
            }
        }
    }
}
template <int NO> __device__ __forceinline__ void phase_gout(const Frame& F, const Params& p, int l, int M) {
    const bf16* PROJ = (const bf16*)(p.ws + WS_PROJ); const float* O = (const float*)(p.ws + WS_O); bf16* A = (bf16*)(p.ws + WS_AGLA);
    const float* gain = p.gla_gain + (size_t)l * DM;
    for (int task = F.gw; task < M * NH; task += F.NGW) { const int row = task >> 2, h = task & 3, c = h * HV + 8 * F.lane;
        f32x4 o0 = *(const GAS f32x4*)(O + (size_t)row * DM + c), o1 = *(const GAS f32x4*)(O + (size_t)row * DM + c + 4);
        if (NO == 2) { o0 += *(const GAS f32x4*)(O + (size_t)(MTOT + row) * DM + c); o1 += *(const GAS f32x4*)(O + (size_t)(MTOT + row) * DM + c + 4); }
        const float ss = wave_sum((o0.x * o0.x + o0.y * o0.y) + (o0.z * o0.z + o0.w * o0.w) + (o1.x * o1.x + o1.y * o1.y) + (o1.z * o1.z + o1.w * o1.w));
        const float r = 1.0f / sqrtf(ss * (1.0f / HV) + RMS_EPS);
        const f32x4 g0 = *(const GAS f32x4*)(gain + c), g1 = *(const GAS f32x4*)(gain + c + 4);
        const v4u gw = *(const GAS v4u*)(PROJ + (size_t)row * NPROJ + CG + c);
        v4u w; w.x = pk2(o0.x * r * g0.x * bflo(gw.x), o0.y * r * g0.y * bfhi(gw.x)); w.y = pk2(o0.z * r * g0.z * bflo(gw.y), o0.w * r * g0.w * bfhi(gw.y));
        w.z = pk2(o1.x * r * g1.x * bflo(gw.z), o1.y * r * g1.y * bfhi(gw.z)); w.w = pk2(o1.z * r * g1.z * bflo(gw.w), o1.w * r * g1.w * bfhi(gw.w));
        *(GAS v4u*)(A + (size_t)row * DM + c) = w; }
}

typedef float f32x16 __attribute__((ext_vector_type(16)));
__device__ __forceinline__ int swap23(int d) { return (d & ~12) | ((d & 4) << 1) | ((d & 8) >> 1); }
constexpr int PREP_ROW = 528;
constexpr int PREP_QS = 0, PREP_KS = 64 * PREP_ROW, PREP_AL = 2 * 64 * PREP_ROW, PREP_TOT = PREP_AL + 4096;
constexpr int N_PREP_A = NCG * 4 * 2, N_PREP_V = NCG * 4;
constexpr int VT_ROW = 1040;

__device__ __forceinline__ void phase_gla_prep(const Frame& F, const Params& p, int l) {
    const bf16* PROJ = (const bf16*)(p.ws + WS_PROJ);
    bf16* QI = (bf16*)(p.ws + WS_QI); bf16* KST = (bf16*)(p.ws + WS_KST); bf16* PM = (bf16*)(p.ws + WS_PM); float* DCB = (float*)(p.ws + WS_DCB); bf16* VT = (bf16*)(p.ws + WS_VT);
    for (int item = F.vcu; item < N_PREP_A + N_PREP_V; item += F.G) {
        if (item < N_PREP_A) {
            const int cg = item >> 3, h = (item >> 1) & 3, dir = item & 1, r0 = cg * 64;
            LAS float* AL = (LAS float*)(F.lds + PREP_AL); LAS float* TOT = (LAS float*)(F.lds + PREP_TOT);
            LAS unsigned short* QS = (LAS unsigned short*)(F.lds + PREP_QS); LAS unsigned short* KS = (LAS unsigned short*)(F.lds + PREP_KS);
            { const int j = F.tid >> 3, r2 = (F.tid & 7) * 2; const unsigned w = *(const GAS unsigned*)(PROJ + (size_t)(r0 + j) * NPROJ + CA + dir * 16 + r2); AL[j * 16 + r2] = bflo(w); AL[j * 16 + r2 + 1] = bfhi(w); }
            const int d = F.tid & 255, jh = F.tid >> 8;
            float w[16];
#pragma unroll
            for (int r = 0; r < 16; ++r) w[r] = p.w_dup[(((size_t)l * 2 + dir) * RANK + r) * 1024 + h * HK + d];
            const float bz = p.b_dup[((size_t)l * 2 + dir) * 1024 + h * HK + d];
            __syncthreads();
            float ex[32]; float run = 0.f;
#pragma unroll
            for (int jo = 0; jo < 32; ++jo) { const LAS f32x4* a = (const LAS f32x4*)(AL + (jh * 32 + jo) * 16); float z = bz;
#pragma unroll
                for (int r4 = 0; r4 < 4; ++r4) { const f32x4 av = a[r4]; z += av.x * w[4 * r4] + av.y * w[4 * r4 + 1] + av.z * w[4 * r4 + 2] + av.w * w[4 * r4 + 3]; }
                ex[jo] = run; run += log_sigmoid_f(z) * 0.0625f; }
            TOT[jh * 256 + d] = run;
            __syncthreads();
            const float t0 = TOT[d], t1 = TOT[256 + d], tot = run;
            const float first = dir ? t1 : t0;
            const float last = t0 + t1;
            const float off = (jh == dir) ? 0.f : first;
            const float Eref = __expf(first), Elr = __expf(last - first);
            const size_t gi = ((size_t)dir * NCG + cg) * 4 + h;
            if (jh == 0) DCB[gi * 256 + d] = __expf(last);
            unsigned kpack[16];
            const int dq = (d & ~15) + swap23(d & 15);
#pragma unroll
            for (int jo = 0; jo < 32; ++jo) { const int j = jh * 32 + jo;
                const float incl = (jo < 31) ? ex[(jo + 1) & 31] : tot;
                const float cum = (dir ? (tot - ex[jo]) : incl) + off;
                const float x = cum - first, e1 = __expf(x), e2 = __expf(-x);
                const bf16* pr = PROJ + (size_t)(r0 + j) * NPROJ;
                const float q = bf2f(pr[CQ + h * HK + d]), k = bf2f(pr[CK + h * HK + d]);
                const float qin = q * e1, kin = k * e2;
                QS[j * (PREP_ROW / 2) + d] = (unsigned short)f2bf(qin); KS[j * (PREP_ROW / 2) + d] = (unsigned short)f2bf(kin);
                QI[((size_t)dir * MTOT + r0 + j) * 1024 + h * HK + dq] = (bf16)f2bf(qin * Eref);
                const unsigned kb = f2bf(kin * Elr); if (jo & 1) kpack[jo >> 1] |= kb << 16; else kpack[jo >> 1] = kb; }
            { GAS v4u* kp = (GAS v4u*)(KST + (gi * 256 + d) * 64 + jh * 32);
#pragma unroll
              for (int c = 0; c < 4; ++c) kp[c] = (v4u){kpack[4 * c], kpack[4 * c + 1], kpack[4 * c + 2], kpack[4 * c + 3]}; }
            __syncthreads();
            { const int ti = F.wave >> 1, fr = F.lane & 15, fq = F.lane >> 4;
#pragma unroll
              for (int q2 = 0; q2 < 2; ++q2) { const int tj = (F.wave & 1) * 2 + q2; f32x4 acc = {0.f, 0.f, 0.f, 0.f};
#pragma unroll
                for (int ks = 0; ks < 8; ++ks) { const bf16x8 a = *(const LAS bf16x8*)(F.lds + PREP_KS + (16 * tj + fr) * PREP_ROW + (32 * ks + 8 * fq) * 2);
                    const bf16x8 bq = *(const LAS bf16x8*)(F.lds + PREP_QS + (16 * ti + fr) * PREP_ROW + (32 * ks + 8 * fq) * 2);
                    acc = __builtin_amdgcn_mfma_f32_16x16x32_bf16(a, bq, acc, 0, 0, 0); }
                const int i = 16 * ti + fr, j0 = 16 * tj + 4 * fq; float v[4];
#pragma unroll
                for (int reg = 0; reg < 4; ++reg) { const int j = j0 + reg; const bool keep = dir ? (j >= i) : (j <= i); v[reg] = keep ? acc[reg] : 0.f; }
                *(GAS u32x2g*)(PM + (gi * 64 + i) * 64 + j0) = (u32x2g){pk2(v[0], v[1]), pk2(v[2], v[3])}; } }
            __syncthreads();
        } else {
            const int it = item - N_PREP_A, cg = it >> 2, h = it & 3, r0 = cg * 64;
#pragma unroll
            for (int k = 0; k < 8; ++k) { const int id = F.tid + NTHREADS * k, row = id >> 6, c = id & 63;
                const v4u x = *(const GAS v4u*)(PROJ + (size_t)(r0 + row) * NPROJ + CV + h * HV + 8 * c); *(LAS v4u*)(F.lds + row * VT_ROW + 16 * c) = x; }
            __syncthreads();
#pragma unroll
            for (int k = 0; k < 8; ++k) { const int id = F.tid + NTHREADS * k, v = id & 511, jb = id >> 9; unsigned e[8];
#pragma unroll
                for (int jj = 0; jj < 8; ++jj) e[jj] = *(const LAS unsigned short*)(F.lds + (8 * jb + jj) * VT_ROW + 2 * v);
                *(GAS v4u*)(VT + (((size_t)cg * 4 + h) * 512 + v) * 64 + 8 * jb) = (v4u){e[0] | (e[1] << 16), e[2] | (e[3] << 16), e[4] | (e[5] << 16), e[6] | (e[7] << 16)}; }
            __syncthreads();
        }
    }
}

#define MFMA32(a, b, c) __builtin_amdgcn_mfma_f32_32x32x16_bf16((a), (b), (c), 0, 0, 0)
__device__ __forceinline__ bf16x8 pack_step(const f32x16& x, int s) {
    v4u pk;
    asm volatile("v_cvt_pk_bf16_f32 %0, %4, %5\n\tv_cvt_pk_bf16_f32 %1, %6, %7\n\tv_cvt_pk_bf16_f32 %2, %8, %9\n\tv_cvt_pk_bf16_f32 %3, %10, %11\n\ts_nop 1"
                 : "=&v"(pk[0]), "=&v"(pk[1]), "=&v"(pk[2]), "=&v"(pk[3])
                 : "v"(x[8 * s]), "v"(x[8 * s + 1]), "v"(x[8 * s + 2]), "v"(x[8 * s + 3]), "v"(x[8 * s + 4]), "v"(x[8 * s + 5]), "v"(x[8 * s + 6]), "v"(x[8 * s + 7]));
    return __builtin_bit_cast(bf16x8, pk);
}
constexpr int SC_RING = 0, SC_EX = 65536, SC_EXSZ = 13312, SC_OST = SC_EX + 2 * SC_EXSZ;
static_assert(SC_OST + 8192 <= RING_BYTES, "scan LDS map");
__device__ __forceinline__ void glds16(const unsigned char* ws, unsigned off, LAS unsigned char* l) { __builtin_amdgcn_global_load_lds((const unsigned*)(ws + off), (LAS unsigned*)l, 16, 0, 0); }
__device__ __forceinline__ int scan_chunk(int n, int b, int dir) { n = n > 67 ? 67 : n; return n < 4 ? 128 + 4 * b + (dir ? 3 - n : n) : 64 * b + (dir ? 67 - n : n - 4); }
#define SC_WAIT_V(n) asm volatile("s_waitcnt vmcnt(" #n ")" ::: "memory")
#define SC_FENCE() asm volatile("" ::: "memory")

__device__ __forceinline__ void phase_gla_scan(const Frame& F, const Params& p) {
    if (F.wave != 0) return;
    const int item = F.vcu; if (item >= 256) return;
    const int g16 = item >> 4, vs = item & 15, b = g16 >> 3, h = (g16 >> 1) & 3, dir = g16 & 1;
    const int lane = F.lane, r = lane & 31, hh = lane >> 5;
    LAS unsigned char* lds = F.lds; const unsigned char* ws = p.ws;
    const unsigned QI0 = (unsigned)(WS_QI + ((size_t)dir * MTOT * 1024 + h * HK) * 2), KST0 = (unsigned)(WS_KST + ((size_t)dir * NCG * 4 + h) * 32768);
    const unsigned PM0 = (unsigned)(WS_PM + ((size_t)dir * NCG * 4 + h) * 8192), DC0 = (unsigned)(WS_DCB + ((size_t)dir * NCG * 4 + h) * 1024), VT0 = (unsigned)(WS_VT + ((size_t)h * 512 + vs * 32) * 128);
    const unsigned O0 = (unsigned)(WS_O + ((size_t)dir * MTOT * DM + h * HV + vs * 32) * 4);
    const unsigned qoff0 = (unsigned)((lane >> 2) * 2048 + 16 * ((lane & 3) ^ ((lane >> 4) & 3)));
    const unsigned koffe = (unsigned)((lane >> 3) * 128 + 16 * ((lane & 7) ^ ((lane >> 4) & 3))), koffo = (unsigned)((lane >> 3) * 128 + 16 * ((lane & 7) ^ (((lane >> 4) & 3) + 4)));
    const unsigned doff = (unsigned)lane * 16u;
    const int xq = (r >> 2) & 3, xk = (r >> 1) & 7;
#define SC_ISSUE_S(cgx, t) do { const unsigned qb_ = QI0 + (unsigned)(cgx) * 131072u + (t) * 64, kb_ = KST0 + (unsigned)(cgx) * 131072u + (t) * 4096; \
        _Pragma("unroll") for (int k_ = 0; k_ < 4; ++k_) glds16(ws, qb_ + k_ * 32768 + qoff0, lds + SC_RING + (t) * 8192 + k_ * 1024); \
        _Pragma("unroll") for (int k_ = 0; k_ < 4; ++k_) glds16(ws, kb_ + k_ * 1024 + ((k_ & 1) ? koffo : koffe), lds + SC_RING + (t) * 8192 + 4096 + k_ * 1024); } while (0)
#define SC_ISSUE_E(cgx, par) do { LAS unsigned char* e_ = lds + SC_EX + (par) * SC_EXSZ; const unsigned pb_ = PM0 + (unsigned)(cgx) * 32768u, vb_ = VT0 + (unsigned)(cgx) * 262144u, db_ = DC0 + (unsigned)(cgx) * 4096u; \
        _Pragma("unroll") for (int k_ = 0; k_ < 8; ++k_) glds16(ws, pb_ + k_ * 1024 + ((k_ & 1) ? koffo : koffe), e_ + k_ * 1024); \
        _Pragma("unroll") for (int k_ = 0; k_ < 4; ++k_) glds16(ws, vb_ + k_ * 1024 + ((k_ & 1) ? koffo : koffe), e_ + 8192 + k_ * 1024); \
        glds16(ws, db_ + doff, e_ + 12288); } while (0)
    f32x16 S[8], o0, o1;
#pragma unroll
    for (int t = 0; t < 8; ++t)
#pragma unroll
        for (int i = 0; i < 16; ++i) S[t][i] = 0.f;
#pragma unroll
    for (int i = 0; i < 16; ++i) { o0[i] = 0.f; o1[i] = 0.f; }
#define SC_DSTAGE(t, E) do { const LAS unsigned char* sl_ = lds + SC_RING + (t) * 8192; \
        { const bf16x8 qa00 = *(const LAS bf16x8*)(sl_ + r * 64 + 16 * ((0 + hh) ^ xq)), qa01 = *(const LAS bf16x8*)(sl_ + r * 64 + 16 * ((2 + hh) ^ xq)); \
          const bf16x8 qa10 = *(const LAS bf16x8*)(sl_ + (32 + r) * 64 + 16 * ((0 + hh) ^ xq)), qa11 = *(const LAS bf16x8*)(sl_ + (32 + r) * 64 + 16 * ((2 + hh) ^ xq)); \
          const bf16x8 sp0 = pack_step(S[t], 0), sp1 = pack_step(S[t], 1); \
          o0 = MFMA32(qa00, sp0, o0); o1 = MFMA32(qa10, sp0, o1); o0 = MFMA32(qa01, sp1, o0); o1 = MFMA32(qa11, sp1, o1); } \
        SC_FENCE(); \
        _Pragma("unroll") for (int g = 0; g < 4; ++g) { const f32x4 dc_ = *(const LAS f32x4*)((E) + 12288 + (32 * (t) + 8 * g + 4 * hh) * 4); \
            S[t][4 * g] *= dc_.x; S[t][4 * g + 1] *= dc_.y; S[t][4 * g + 2] *= dc_.z; S[t][4 * g + 3] *= dc_.w; } \
        SC_FENCE(); \
        _Pragma("unroll") for (int s4 = 0; s4 < 4; ++s4) { const bf16x8 ka_ = *(const LAS bf16x8*)(sl_ + 4096 + r * 128 + 16 * ((2 * s4 + hh) ^ xk)); const bf16x8 vb_ = *(const LAS bf16x8*)((E) + 8192 + r * 128 + 16 * ((2 * s4 + hh) ^ xk)); S[t] = MFMA32(ka_, vb_, S[t]); } \
        SC_FENCE(); } while (0)

    int cg = scan_chunk(0, b, dir);
    SC_ISSUE_E(cg, 0); SC_ISSUE_S(cg, 0); SC_ISSUE_S(cg, 1); SC_ISSUE_S(cg, 2); SC_ISSUE_S(cg, 3);
    for (int n = 0; n < 68; ++n) {
        const int par = n & 1, cgn = scan_chunk(n + 1, b, dir);
        const LAS unsigned char* E = lds + SC_EX + par * SC_EXSZ;
        SC_ISSUE_S(cg, 4); SC_WAIT_V(32);
        SC_DSTAGE(0, E);
        SC_ISSUE_S(cg, 5); SC_WAIT_V(32); SC_DSTAGE(1, E);
        SC_ISSUE_S(cg, 6); SC_WAIT_V(32); SC_DSTAGE(2, E);
        SC_ISSUE_S(cg, 7); SC_WAIT_V(32); SC_DSTAGE(3, E);
        SC_ISSUE_E(cgn, par ^ 1); SC_WAIT_V(37); SC_DSTAGE(4, E);
        SC_ISSUE_S(cgn, 0); SC_WAIT_V(37); SC_DSTAGE(5, E);
        SC_ISSUE_S(cgn, 1); SC_WAIT_V(37); SC_DSTAGE(6, E);
        SC_ISSUE_S(cgn, 2); SC_WAIT_V(37); SC_DSTAGE(7, E);
        SC_ISSUE_S(cgn, 3);
#pragma unroll
        for (int s4 = 0; s4 < 4; ++s4) { const bf16x8 pa0 = *(const LAS bf16x8*)(E + r * 128 + 16 * ((2 * s4 + hh) ^ xk)), pa1 = *(const LAS bf16x8*)(E + (32 + r) * 128 + 16 * ((2 * s4 + hh) ^ xk));
            const bf16x8 vb = *(const LAS bf16x8*)(E + 8192 + r * 128 + 16 * ((2 * s4 + hh) ^ xk)); o0 = MFMA32(pa0, vb, o0); o1 = MFMA32(pa1, vb, o1); }
        SC_FENCE();
        { LAS float* ost = (LAS float*)(lds + SC_OST);
#pragma unroll
          for (int i = 0; i < 16; ++i) { const int row = 8 * (i >> 2) + 4 * hh + (i & 3); ost[row * 32 + r] = o0[i]; ost[(32 + row) * 32 + r] = o1[i]; o0[i] = 0.f; o1[i] = 0.f; }
          asm volatile("s_waitcnt lgkmcnt(0)" ::: "memory");
          const unsigned ob = O0 + (unsigned)cg * (64u * DM * 4u) + (unsigned)((lane >> 3) * (DM * 4) + 16 * (lane & 7));
#pragma unroll
          for (int k = 0; k < 8; ++k) { const f32x4 v = *(const LAS f32x4*)(ost + (8 * k + (lane >> 3)) * 32 + 4 * (lane & 7)); *(GAS f32x4*)(ws + ob + (unsigned)(k * 8 * DM * 4)) = v; }
          asm volatile("s_waitcnt lgkmcnt(0)" ::: "memory"); }
        cg = cgn;
    }
    SC_WAIT_V(0);
#undef SC_ISSUE_S
#undef SC_ISSUE_E
#undef SC_DSTAGE
}

enum { PH_PRO_A = 0, PH_PRO_B, PH_WIN, PH_LA, PH_GLA, PH_GOUT, PH_POOL0, PH_POOL1, PH_PGRP, PH_PPO, PH_GO, PH_WOUT, PH_LN0, PH_FFI, PH_FFO, PH_LN1, PH_COUNT };

template <int PH> __device__ __forceinline__ void run_phase(const Frame& F0, const Params& p0, int l) {
    Frame F = F0; asm volatile("" : "+v"(F.tid));
    F.lane = F.tid & 63; F.wave = __builtin_amdgcn_readfirstlane(F.tid >> 6); F.gw = F.vcu * NWAVES + F.wave;
    Params p = p0; asm volatile("" : "+s"(p.ws));
    const int M = (l == DEPTH - 1) ? MLAT : MTOT;
    bf16* H = (bf16*)(p.ws + WS_H); bf16* PROJ = (bf16*)(p.ws + WS_PROJ); bf16* ACT = (bf16*)(p.ws + WS_ACT); float* X = (float*)(p.ws + WS_X); float* V = (float*)(p.ws + WS_V);
    bf16* AGLA = (bf16*)(p.ws + WS_AGLA); bf16* T = (bf16*)(p.ws + WS_T); bf16* U = (bf16*)(p.ws + WS_U); float* TEMP = (float*)(p.ws + WS_TEMP); bf16* MRG = (bf16*)(p.ws + WS_MRG);
    pg8::StaticOrder S;
    if constexpr (PH == PH_PRO_A) phase_prologue_a(F, p);
    if constexpr (PH == PH_PRO_B) phase_prologue_b(F, p);
    if constexpr (PH == PH_WIN) { pg8::Gemm g{H, wlayer(p, l, WO_IN), MTOT, NPROJ, DM}; S.init(MTOT, NPROJ, F.G, (int)blockIdx.x); EpiProj E{PROJ};
        pg8::gemm_phase<EpiProj, pg8::StaticOrder, true, true>(F.lds, g, S, E); }
    if constexpr (PH == PH_LA) phase_gla_prep(F, p, l);
    if constexpr (PH == PH_GLA) phase_gla_scan(F, p);
    if constexpr (PH == PH_GOUT) phase_gout<2>(F, p, l, M);
    if constexpr (PH == PH_POOL0) phase_pool(F, p, 0);
    if constexpr (PH == PH_POOL1) phase_pool(F, p, 1);
    if constexpr (PH == PH_PGRP) { pg8::Gemm g{T, wlayer(p, l, WO_PG), M, 1024, 1024}; S.init(M, 1024, F.G, (int)blockIdx.x); EpiBf16Plain E{U, 1024};
        pg8::gemm_phase<EpiBf16Plain, pg8::StaticOrder, true, true>(F.lds, g, S, E); }
    if constexpr (PH == PH_PPO) { pg8::Gemm g{U, wlayer(p, l, WO_PO), MLAT, DM, DPOOL}; S.init(MLAT, DM, F.G, (int)blockIdx.x); EpiGateTemp E{TEMP, PROJ};
        pg8::gemm_phase<EpiGateTemp, pg8::StaticOrder, true, true>(F.lds, g, S, E);
        if (l < DEPTH - 1) small_gemm_ctx(F, U, wlayer(p, l, WO_PO), DPOOL, E); }
    if constexpr (PH == PH_GO) { pg8::Gemm g{AGLA, wlayer(p, l, WO_GO), MLAT, DM, DM}; S.init(MLAT, DM, F.G, (int)blockIdx.x); EpiMerge E{MRG, TEMP, PROJ};
        pg8::gemm_phase<EpiMerge, pg8::StaticOrder, true, true>(F.lds, g, S, E);
        if (l < DEPTH - 1) small_gemm_ctx(F, AGLA, wlayer(p, l, WO_GO), DM, E); }
    if constexpr (PH == PH_WOUT) { pg8::Gemm g{MRG, wlayer(p, l, WO_OUT), MLAT, DM, DM}; S.init(MLAT, DM, F.G, (int)blockIdx.x);
        EpiResid E{V, l == 0 ? p.x : X, l == 0 ? p.ctx : X + (size_t)MLAT * DM, modv(p, l, 0, 2)};
        pg8::gemm_phase<EpiResid, pg8::StaticOrder, true, true>(F.lds, g, S, E);
        if (l < DEPTH - 1) small_gemm_ctx(F, MRG, wlayer(p, l, WO_OUT), DM, E); }
    if constexpr (PH == PH_LN0) phase_ln(F, p, l, 0, M);
    if constexpr (PH == PH_FFI) { pg8::Gemm g{H, wlayer(p, l, WO_FI), M, NFFI, DM}; S.init(M, NFFI, F.G, (int)blockIdx.x); EpiSwiglu E{ACT};
        pg8::gemm_phase<EpiSwiglu, pg8::StaticOrder, true, true>(F.lds, g, S, E); }
    if constexpr (PH == PH_FFO) { pg8::Gemm g{ACT, wlayer(p, l, WO_FO), MLAT, DM, DFF}; S.init(MLAT, DM, F.G, (int)blockIdx.x);
        EpiResid E{V, X, X + (size_t)MLAT * DM, modv(p, l, 0, 5)};
        pg8::gemm_phase<EpiResid, pg8::StaticOrder, true, true>(F.lds, g, S, E);
        if (l < DEPTH - 1) small_gemm_ctx(F, ACT, wlayer(p, l, WO_FO), DFF, E); }
    if constexpr (PH == PH_LN1) phase_ln(F, p, l, 1, M);
}
__device__ __forceinline__ Frame make_frame(unsigned char* lds) {
    Frame F; F.lds = (LAS unsigned char*)lds; F.tid = threadIdx.x; F.lane = F.tid & 63; F.wave = __builtin_amdgcn_readfirstlane(F.tid >> 6);
    F.G = gridDim.x; const int bx = blockIdx.x; F.vcu = (F.G % 8 == 0) ? (bx % 8) * (F.G / 8) + bx / 8 : bx; F.gw = F.vcu * NWAVES + F.wave; F.NGW = F.G * NWAVES;
    return F;
}

constexpr int CW_BAR = 4096;
__device__ __forceinline__ XcdBarrier mkbar(const Params& p, unsigned x, volatile LAS unsigned* st) { unsigned char* w = p.ws; asm volatile("" : "+s"(w), "+s"(x)); XcdBarrier b; b.bar = (unsigned*)(w + WS_CTL) + CW_BAR; b.x = x; b.st = st; return b; }
#define PHASE(ph, l) do { run_phase<ph>(F, p, (l)); xcd_barrier(mkbar(p, bar_x, bar_st)); } while (0)
__global__ void __launch_bounds__(NTHREADS, 2) k_mega(Params p) {
    extern __shared__ __attribute__((aligned(16))) unsigned char lds[];
    const Frame F = make_frame(lds);
    for (int u = F.tid; u < (LDS_BYTES - RING_BYTES) / 4; u += NTHREADS) ((LAS unsigned*)(F.lds + RING_BYTES))[u] = 0u;
    __syncthreads();
    volatile LAS unsigned* const bar_st = (volatile LAS unsigned*)(F.lds + MISC_OFF) + 8;
    const unsigned bar_x = xcd_barrier_post((unsigned*)(p.ws + WS_CTL) + CW_BAR, bar_st).x;
    PHASE(PH_PRO_A, 0);
    PHASE(PH_PRO_B, 0);
    for (int l = 0; l < DEPTH; ++l) {
        PHASE(PH_WIN, l);
        PHASE(PH_LA, l);
        PHASE(PH_GLA, l);
        PHASE(PH_GOUT, l);
        PHASE(PH_POOL0, l);
        PHASE(PH_POOL1, l);
        PHASE(PH_PGRP, l);
        PHASE(PH_PPO, l);
        PHASE(PH_GO, l);
        PHASE(PH_WOUT, l);
        PHASE(PH_LN0, l);
        PHASE(PH_FFI, l);
        PHASE(PH_FFO, l);
        if (l < DEPTH - 1) PHASE(PH_LN1, l); else run_phase<PH_LN1>(F, p, l);
    }
}

extern "C" void kernel_launch(void* const* d_in, const int* in_sizes, int n_in, void* d_out, int out_size, void* d_ws, size_t ws_size, hipStream_t stream) {
    static int grid = 0;
    if (grid == 0) {
        if (n_in != 21 || out_size != MLAT * DM || ws_size < WS_END) { fprintf(stderr, "kernel_launch: unexpected problem (n_in %d, out %d, ws %zu, need %zu)\n", n_in, out_size, ws_size, (size_t)WS_END); grid = -1; return; }
        int dev = 0, cus = 0, per_cu = 0;
        if (hipGetDevice(&dev) != hipSuccess || hipDeviceGetAttribute(&cus, hipDeviceAttributeMultiprocessorCount, dev) != hipSuccess) { grid = -1; return; }
        if (hipFuncSetAttribute((const void*)k_mega, hipFuncAttributeMaxDynamicSharedMemorySize, LDS_BYTES) != hipSuccess) { fprintf(stderr, "kernel_launch: hipFuncSetAttribute failed\n"); grid = -1; return; }
        if (hipOccupancyMaxActiveBlocksPerMultiprocessor(&per_cu, (const void*)k_mega, NTHREADS, LDS_BYTES) != hipSuccess || per_cu < 1) fprintf(stderr, "kernel_launch: occupancy query reports %d workgroups per CU\n", per_cu);
        (void)hipGetLastError();
        grid = cus;
    }
    if (grid < 0) return;
    (void)hipMemsetAsync((char*)d_ws + WS_CTL, 0, CTL_BYTES, stream);
    Params p{};
    const float** pp = (const float**)&p;
    for (int i = 0; i < 21; ++i) pp[i] = (const float*)d_in[i];
    p.out = (float*)d_out; p.ws = (unsigned char*)d_ws; p.layer = 0; p.pad = 0;
    hipLaunchKernelGGL(k_mega, dim3(grid), dim3(NTHREADS), LDS_BYTES, stream, p);
}
```

```cpp
#include <hip/hip_runtime.h>
#include <cstdio>
#include <cstdint>
namespace pg8 {
#define PG8_LAS __attribute__((address_space(3)))
typedef unsigned short bf16_t;
typedef short bf16x8 __attribute__((ext_vector_type(8)));
typedef float f32x4 __attribute__((ext_vector_type(4)));
typedef unsigned u32x4 __attribute__((ext_vector_type(4)));
constexpr int BM = 256, BK = 64, HALF = 128, HTB = HALF * BK * 2  , STAGE_BYTES = 8 * HTB, NXCD = 8, WGM = 8;

__host__ __device__ __forceinline__ int lds_byte(int r, int c) { const int st = (r >> 4) * 2 + (c >> 5), rr = r & 15, cc = c & 31, ob = rr * 64 + cc * 2; return st * 1024 + (ob ^ (((ob >> 9) & 1) << 5)); }
__host__ __device__ __forceinline__ void stage_rc(int b, int& R, int& C) { const int st = b / 1024, sb = b % 1024, swz = sb ^ (((sb >> 9) & 1) << 5); R = (st >> 1) * 16 + swz / 64; C = (st & 1) * 32 + (swz % 64) / 2; }
__host__ __device__ __forceinline__ int perm32(int rho) { const int n = rho >> 4, i = rho & 15; return 8 * (i >> 2) + 4 * n + (i & 3); }

struct Unit { int pm, pn; };
struct Gemm { const bf16_t* A; const bf16_t* Bt; int M, N, K; };

struct StaticOrder {
    int nM, nN, nwg, G, c;
    __host__ __device__ void init(int M, int N, int G_, int c_) { nM = M / BM; nN = N / BM; nwg = nM * nN; G = G_; c = c_; }
    __host__ __device__ bool next(int i, Unit& u) const {
        const long L = (long)i * G + c; if (L >= nwg) return false;
        int wgid = (int)L; { const int q = nwg / NXCD, r = nwg % NXCD, xcd = wgid % NXCD, off = wgid / NXCD; wgid = (xcd < r ? xcd * (q + 1) : r * (q + 1) + (xcd - r) * q) + off; }
        const int nig = WGM * nN, gid = wgid / nig, fm = gid * WGM, gsz = (nM - fm) < WGM ? (nM - fm) : WGM;
        u.pm = fm + ((wgid % nig) % gsz); u.pn = (wgid % nig) / gsz; return true;
    }
    __device__ __forceinline__ void a_ready(const Unit&) const {}
    __device__ __forceinline__ void done(const Unit&) const {}
};
__device__ __forceinline__ unsigned cvt_pk_bf16(float lo, float hi) { unsigned r; asm volatile("v_cvt_pk_bf16_f32 %0, %1, %2" : "=v"(r) : "v"(lo), "v"(hi)); return r; }
template <class Epi, class Sched, bool ALIGN_EPI = false, bool SP2 = false>
__device__ __forceinline__ void gemm_phase(PG8_LAS unsigned char* lds, const Gemm g, const Sched& S, const Epi& E) {
    int tid_ = threadIdx.x; asm volatile("" : "+v"(tid_));
    const int tid = tid_, wid = __builtin_amdgcn_readfirstlane(tid >> 6), lane = tid & 63, wr = wid >> 2, wc = wid & 3, fr = lane & 15, fq = lane >> 4;
    const int K = g.K, nt = K / BK;
    unsigned voffA[2], voffB[2];
#pragma unroll
    for (int i = 0; i < 2; ++i) { int R, C; stage_rc(tid * 16 + i * 8192, R, C); const int Rb = Epi::PERM ? ((R & ~31) + perm32(R & 31)) : R;
        voffA[i] = (unsigned)(R * K + C) * 2u; voffB[i] = (unsigned)(Rb * K + C) * 2u; }
    const size_t kstep = (size_t)(BK * 2);
    const size_t hstep = (size_t)HALF * K * 2;
    const size_t tstep = 2 * hstep;
    const unsigned ldsw = (unsigned)wid * 1024u;
    const int aoff = lds_byte(wr * 64 + fr, fq * 8), boff = lds_byte(wc * 32 + fr, fq * 8);
#define PG8_SA(b, h) (((b) * 2 + (h)) * HTB)
#define PG8_SB(b, h) ((4 + (b) * 2 + (h)) * HTB)
#define PG8_STAGE(bufoff, gbase, voff) do { _Pragma("unroll") for (int _i = 0; _i < 2; ++_i) \
        __builtin_amdgcn_global_load_lds((const unsigned*)((const char*)(gbase) + (voff)[_i]), (PG8_LAS unsigned*)(lds + (bufoff) + ldsw + _i * 8192), 16, 0, 0); } while (0)
#define PG8_LDA(dst, b, h) do { _Pragma("unroll") for (int m = 0; m < 4; ++m) _Pragma("unroll") for (int k = 0; k < 2; ++k) dst[m][k] = *(const PG8_LAS bf16x8*)(lds + PG8_SA(b, h) + aoff + m * 2048 + k * 1024); } while (0)
#define PG8_LDB(dst, b, h) do { _Pragma("unroll") for (int n = 0; n < 2; ++n) _Pragma("unroll") for (int k = 0; k < 2; ++k) dst[n][k] = *(const PG8_LAS bf16x8*)(lds + PG8_SB(b, h) + boff + n * 2048 + k * 1024); } while (0)
#define PG8_MMA(ai, bj, At, Bt) do { __builtin_amdgcn_s_setprio(1); _Pragma("unroll") for (int m = 0; m < 4; ++m) _Pragma("unroll") for (int n = 0; n < 2; ++n) _Pragma("unroll") for (int k = 0; k < 2; ++k) \
        acc[ai][bj][m][n] = __builtin_amdgcn_mfma_f32_16x16x32_bf16(Bt[n][k], At[m][k], acc[ai][bj][m][n], 0, 0, 0); __builtin_amdgcn_s_setprio(0); } while (0)
#define PG8_WAIT_V(n) asm volatile("s_waitcnt vmcnt(" #n ")" ::: "memory")
#define PG8_WAIT_L(n) asm volatile("s_waitcnt lgkmcnt(" #n ")" ::: "memory")
#define PG8_BAR __builtin_amdgcn_s_barrier()
#define PG8_SCHED __builtin_amdgcn_sched_barrier(0)
    Unit cur, nxt; int ui = 0;
    if (!S.next(0, cur)) return;
    f32x4 acc[2][2][4][2];
#pragma unroll
    for (int a = 0; a < 2; ++a)
#pragma unroll
        for (int b = 0; b < 2; ++b)
#pragma unroll
            for (int m = 0; m < 4; ++m)
#pragma unroll
                for (int n = 0; n < 2; ++n) acc[a][b][m][n] = (f32x4){0.f, 0.f, 0.f, 0.f};
    bf16x8 At[4][2], B0[2][2], B1[2][2];
    const char* cA = (const char*)g.A + (size_t)cur.pm * tstep; const char* cB = (const char*)g.Bt + (size_t)cur.pn * tstep;
    S.a_ready(cur);
    if constexpr (SP2) {
        PG8_STAGE(PG8_SB(0, 0), cB, voffB); PG8_STAGE(PG8_SB(0, 1), cB + hstep, voffB); PG8_STAGE(PG8_SA(0, 0), cA, voffA); PG8_STAGE(PG8_SA(0, 1), cA + hstep, voffA);
        if (wr == 1) PG8_BAR;
        PG8_WAIT_V(2); PG8_BAR;
        PG8_STAGE(PG8_SB(1, 0), cB + kstep, voffB); PG8_STAGE(PG8_SA(1, 0), cA + kstep, voffA); PG8_STAGE(PG8_SB(1, 1), cB + hstep + kstep, voffB);
        PG8_WAIT_V(6); PG8_BAR;
    } else {
        PG8_STAGE(PG8_SB(0, 0), cB, voffB); PG8_STAGE(PG8_SA(0, 0), cA, voffA); PG8_STAGE(PG8_SB(0, 1), cB + hstep, voffB); PG8_STAGE(PG8_SA(0, 1), cA + hstep, voffA);
        if (wr == 1) PG8_BAR;
        PG8_WAIT_V(4); PG8_BAR;
        PG8_STAGE(PG8_SB(1, 0), cB + kstep, voffB); PG8_STAGE(PG8_SA(1, 0), cA + kstep, voffA); PG8_STAGE(PG8_SB(1, 1), cB + hstep + kstep, voffB);
        PG8_WAIT_V(6); PG8_BAR;
    }
    for (;;) {
        const bool has_next = S.next(ui + 1, nxt);
        const char* nA = has_next ? (const char*)g.A + (size_t)nxt.pm * tstep : cA; const char* nB = has_next ? (const char*)g.Bt + (size_t)nxt.pn * tstep : cB;
        for (int t = 0; t < nt; t += 2) {
            const bool last = (t == nt - 2);
            const char* a1 = cA + (size_t)(t + 1) * kstep;
            const char* a2 = last ? nA : cA + (size_t)(t + 2) * kstep; const char* b2 = last ? nB : cB + (size_t)(t + 2) * kstep;
            const char* a3 = a2 + kstep; const char* b3 = b2 + kstep;
            if (last && has_next) S.a_ready(nxt);
            if constexpr (SP2) {
            PG8_LDB(B0, 0, 0); PG8_LDB(B1, 0, 1); PG8_SCHED; PG8_LDA(At, 0, 0); PG8_STAGE(PG8_SA(1, 1), a1 + hstep, voffA);
            PG8_WAIT_V(8); PG8_WAIT_L(0); PG8_BAR; PG8_MMA(0, 0, At, B0); PG8_MMA(0, 1, At, B1); PG8_BAR; PG8_SCHED;
            PG8_LDA(At, 0, 1); PG8_STAGE(PG8_SB(0, 0), b2, voffB); PG8_STAGE(PG8_SB(0, 1), b2 + hstep, voffB); PG8_STAGE(PG8_SA(0, 0), a2, voffA);
            PG8_WAIT_V(8); PG8_WAIT_L(0); PG8_BAR; PG8_MMA(1, 0, At, B0); PG8_MMA(1, 1, At, B1); PG8_BAR; PG8_SCHED;
            PG8_LDB(B0, 1, 0); PG8_LDB(B1, 1, 1); PG8_SCHED; PG8_LDA(At, 1, 0); PG8_STAGE(PG8_SA(0, 1), a2 + hstep, voffA);
            PG8_WAIT_V(8); PG8_WAIT_L(0); PG8_BAR; PG8_MMA(0, 0, At, B0); PG8_MMA(0, 1, At, B1); PG8_BAR; PG8_SCHED;
            PG8_LDA(At, 1, 1); PG8_STAGE(PG8_SB(1, 0), b3, voffB); PG8_STAGE(PG8_SB(1, 1), b3 + hstep, voffB); PG8_STAGE(PG8_SA(1, 0), a3, voffA);
            PG8_WAIT_V(8); PG8_WAIT_L(0); PG8_BAR; PG8_MMA(1, 0, At, B0); PG8_MMA(1, 1, At, B1); PG8_BAR; PG8_SCHED;
            } else {
            PG8_LDB(B0, 0, 0); PG8_SCHED; PG8_LDA(At, 0, 0); PG8_STAGE(PG8_SA(1, 1), a1 + hstep, voffA);
            PG8_WAIT_L(8); PG8_BAR; PG8_WAIT_L(0); PG8_MMA(0, 0, At, B0); PG8_BAR; PG8_SCHED;
            PG8_LDB(B1, 0, 1); PG8_STAGE(PG8_SB(0, 0), b2, voffB);
            PG8_BAR; PG8_WAIT_L(0); PG8_MMA(0, 1, At, B1); PG8_BAR;
            PG8_LDA(At, 0, 1); PG8_STAGE(PG8_SA(0, 0), a2, voffA);
            PG8_BAR; PG8_WAIT_L(0); PG8_MMA(1, 0, At, B0); PG8_BAR; PG8_SCHED;
            PG8_STAGE(PG8_SB(0, 1), b2 + hstep, voffB);
            PG8_WAIT_V(6); PG8_BAR; PG8_MMA(1, 1, At, B1); PG8_BAR;
            PG8_LDB(B0, 1, 0); PG8_SCHED; PG8_LDA(At, 1, 0); PG8_STAGE(PG8_SA(0, 1), a2 + hstep, voffA);
            PG8_WAIT_L(8); PG8_BAR; PG8_WAIT_L(0); PG8_MMA(0, 0, At, B0); PG8_BAR; PG8_SCHED;
            PG8_LDB(B1, 1, 1); PG8_STAGE(PG8_SB(1, 0), b3, voffB);
            PG8_BAR; PG8_WAIT_L(0); PG8_MMA(0, 1, At, B1); PG8_BAR;
            PG8_LDA(At, 1, 1); PG8_STAGE(PG8_SA(1, 0), a3, voffA);
            PG8_BAR; PG8_WAIT_L(0); PG8_MMA(1, 0, At, B0); PG8_BAR; PG8_SCHED;
            PG8_STAGE(PG8_SB(1, 1), b3 + hstep, voffB);
            PG8_WAIT_V(6); PG8_BAR; PG8_MMA(1, 1, At, B1); PG8_BAR;
            }
        }
        if constexpr (ALIGN_EPI) { if (wr == 0) PG8_BAR; }
        if constexpr (!Epi::AFTER_DRAIN) { E(acc, cur, wr, wc, fr, fq); S.done(cur); }
        if (!has_next) break;
#pragma unroll
        for (int a = 0; a < 2; ++a)
#pragma unroll
            for (int b = 0; b < 2; ++b)
#pragma unroll
                for (int m = 0; m < 4; ++m)
#pragma unroll
                    for (int n = 0; n < 2; ++n) acc[a][b][m][n] = (f32x4){0.f, 0.f, 0.f, 0.f};
        cur = nxt; cA = nA; cB = nB; ++ui;
        if constexpr (ALIGN_EPI) { if (wr == 1) PG8_BAR; }
    }
    PG8_WAIT_V(0);
    if constexpr (!ALIGN_EPI) { if (wr == 0) PG8_BAR; }
    PG8_BAR;
    if constexpr (Epi::AFTER_DRAIN) { E.fused(acc, cur, wr, wc, fr, fq, lds, wid, lane); S.done(cur); }
#undef PG8_SA
#undef PG8_SB
#undef PG8_STAGE
#undef PG8_LDA
#undef PG8_LDB
#undef PG8_MMA
#undef PG8_WAIT_V
#undef PG8_WAIT_L
#undef PG8_BAR
#undef PG8_SCHED
}
}
#define GAS __attribute__((address_space(1)))
#define LAS __attribute__((address_space(3)))
typedef unsigned short bf16;
typedef unsigned v4u __attribute__((ext_vector_type(4)));
typedef float f32x4 __attribute__((ext_vector_type(4)));
typedef short bf16x8 __attribute__((ext_vector_type(8)));
typedef GAS unsigned gu32;
typedef GAS unsigned long long gu64;
#define RLX_AGENT __ATOMIC_RELAXED, __HIP_MEMORY_SCOPE_AGENT
#define LDS_WAIT() asm volatile("s_waitcnt lgkmcnt(0)" ::: "memory")
#define VM_WAIT() asm volatile("s_waitcnt vmcnt(0)" ::: "memory")
__device__ __forceinline__ unsigned long long rt() { return __builtin_amdgcn_s_memrealtime(); }
__device__ __forceinline__ unsigned f2bf(float f) { unsigned u = __builtin_bit_cast(unsigned, f); return (u + 0x7fffu + ((u >> 16) & 1u)) >> 16; }
__device__ __forceinline__ unsigned pk2(float lo, float hi) { return f2bf(lo) | (f2bf(hi) << 16); }

#define XB_TMO      128
#define XB_XCNT(j)  (256  + 64 * (j))
#define XB_XSUB(j)  (1280 + 64 * (j))
#define XB_XGEN(j)  (2304 + 64 * (j))
#define XB_TOP      3328
#define XB_TOPGEN   3392
#define XCD_BAR_WORDS 3456
#define XB_SPIN_CAP (1u << 18)

__device__ __forceinline__ unsigned xb_ld(unsigned* p)              { return __hip_atomic_load(p, __ATOMIC_RELAXED, __HIP_MEMORY_SCOPE_AGENT); }
__device__ __forceinline__ unsigned xb_add(unsigned* p, unsigned v) { return __hip_atomic_fetch_add(p, v, __ATOMIC_RELAXED, __HIP_MEMORY_SCOPE_AGENT); }
__device__ __forceinline__ unsigned xb_xcc_id() { return (unsigned)__builtin_amdgcn_s_getreg((3 << 11) | 20) & 0xFu; }
#define XB_SPIN(cond, bar) do { unsigned _sp = 0; while (cond) { __builtin_amdgcn_s_sleep(1); \
    if ((++_sp & 255u) == 0u) { if (xb_ld(&(bar)[XB_TMO])) break; if (_sp > XB_SPIN_CAP) { atomicAdd(&(bar)[XB_TMO], 1u); break; } } } } while (0)

struct XcdBarrier {
    unsigned* bar; unsigned x;
    volatile LAS unsigned* st;
};

__device__ __forceinline__ XcdBarrier xcd_barrier_post(unsigned* bar, volatile LAS unsigned* st) {
    XcdBarrier b; b.bar = bar; b.x = xb_xcc_id(); b.st = st;
    if (threadIdx.x == 0) (void)xb_add(&bar[XB_XCNT(b.x)], 1u);
    return b;
}
__device__ __forceinline__ void xcd_barrier_complete(unsigned* bar, unsigned x, unsigned& nloc, unsigned& nx) {
    const unsigned G = gridDim.x * gridDim.y * gridDim.z;
    unsigned sum, cnt, mine, sp = 0u;
    for (;;) {
        sum = 0u; cnt = 0u; mine = 0u;
#pragma unroll
        for (unsigned j = 0; j < 16; ++j) { const unsigned c = xb_ld(&bar[XB_XCNT(j)]); sum += c; cnt += (c > 0u) ? 1u : 0u; mine = (j == x) ? c : mine; }
        if (sum == G) break;
        __builtin_amdgcn_s_sleep(1);
        if ((++sp & 255u) == 0u) { if (xb_ld(&bar[XB_TMO])) break; if (sp > XB_SPIN_CAP) { atomicAdd(&bar[XB_TMO], 1u); break; } }
    }
    nloc = mine > 0u ? mine : 1u; nx = cnt > 0u ? cnt : 1u;
}

__device__ __forceinline__ void xcd_barrier(const XcdBarrier& b) {
    asm volatile("s_waitcnt vmcnt(0)" ::: "memory");
    __syncthreads();
    if (threadIdx.x == 0) {
        unsigned* bar = b.bar;
        __builtin_amdgcn_s_waitcnt(0);
        unsigned nloc = b.st[0], nx = b.st[1];
        if (nloc == 0u) { xcd_barrier_complete(bar, b.x, nloc, nx); b.st[0] = nloc; b.st[1] = nx; }
        const unsigned old = xb_add(&bar[XB_XSUB(b.x)], 1u);
        const unsigned gen = old / nloc;
        if (old + 1u == (gen + 1u) * nloc) {
            __builtin_amdgcn_fence(__ATOMIC_RELEASE, "agent");
            asm volatile("s_waitcnt vmcnt(0)" ::: "memory");
            const unsigned og = xb_add(&bar[XB_TOP], 1u);
            const unsigned tg = og / nx;
            if (og + 1u == (tg + 1u) * nx) xb_add(&bar[XB_TOPGEN], 1u);
            else XB_SPIN(xb_ld(&bar[XB_TOPGEN]) == tg, bar);
            __builtin_amdgcn_fence(__ATOMIC_ACQUIRE, "agent");
            xb_add(&bar[XB_XGEN(b.x)], 1u);
            asm volatile("s_waitcnt vmcnt(0)" ::: "memory");
        } else {
            XB_SPIN(xb_ld(&bar[XB_XGEN(b.x)]) == gen, bar);
            __builtin_amdgcn_fence(__ATOMIC_ACQUIRE, "agent");
            asm volatile("s_waitcnt vmcnt(0)" ::: "memory");
        }
    }
    __syncthreads();
}

constexpr int DM = 2048, NBATCH = 2, SEQ = 4096, DEPTH = 4, CTXL = 256;
constexpr int NH = 4, HK = 256, HV = 512, RANK = 16;
constexpr int DPOOL = 1024, DFF = 5632, NMODV = 6 * DM;
constexpr int MLAT = NBATCH * SEQ, MCTX = NBATCH * CTXL, MTOT = MLAT + MCTX;
constexpr int NPROJ = 11520, NPROJ_SRC = 11296, NFFI = 2 * DFF;
constexpr int CQ = 0, CK = 1024, CV = 2048, CG = 4096, CP = 6144, CBG = 7168, CBP = 9216, CA = 11264;
constexpr float ALPHA = 1.6817928305074290f;
constexpr float LN_EPS = 1e-5f, RMS_EPS = 1e-6f;
constexpr int NWAVES = 8, NTHREADS = 512;
constexpr int LDS_BYTES = 147456;
constexpr int RING_BYTES = 131072, MISC_OFF = RING_BYTES + 320;

constexpr size_t al256(size_t x) { return (x + 255) & ~(size_t)255; }
constexpr size_t WS_CTL = 0, CTL_BYTES = 1u << 20;
constexpr size_t SZ_MODP = (size_t)DEPTH * 8 * 3 * NMODV * 4, SZ_MOD = (size_t)DEPTH * 3 * NMODV * 4;
constexpr size_t WS_MODP = WS_CTL + CTL_BYTES, WS_MOD = al256(WS_MODP + SZ_MODP), WS_W = al256(WS_MOD + SZ_MOD);
constexpr size_t WO_IN = 0, SZ_IN = (size_t)NPROJ * DM * 2;
constexpr size_t WO_GO = WO_IN + SZ_IN, SZ_GO = (size_t)DM * DM * 2;
constexpr size_t WO_PG = WO_GO + SZ_GO, SZ_PG = (size_t)1024 * 1024 * 2;
constexpr size_t WO_PO = WO_PG + SZ_PG, SZ_PO = (size_t)DM * 1024 * 2;
constexpr size_t WO_OUT = WO_PO + SZ_PO, SZ_OUT = (size_t)DM * DM * 2;
constexpr size_t WO_FI = WO_OUT + SZ_OUT, SZ_FI = (size_t)NFFI * DM * 2;
constexpr size_t WO_FO = WO_FI + SZ_FI, SZ_FO = (size_t)DM * DFF * 2;
constexpr size_t WO_PC = WO_FO + SZ_FO;
constexpr size_t W_LAYER = WO_PC + SZ_PO;
constexpr size_t WS_X = al256(WS_W + DEPTH * W_LAYER), SZ_X = (size_t)MTOT * DM * 4;
constexpr size_t WS_V = WS_X + SZ_X;
constexpr size_t WS_H = WS_V + SZ_X, SZ_H = (size_t)MTOT * DM * 2;
constexpr size_t WS_PROJ = WS_H + SZ_H, SZ_PROJ = (size_t)MTOT * NPROJ * 2;
constexpr size_t WS_ACT = WS_PROJ;
constexpr int NCG = MTOT / 64;
constexpr size_t WS_LA = WS_PROJ + SZ_PROJ, SZ_LA = (size_t)2 * MTOT * 1024 * 4;
constexpr size_t WS_QI = WS_LA, SZ_QI = (size_t)2 * MTOT * 1024 * 2;
constexpr size_t WS_KST = WS_QI + SZ_QI, SZ_KST = (size_t)2 * NCG * 4 * 256 * 64 * 2;
constexpr size_t WS_PM = WS_KST + SZ_KST, SZ_PM = (size_t)2 * NCG * 4 * 64 * 64 * 2;
constexpr size_t WS_DCB = WS_PM + SZ_PM, SZ_DCB = (size_t)2 * NCG * 4 * 256 * 4;
constexpr size_t WS_VT = WS_DCB + SZ_DCB, SZ_VT = (size_t)NCG * 4 * 512 * 64 * 2;
constexpr size_t WS_GLAEND = WS_VT + SZ_VT;
static_assert(WS_GLAEND >= WS_LA + SZ_LA, "overlay");
constexpr size_t WS_O = WS_GLAEND, SZ_O = (size_t)MTOT * DM * 4;
constexpr size_t WS_AGLA = WS_O + 2 * SZ_O;
constexpr size_t WS_HM = WS_AGLA + SZ_H, SZ_HM = (size_t)MTOT * 1024 * 4;
constexpr size_t WS_T = WS_HM + SZ_HM, SZ_T = (size_t)MTOT * 1024 * 2;
constexpr size_t WS_U = WS_T + SZ_T;
constexpr size_t WS_TEMP = WS_U + SZ_T;
constexpr size_t WS_MRG = WS_TEMP + SZ_X;
constexpr size_t WS_END = WS_MRG + SZ_H;

struct Params {
    const float *x, *c, *ctx, *c_ctx, *w_ada, *b_ada, *w_in, *w_dup, *b_dup, *gla_gain, *w_pg, *pool_scale, *w_go, *w_po, *w_out, *ln1g, *ln1b, *w_fi, *w_fo, *ln2g, *ln2b;
    float* out; unsigned char* ws; int layer; int pad;
};
typedef float f32x2g __attribute__((ext_vector_type(2)));
typedef unsigned u32x2g __attribute__((ext_vector_type(2)));
struct Frame { LAS unsigned char* lds; int tid, lane, wave, vcu, G, gw, NGW; };

__device__ __forceinline__ bf16* wlayer(const Params& p, int l, size_t off) { return (bf16*)(p.ws + WS_W + (size_t)l * W_LAYER + off); }
__device__ __forceinline__ const float* modv(const Params& p, int l, int mi, int which) { return (const float*)(p.ws + WS_MOD) + ((size_t)l * 3 + mi) * NMODV + (size_t)which * DM; }
__device__ __forceinline__ float bf2f(unsigned short b) { return __builtin_bit_cast(float, (unsigned)b << 16); }
__device__ __forceinline__ float bflo(unsigned w) { return __builtin_bit_cast(float, w << 16); }
__device__ __forceinline__ float bfhi(unsigned w) { return __builtin_bit_cast(float, w & 0xffff0000u); }
__device__ __forceinline__ float fast_sigmoid(float x) { return __builtin_amdgcn_rcpf(1.0f + __expf(-x)); }
__device__ __forceinline__ float wave_sum(float v) {
#pragma unroll
    for (int o = 1; o < 64; o <<= 1) v += __shfl_xor(v, o);
    return v;
}
__device__ __forceinline__ int mod_index(int row) { return row < SEQ ? 0 : (row < MLAT ? 1 : 2); }

struct EpiProj {
    static constexpr bool PERM = true, AFTER_DRAIN = false;
    bf16* O;
    __device__ __forceinline__ void operator()(const pg8::f32x4 (&acc)[2][2][4][2], const pg8::Unit& u, int wr, int wc, int fr, int fq) const {
        const int row0 = u.pm * 256 + wr * 64 + fr, col0 = u.pn * 256 + wc * 32 + 8 * fq;
        const int mode = (u.pn >= 16 && u.pn < 24) ? 1 : ((u.pn >= 28 && u.pn < 44) ? 2 : 0);
#pragma unroll
        for (int ai = 0; ai < 2; ++ai)
#pragma unroll
            for (int m = 0; m < 4; ++m) { bf16* rowp = O + (size_t)(row0 + ai * 128 + m * 16) * NPROJ + col0;
#pragma unroll
                for (int bj = 0; bj < 2; ++bj) { pg8::f32x4 v0 = acc[ai][bj][m][0], v1 = acc[ai][bj][m][1];
                    if (mode != 0) {
#pragma unroll
                        for (int j = 0; j < 4; ++j) { const float s0 = fast_sigmoid(v0[j]), s1 = fast_sigmoid(v1[j]); v0[j] = (mode == 1) ? v0[j] * s0 : s0; v1[j] = (mode == 1) ? v1[j] * s1 : s1; } }
                    pg8::u32x4 w; w.x = pg8::cvt_pk_bf16(v0[0], v0[1]); w.y = pg8::cvt_pk_bf16(v0[2], v0[3]); w.z = pg8::cvt_pk_bf16(v1[0], v1[1]); w.w = pg8::cvt_pk_bf16(v1[2], v1[3]);
                    *(pg8::u32x4*)(rowp + bj * 128) = w; } }
    }
};
struct EpiBf16Plain {
    static constexpr bool PERM = true, AFTER_DRAIN = false;
    bf16* O; int ldc;
    __device__ __forceinline__ void operator()(const pg8::f32x4 (&acc)[2][2][4][2], const pg8::Unit& u, int wr, int wc, int fr, int fq) const {
        const int row0 = u.pm * 256 + wr * 64 + fr, col0 = u.pn * 256 + wc * 32 + 8 * fq;
#pragma unroll
        for (int ai = 0; ai < 2; ++ai)
#pragma unroll
            for (int m = 0; m < 4; ++m) { bf16* rowp = O + (size_t)(row0 + ai * 128 + m * 16) * ldc + col0;
#pragma unroll
                for (int bj = 0; bj < 2; ++bj) { const pg8::f32x4 v0 = acc[ai][bj][m][0], v1 = acc[ai][bj][m][1];
                    pg8::u32x4 w; w.x = pg8::cvt_pk_bf16(v0[0], v0[1]); w.y = pg8::cvt_pk_bf16(v0[2], v0[3]); w.z = pg8::cvt_pk_bf16(v1[0], v1[1]); w.w = pg8::cvt_pk_bf16(v1[2], v1[3]);
                    *(pg8::u32x4*)(rowp + bj * 128) = w; } }
    }
};
struct EpiGateTemp {
    static constexpr bool PERM = true, AFTER_DRAIN = false;
    float* T; const bf16* PROJ;
    __device__ __forceinline__ void operator()(const pg8::f32x4 (&acc)[2][2][4][2], const pg8::Unit& u, int wr, int wc, int fr, int fq) const {
        const int row0 = u.pm * 256 + wr * 64 + fr, col0 = u.pn * 256 + wc * 32 + 8 * fq;
#pragma unroll
        for (int ai = 0; ai < 2; ++ai)
#pragma unroll
            for (int m = 0; m < 4; ++m) { const int row = row0 + ai * 128 + m * 16;
#pragma unroll
                for (int bj = 0; bj < 2; ++bj) { const int c = col0 + bj * 128;
                    const pg8::u32x4 gw = *(const pg8::u32x4*)(PROJ + (size_t)row * NPROJ + CBP + c);
                    pg8::f32x4 v0 = acc[ai][bj][m][0], v1 = acc[ai][bj][m][1];
                    v0[0] *= bflo(gw.x); v0[1] *= bfhi(gw.x); v0[2] *= bflo(gw.y); v0[3] *= bfhi(gw.y);
                    v1[0] *= bflo(gw.z); v1[1] *= bfhi(gw.z); v1[2] *= bflo(gw.w); v1[3] *= bfhi(gw.w);
                    float* tp = T + (size_t)row * DM + c; *(pg8::f32x4*)tp = v0; *(pg8::f32x4*)(tp + 4) = v1; } }
    }
    __device__ __forceinline__ void small(int row, int col, pg8::f32x4 v) const {
        const u32x2g gw = *(const u32x2g*)(PROJ + (size_t)row * NPROJ + CBP + col);
        v[0] *= bflo(gw.x); v[1] *= bfhi(gw.x); v[2] *= bflo(gw.y); v[3] *= bfhi(gw.y); *(pg8::f32x4*)(T + (size_t)row * DM + col) = v; }
};
struct EpiMerge {
    static constexpr bool PERM = true, AFTER_DRAIN = false;
    bf16* O; const float* T; const bf16* PROJ;
    __device__ __forceinline__ void operator()(const pg8::f32x4 (&acc)[2][2][4][2], const pg8::Unit& u, int wr, int wc, int fr, int fq) const {
        const int row0 = u.pm * 256 + wr * 64 + fr, col0 = u.pn * 256 + wc * 32 + 8 * fq;
#pragma unroll
        for (int ai = 0; ai < 2; ++ai)
#pragma unroll
            for (int m = 0; m < 4; ++m) { const int row = row0 + ai * 128 + m * 16;
#pragma unroll
                for (int bj = 0; bj < 2; ++bj) { const int c = col0 + bj * 128;
                    const pg8::u32x4 gw = *(const pg8::u32x4*)(PROJ + (size_t)row * NPROJ + CBG + c);
                    const float* tp = T + (size_t)row * DM + c; const pg8::f32x4 t0 = *(const pg8::f32x4*)tp, t1 = *(const pg8::f32x4*)(tp + 4);
                    pg8::f32x4 v0 = acc[ai][bj][m][0], v1 = acc[ai][bj][m][1];
                    v0[0] = v0[0] * bflo(gw.x) + t0[0]; v0[1] = v0[1] * bfhi(gw.x) + t0[1]; v0[2] = v0[2] * bflo(gw.y) + t0[2]; v0[3] = v0[3] * bfhi(gw.y) + t0[3];
                    v1[0] = v1[0] * bflo(gw.z) + t1[0]; v1[1] = v1[1] * bfhi(gw.z) + t1[1]; v1[2] = v1[2] * bflo(gw.w) + t1[2]; v1[3] = v1[3] * bfhi(gw.w) + t1[3];
                    pg8::u32x4 w; w.x = pg8::cvt_pk_bf16(v0[0], v0[1]); w.y = pg8::cvt_pk_bf16(v0[2], v0[3]); w.z = pg8::cvt_pk_bf16(v1[0], v1[1]); w.w = pg8::cvt_pk_bf16(v1[2], v1[3]);
                    *(pg8::u32x4*)(O + (size_t)row * DM + c) = w; } }
    }
    __device__ __forceinline__ void small(int row, int col, pg8::f32x4 v) const {
        const u32x2g gw = *(const u32x2g*)(PROJ + (size_t)row * NPROJ + CBG + col); const pg8::f32x4 t = *(const pg8::f32x4*)(T + (size_t)row * DM + col);
        v[0] = v[0] * bflo(gw.x) + t[0]; v[1] = v[1] * bfhi(gw.x) + t[1]; v[2] = v[2] * bflo(gw.y) + t[2]; v[3] = v[3] * bfhi(gw.y) + t[3];
        *(u32x2g*)(O + (size_t)row * DM + col) = (u32x2g){pg8::cvt_pk_bf16(v[0], v[1]), pg8::cvt_pk_bf16(v[2], v[3])}; }
};
struct EpiResid {
    static constexpr bool PERM = false, AFTER_DRAIN = false;
    float* V; const float* xlat; const float* xctx; const float* gt0;
    __device__ __forceinline__ void operator()(const pg8::f32x4 (&acc)[2][2][4][2], const pg8::Unit& u, int wr, int wc, int fr, int fq) const {
        const int row0 = u.pm * 256 + wr * 64 + fr, col0 = u.pn * 256 + wc * 32 + 4 * fq;
        const int mi = u.pm < 16 ? 0 : (u.pm < 32 ? 1 : 2);
        const float* gt = gt0 + (size_t)mi * NMODV + col0;
        pg8::f32x4 gv[2][2];
#pragma unroll
        for (int bj = 0; bj < 2; ++bj)
#pragma unroll
            for (int n = 0; n < 2; ++n) gv[bj][n] = *(const pg8::f32x4*)(gt + bj * 128 + n * 16);
#pragma unroll
        for (int ai = 0; ai < 2; ++ai)
#pragma unroll
            for (int m = 0; m < 4; ++m) { const int row = row0 + ai * 128 + m * 16;
                const float* xr = (u.pm < 32 ? xlat + (size_t)row * DM : xctx + (size_t)(row - MLAT) * DM) + col0; float* vr = V + (size_t)row * DM + col0;
#pragma unroll
                for (int bj = 0; bj < 2; ++bj)
#pragma unroll
                    for (int n = 0; n < 2; ++n) { const pg8::f32x4 xv = *(const pg8::f32x4*)(xr + bj * 128 + n * 16);
                        *(pg8::f32x4*)(vr + bj * 128 + n * 16) = xv * ALPHA + gv[bj][n] * acc[ai][bj][m][n]; } }
    }
    __device__ __forceinline__ void small(int row, int col, pg8::f32x4 v) const {
        const pg8::f32x4 g = *(const pg8::f32x4*)(gt0 + (size_t)2 * NMODV + col), xv = *(const pg8::f32x4*)(xctx + (size_t)(row - MLAT) * DM + col);
        *(pg8::f32x4*)(V + (size_t)row * DM + col) = xv * ALPHA + g * v; }
};
struct EpiSwiglu {
    static constexpr bool PERM = true, AFTER_DRAIN = false;
    bf16* O;
    __device__ __forceinline__ void operator()(const pg8::f32x4 (&acc)[2][2][4][2], const pg8::Unit& u, int wr, int wc, int fr, int fq) const {
        const int row0 = u.pm * 256 + wr * 64 + fr, col0 = u.pn * 128 + wc * 32 + 8 * fq;
#pragma unroll
        for (int ai = 0; ai < 2; ++ai)
#pragma unroll
            for (int m = 0; m < 4; ++m) { const int row = row0 + ai * 128 + m * 16;
                pg8::f32x4 a0, a1;
#pragma unroll
                for (int j = 0; j < 4; ++j) { const float g0 = acc[ai][0][m][0][j], g1 = acc[ai][0][m][1][j];
                    a0[j] = g0 * fast_sigmoid(g0) * acc[ai][1][m][0][j]; a1[j] = g1 * fast_sigmoid(g1) * acc[ai][1][m][1][j]; }
                pg8::u32x4 w; w.x = pg8::cvt_pk_bf16(a0[0], a0[1]); w.y = pg8::cvt_pk_bf16(a0[2], a0[3]); w.z = pg8::cvt_pk_bf16(a1[0], a1[1]); w.w = pg8::cvt_pk_bf16(a1[2], a1[3]);
                *(pg8::u32x4*)(O + (size_t)row * DFF + col0) = w; }
    }
};

template <class Epi> __device__ __forceinline__ void small_gemm_ctx(const Frame& F, const bf16* A, const bf16* Bt, int K, const Epi& E) {
    const int c = (int)blockIdx.x; if (c >= 256) return;
    const int rb = MLAT + 64 * (c >> 5), cb = 64 * (c & 31);
    const int fr = F.lane & 15, fq = F.lane >> 4, kw = K >> 3;
    f32x4 acc[4][4];
#pragma unroll
    for (int m = 0; m < 4; ++m)
#pragma unroll
        for (int n = 0; n < 4; ++n) acc[m][n] = (f32x4){0.f, 0.f, 0.f, 0.f};
    const bf16* ap = A + (size_t)(rb + fr) * K + F.wave * kw + 8 * fq; const bf16* bp = Bt + (size_t)(cb + fr) * K + F.wave * kw + 8 * fq;
#pragma unroll 2
    for (int ks = 0; ks < kw; ks += 32) { bf16x8 a[4], b[4];
#pragma unroll
        for (int m = 0; m < 4; ++m) { a[m] = *(const GAS bf16x8*)(ap + (size_t)m * 16 * K + ks); b[m] = *(const GAS bf16x8*)(bp + (size_t)m * 16 * K + ks); }
#pragma unroll
        for (int m = 0; m < 4; ++m)
#pragma unroll
            for (int n = 0; n < 4; ++n) acc[m][n] = __builtin_amdgcn_mfma_f32_16x16x32_bf16(a[m], b[n], acc[m][n], 0, 0, 0); }
    LAS float* part = (LAS float*)F.lds + F.wave * 4096;
#pragma unroll
    for (int m = 0; m < 4; ++m)
#pragma unroll
        for (int n = 0; n < 4; ++n)
#pragma unroll
            for (int reg = 0; reg < 4; ++reg) part[(16 * m + 4 * fq + reg) * 64 + 16 * n + fr] = acc[m][n][reg];
    __syncthreads();
#pragma unroll
    for (int q = 0; q < 2; ++q) { const int idx = F.tid * 2 + q, row = idx >> 4, col = (idx & 15) * 4; f32x4 s = {0.f, 0.f, 0.f, 0.f};
#pragma unroll
        for (int w = 0; w < 8; ++w) s += *(const LAS f32x4*)((LAS float*)F.lds + w * 4096 + row * 64 + col);
        E.small(rb + row, cb + col, s); }
    __syncthreads();
}
__device__ __forceinline__ void transpose_item(const float* W, int N, int k0, int n0, bf16* WT, int ldk, int drow0, float colscale, const float* rowscale, LAS float* scr, int lane) {
#pragma unroll 8
    for (int i = 0; i < 32; ++i) { const int kk = 2 * i + (lane >> 5); float v = W[(size_t)(k0 + kk) * N + n0 + (lane & 31)]; if (rowscale) v *= rowscale[k0 + kk]; scr[kk * 33 + (lane & 31)] = v * colscale; }
    LDS_WAIT(); asm volatile("" ::: "memory");
    const int c = lane & 7;
#pragma unroll
    for (int j = 0; j < 4; ++j) { const int n = (lane >> 3) + 8 * j; const LAS float* s = scr + (8 * c) * 33 + n;
        v4u o; o.x = pk2(s[0 * 33], s[1 * 33]); o.y = pk2(s[2 * 33], s[3 * 33]); o.z = pk2(s[4 * 33], s[5 * 33]); o.w = pk2(s[6 * 33], s[7 * 33]);
        *(GAS v4u*)(WT + (size_t)(drow0 + n) * ldk + k0 + 8 * c) = o; }
    LDS_WAIT(); asm volatile("" ::: "memory");
}
constexpr int IT_IN = 32 * (NPROJ_SRC / 32), IT_GO = 32 * 64, IT_PO = 16 * 64, IT_OUT = 32 * 64, IT_FI = 32 * (NFFI / 32), IT_FO = (DFF / 64) * 64, IT_PG = 1024, IT_ZIN = 224, IT_ZPG = 1024;
constexpr int IT_LAYER = IT_IN + IT_GO + IT_PO + IT_OUT + IT_FI + IT_FO + IT_PG + IT_ZIN + IT_ZPG;
constexpr int IT_MOD = DEPTH * 48 * 8;
__device__ __forceinline__ void phase_prologue_a(const Frame& F, const Params& p) {
    LAS float* scr = (LAS float*)(F.lds + F.wave * 16384);
    for (int it = F.gw; it < IT_MOD; it += F.NGW) {
        const int l = it / 384, r = it % 384, nb = r / 8, kb = r % 8, k0 = 256 * kb, n0 = 256 * nb + 4 * F.lane;
#pragma unroll
        for (int j = 0; j < 4; ++j) { const int k = k0 + F.lane + 64 * j;
            const float c0 = p.c[k], c1 = p.c[DM + k], c2 = p.c_ctx[k];
            scr[(F.lane + 64 * j) * 3 + 0] = c0 / (1.0f + expf(-c0)); scr[(F.lane + 64 * j) * 3 + 1] = c1 / (1.0f + expf(-c1)); scr[(F.lane + 64 * j) * 3 + 2] = c2 / (1.0f + expf(-c2)); }
        LDS_WAIT(); asm volatile("" ::: "memory");
        f32x4 a0 = {0.f, 0.f, 0.f, 0.f}, a1 = a0, a2 = a0;
        const float* wp = p.w_ada + ((size_t)l * DM + k0) * NMODV + n0;
#pragma unroll 8
        for (int kk = 0; kk < 256; ++kk) { const f32x4 w = *(const GAS f32x4*)(wp + (size_t)kk * NMODV); const float s0 = scr[kk * 3], s1 = scr[kk * 3 + 1], s2 = scr[kk * 3 + 2];
            a0 += w * s0; a1 += w * s1; a2 += w * s2; }
        float* mp = (float*)(p.ws + WS_MODP) + ((size_t)(l * 8 + kb) * 3) * NMODV + n0;
        *(GAS f32x4*)(mp) = a0; *(GAS f32x4*)(mp + NMODV) = a1; *(GAS f32x4*)(mp + 2 * NMODV) = a2;
        LDS_WAIT(); asm volatile("" ::: "memory");
    }
    for (int it = F.gw; it < DEPTH * IT_LAYER; it += F.NGW) {
        const int l = it / IT_LAYER; int r = it % IT_LAYER;
        if (r < IT_IN) { const int nblk = NPROJ_SRC / 32, kb = r / nblk, n0 = 32 * (r % nblk);
            int drow; float cs = 1.0f;
            if (n0 < 6144) { drow = n0; if (n0 < 1024) cs = 0.0625f; } else if (n0 < 6176) drow = CA + (n0 - 6144); else if (n0 < 7200) drow = CP + (n0 - 6176); else drow = CBG + (n0 - 7200);
            transpose_item(p.w_in + (size_t)l * DM * NPROJ_SRC, NPROJ_SRC, 64 * kb, n0, wlayer(p, l, WO_IN), DM, drow, cs, nullptr, scr, F.lane); continue; } r -= IT_IN;
        if (r < IT_GO) { transpose_item(p.w_go + (size_t)l * DM * DM, DM, 64 * (r / 64), 32 * (r % 64), wlayer(p, l, WO_GO), DM, 32 * (r % 64), 1.0f, nullptr, scr, F.lane); continue; } r -= IT_GO;
        if (r < IT_PO) { transpose_item(p.w_po + (size_t)l * DPOOL * DM, DM, 64 * (r / 64), 32 * (r % 64), wlayer(p, l, WO_PO), DPOOL, 32 * (r % 64), 1.0f, p.pool_scale + (size_t)l * DPOOL, scr, F.lane); continue; } r -= IT_PO;
        if (r < IT_OUT) { transpose_item(p.w_out + (size_t)l * DM * DM, DM, 64 * (r / 64), 32 * (r % 64), wlayer(p, l, WO_OUT), DM, 32 * (r % 64), 1.0f, nullptr, scr, F.lane); continue; } r -= IT_OUT;
        if (r < IT_FI) { const int nblk = NFFI / 32, kb = r / nblk, n0 = 32 * (r % nblk), up = n0 >= DFF ? 1 : 0, ch = n0 - up * DFF;
            transpose_item(p.w_fi + (size_t)l * DM * NFFI, NFFI, 64 * kb, n0, wlayer(p, l, WO_FI), DM, 256 * (ch / 128) + 128 * up + (ch % 128), 1.0f, nullptr, scr, F.lane); continue; } r -= IT_FI;
        if (r < IT_FO) { transpose_item(p.w_fo + (size_t)l * DFF * DM, DM, 64 * (r / 64), 32 * (r % 64), wlayer(p, l, WO_FO), DFF, 32 * (r % 64), 1.0f, nullptr, scr, F.lane); continue; } r -= IT_FO;
        if (r < IT_PG) { const int g = r >> 8, i = r & 255;
            const f32x4 v = *(const GAS f32x4*)(p.w_pg + (((size_t)l * 4 + g) * 256 + i) * 256 + 4 * F.lane);
            *(GAS u32x2g*)(wlayer(p, l, WO_PG) + (size_t)(256 * g + i) * 1024 + 256 * g + 4 * F.lane) = (u32x2g){pk2(v.x, v.y), pk2(v.z, v.w)}; continue; } r -= IT_PG;
        if (r < IT_ZIN) { GAS v4u* zp = (GAS v4u*)(wlayer(p, l, WO_IN) + (size_t)(NPROJ_SRC + r) * DM);
#pragma unroll
            for (int j = 0; j < 4; ++j) zp[F.lane + 64 * j] = (v4u){0u, 0u, 0u, 0u};
            continue; } r -= IT_ZIN;
        { GAS v4u* zp = (GAS v4u*)(wlayer(p, l, WO_PG) + (size_t)r * 1024); const int g = r >> 8;
#pragma unroll
          for (int j = 0; j < 2; ++j) { const int ch = F.lane + 64 * j; if ((ch >> 5) != g) zp[ch] = (v4u){0u, 0u, 0u, 0u}; } }
    }
}
__device__ __forceinline__ void phase_prologue_b(const Frame& F, const Params& p) {
    const float* MP = (const float*)(p.ws + WS_MODP); float* MO = (float*)(p.ws + WS_MOD);
    for (int e = F.vcu * NTHREADS + F.tid; e < DEPTH * 3 * NMODV; e += F.G * NTHREADS) { const int l = e / (3 * NMODV), r = e % (3 * NMODV), n = r % NMODV;
        float s = p.b_ada[(size_t)l * NMODV + n];
#pragma unroll
        for (int kb = 0; kb < 8; ++kb) s += MP[((size_t)(l * 8 + kb) * 3) * NMODV + r];
        MO[e] = s; }
    LAS float* sm = (LAS float*)F.lds;
    for (int e = F.tid; e < 3 * 2 * DM; e += NTHREADS) { const int mi = e / (2 * DM), r = e % (2 * DM);
        float s = p.b_ada[r];
#pragma unroll
        for (int kb = 0; kb < 8; ++kb) s += MP[((size_t)kb * 3 + mi) * NMODV + r];
        sm[e] = s; }
    __syncthreads();
    bf16* H = (bf16*)(p.ws + WS_H);
    for (int row = F.gw; row < MTOT; row += F.NGW) { const int mi = mod_index(row);
        const float* xr = row < MLAT ? p.x + (size_t)row * DM : p.ctx + (size_t)(row - MLAT) * DM;
        const LAS float* sh = sm + mi * 2 * DM; const LAS float* sc = sh + DM;
        GAS unsigned long long* o8 = (GAS unsigned long long*)(H + (size_t)row * DM) + F.lane;
#pragma unroll
        for (int j = 0; j < 8; ++j) { const int c = 4 * F.lane + 256 * j; const f32x4 v = *(const GAS f32x4*)(xr + c);
            const float y0 = v.x * (1.0f + sc[c]) + sh[c], y1 = v.y * (1.0f + sc[c + 1]) + sh[c + 1], y2 = v.z * (1.0f + sc[c + 2]) + sh[c + 2], y3 = v.w * (1.0f + sc[c + 3]) + sh[c + 3];
            o8[64 * j] = (unsigned long long)pk2(y0, y1) | ((unsigned long long)pk2(y2, y3) << 32); } }
    __syncthreads();
}
__device__ __forceinline__ void phase_ln(const Frame& F, const Params& p, int l, int sub, int M) {
    const float* V = (const float*)(p.ws + WS_V); float* X = (float*)(p.ws + WS_X); bf16* H = (bf16*)(p.ws + WS_H);
    const float* gain = (sub == 0 ? p.ln1g : p.ln2g) + (size_t)l * DM; const float* bias = (sub == 0 ? p.ln1b : p.ln2b) + (size_t)l * DM;
    const bool last = (sub == 1 && l == DEPTH - 1);
    const int lm = sub == 0 ? l : l + 1, wsh = sub == 0 ? 3 : 0, wsc = sub == 0 ? 4 : 1;
    for (int row = F.gw; row < M; row += F.NGW) {
        const GAS f32x4* vr = (const GAS f32x4*)(V + (size_t)row * DM) + F.lane;
        f32x4 v[8]; float s = 0.f;
#pragma unroll
        for (int j = 0; j < 8; ++j) { v[j] = vr[64 * j]; s += (v[j].x + v[j].y) + (v[j].z + v[j].w); }
        const float mean = wave_sum(s) * (1.f / DM); float s2 = 0.f;
#pragma unroll
        for (int j = 0; j < 8; ++j) { v[j] = v[j] - mean; s2 += (v[j].x * v[j].x + v[j].y * v[j].y) + (v[j].z * v[j].z + v[j].w * v[j].w); }
        const float rstd = 1.f / sqrtf(wave_sum(s2) * (1.f / DM) + LN_EPS);
#pragma unroll
        for (int j = 0; j < 8; ++j) { const int c = 4 * F.lane + 256 * j; const f32x4 g = *(const GAS f32x4*)(gain + c), b = *(const GAS f32x4*)(bias + c); v[j] = v[j] * rstd * g + b; }
        if (last) { GAS f32x4* o = (GAS f32x4*)(p.out + (size_t)row * DM) + F.lane;
#pragma unroll
            for (int j = 0; j < 8; ++j) o[64 * j] = v[j];
        } else {
            GAS f32x4* xo = (GAS f32x4*)(X + (size_t)row * DM) + F.lane;
            const int mi = mod_index(row); const float* sh = modv(p, lm, mi, wsh); const float* sc = modv(p, lm, mi, wsc);
            GAS unsigned long long* o8 = (GAS unsigned long long*)(H + (size_t)row * DM) + F.lane;
#pragma unroll
            for (int j = 0; j < 8; ++j) { const int c = 4 * F.lane + 256 * j; xo[64 * j] = v[j];
                const f32x4 a = *(const GAS f32x4*)(sc + c), b = *(const GAS f32x4*)(sh + c); const f32x4 y = v[j] * (a + 1.0f) + b;
                o8[64 * j] = (unsigned long long)pk2(y.x, y.y) | ((unsigned long long)pk2(y.z, y.w) << 32); } }
    }
}
template <int G, int PASS> __device__ __forceinline__ void pool_task(const unsigned char* ws, int base_row, int st, int n, int pos0, int c) {
    constexpr int W = 2 << G, LO = W / 2, HI = W - LO - 1, NIN = 32 + W - 1;
    const bf16* PROJ = (const bf16*)(ws + WS_PROJ); float* HM = (float*)(ws + WS_HM); bf16* T = (bf16*)(ws + WS_T);
    float s0[NIN], s1[NIN];
#pragma unroll
    for (int q = 0; q < NIN; ++q) { const int pos = pos0 - LO + q; const bool ok = pos >= 0 && pos < n; const int row = base_row + (ok ? pos : pos0) * st;
        if (PASS == 0) { const unsigned wv = *(const GAS unsigned*)(PROJ + (size_t)row * NPROJ + CP + c); s0[q] = ok ? bflo(wv) : 0.f; s1[q] = ok ? bfhi(wv) : 0.f; }
        else { const f32x2g hv = *(const GAS f32x2g*)(HM + (size_t)row * DPOOL + c); s0[q] = ok ? hv.x : 0.f; s1[q] = ok ? hv.y : 0.f; } }
#pragma unroll
    for (int q = 1; q < NIN; ++q) { s0[q] += s0[q - 1]; s1[q] += s1[q - 1]; }
#pragma unroll
    for (int i = 0; i < 32; ++i) { const int pos = pos0 + i, row = base_row + pos * st;
        const int cnt = min(pos + HI + 1, n) - max(pos - LO, 0); const float inv = 1.0f / (float)cnt;
        const float m0 = (s0[i + W - 1] - (i > 0 ? s0[i > 0 ? i - 1 : 0] : 0.f)) * inv, m1 = (s1[i + W - 1] - (i > 0 ? s1[i > 0 ? i - 1 : 0] : 0.f)) * inv;
        if (PASS == 0) *(GAS f32x2g*)(HM + (size_t)row * DPOOL + c) = (f32x2g){m0, m1};
        else { const unsigned wv = *(const GAS unsigned*)(PROJ + (size_t)row * NPROJ + CP + c); *(GAS unsigned*)(T + (size_t)row * DPOOL + c) = pk2(m0 - bflo(wv), m1 - bfhi(wv)); } }
}
template <int PASS> __device__ __forceinline__ void pool_dispatch(const unsigned char* ws, int g, int base_row, int st, int n, int pos0, int c) {
    if (g == 0) pool_task<0, PASS>(ws, base_row, st, n, pos0, c); else if (g == 1) pool_task<1, PASS>(ws, base_row, st, n, pos0, c);
    else if (g == 2) pool_task<2, PASS>(ws, base_row, st, n, pos0, c); else pool_task<3, PASS>(ws, base_row, st, n, pos0, c);
}
constexpr int N_POOL_LAT = 128 * 2 * 8, N_POOL_CTX = 2 * 8 * 8, N_POOL_TASKS = N_POOL_LAT + N_POOL_CTX;
template <int PASS> __device__ __forceinline__ void phase_pool(const Frame& F, const Params& p, int wi, int nw) {
    for (int id = wi; id < N_POOL_TASKS; id += nw) {
        if (id < N_POOL_LAT) { const int cb = id & 7, half = (id >> 3) & 1, line = id >> 4, c = cb * 128 + 2 * F.lane;
            if (PASS == 0) pool_dispatch<0>(p.ws, cb >> 1, line * 64, 1, 64, 32 * half, c);
            else pool_dispatch<1>(p.ws, cb >> 1, (line >> 6) * SEQ + (line & 63), 64, 64, 32 * half, c);
        } else { const int id2 = id - N_POOL_LAT, cb = id2 & 7, blk = (id2 >> 3) & 7, b = id2 >> 6, c = cb * 128 + 2 * F.lane;
            if (PASS == 0) pool_dispatch<0>(p.ws, cb >> 1, MLAT + b * CTXL, 1, CTXL, 32 * blk, c);
            else { const bf16* PROJ = (const bf16*)(p.ws + WS_PROJ); const float* HM = (const float*)(p.ws + WS_HM); bf16* T = (bf16*)(p.ws + WS_T);
#pragma unroll 8
                for (int i = 0; i < 32; ++i) { const int row = MLAT + b * CTXL + 32 * blk + i; const f32x2g hv = *(const GAS f32x2g*)(HM + (size_t)row * DPOOL + c);
                    const unsigned wv = *(const GAS unsigned*)(PROJ + (size_t)row * NPROJ + CP + c); *(GAS unsigned*)(T + (size_t)row * DPOOL + c) = pk2(hv.x - bflo(wv), hv.y - bfhi(wv)); } }
        }
    }
}
__device__ __forceinline__ float log_sigmoid_f(float z) { return fminf(z, 0.f) - log1pf(expf(-fabsf(z))); }
__device__ __forceinline__ void phase_la(const Frame& F, const Params& p, int l) {
    const bf16* PROJ = (const bf16*)(p.ws + WS_PROJ); float* LA = (float*)(p.ws + WS_LA);
    for (int task = F.gw; task < MTOT * 2; task += F.NGW) { const int row = task >> 1, dir = task & 1;
        const bf16* ap = PROJ + (size_t)row * NPROJ + CA + dir * 16; float a[16];
#pragma unroll
        for (int r = 0; r < 16; ++r) a[r] = bf2f(ap[r]);
        const float* wu = p.w_dup + ((size_t)l * 2 + dir) * RANK * 1024; const float* bu = p.b_dup + ((size_t)l * 2 + dir) * 1024;
#pragma unroll
        for (int j = 0; j < 4; ++j) { const int d = 4 * F.lane + 256 * j; f32x4 z = *(const GAS f32x4*)(bu + d);
#pragma unroll
            for (int r = 0; r < 16; ++r) z += *(const GAS f32x4*)(wu + (size_t)r * 1024 + d) * a[r];
            f32x4 o; o.x = log_sigmoid_f(z.x) * 0.0625f; o.y = log_sigmoid_f(z.y) * 0.0625f; o.z = log_sigmoid_f(z.z) * 0.0625f; o.w = log_sigmoid_f(z.w) * 0.0625f;
            *(GAS f32x4*)(LA + ((size_t)dir * MTOT + row) * 1024 + d) = o; } }
}
__device__ __forceinline__ void phase_gla_naive(const Frame& F, const Params& p) {
    const bf16* PROJ = (const bf16*)(p.ws + WS_PROJ); const float* LA = (const float*)(p.ws + WS_LA); float* O = (float*)(p.ws + WS_O);
    for (int it = F.gw; it < NBATCH * NH * HV; it += F.NGW) { const int b = it >> 11, h = (it >> 9) & 3, vcol = it & 511;
        for (int dir = 0; dir < 2; ++dir) {
            float S0 = 0.f, S1 = 0.f, S2 = 0.f, S3 = 0.f;
#pragma unroll 4
            for (int step = 0; step < CTXL + SEQ; ++step) {
                int row; if (step < CTXL) { const int t = dir ? CTXL - 1 - step : step; row = MLAT + b * CTXL + t; } else { const int s2 = step - CTXL; const int t = dir ? SEQ - 1 - s2 : s2; row = b * SEQ + t; }
                const bf16* pr = PROJ + (size_t)row * NPROJ;
                const u32x2g qw = *(const GAS u32x2g*)(pr + CQ + h * HK + 4 * F.lane), kw = *(const GAS u32x2g*)(pr + CK + h * HK + 4 * F.lane);
                const f32x4 la = *(const GAS f32x4*)(LA + ((size_t)dir * MTOT + row) * 1024 + h * HK + 4 * F.lane);
                const float vv = bf2f(pr[CV + h * HV + vcol]);
                S0 = expf(la.x) * S0 + bflo(kw.x) * vv; S1 = expf(la.y) * S1 + bfhi(kw.x) * vv; S2 = expf(la.z) * S2 + bflo(kw.y) * vv; S3 = expf(la.w) * S3 + bfhi(kw.y) * vv;
                const float part = wave_sum((bflo(qw.x) * S0 + bfhi(qw.x) * S1) + (bflo(qw.y) * S2 + bfhi(qw.y) * S3));
                if (F.lane == 0) { float* op = O + (size_t)row * DM + h * HV + vcol; *op = dir ? *op + part : part; }
            }
        }
    }
}
template <int NO> __device__ __forceinline__ void phase_gout(const Frame& F, const Params& p, int l, int M) {
    const bf16* PROJ = (const bf16*)(p.ws + WS_PROJ); const float* O = (const float*)(p.ws + WS_O); bf16* A = (bf16*)(p.ws + WS_AGLA);
    const float* gain = p.gla_gain + (size_t)l * DM;
    for (int task = F.gw; task < M * NH; task += F.NGW) { const int row = task >> 2, h = task & 3, c = h * HV + 8 * F.lane;
        f32x4 o0 = *(const GAS f32x4*)(O + (size_t)row * DM + c), o1 = *(const GAS f32x4*)(O + (size_t)row * DM + c + 4);
        if (NO == 2) { o0 += *(const GAS f32x4*)(O + (size_t)(MTOT + row) * DM + c); o1 += *(const GAS f32x4*)(O + (size_t)(MTOT + row) * DM + c + 4); }
        const float ss = wave_sum((o0.x * o0.x + o0.y * o0.y) + (o0.z * o0.z + o0.w * o0.w) + (o1.x * o1.x + o1.y * o1.y) + (o1.z * o1.z + o1.w * o1.w));
        const float r = 1.0f / sqrtf(ss * (1.0f / HV) + RMS_EPS);
        const f32x4 g0 = *(const GAS f32x4*)(gain + c), g1 = *(const GAS f32x4*)(gain + c + 4);
        const v4u gw = *(const GAS v4u*)(PROJ + (size_t)row * NPROJ + CG + c);
        v4u w; w.x = pk2(o0.x * r * g0.x * bflo(gw.x), o0.y * r * g0.y * bfhi(gw.x)); w.y = pk2(o0.z * r * g0.z * bflo(gw.y), o0.w * r * g0.w * bfhi(gw.y));
        w.z = pk2(o1.x * r * g1.x * bflo(gw.z), o1.y * r * g1.y * bfhi(gw.z)); w.w = pk2(o1.z * r * g1.z * bflo(gw.w), o1.w * r * g1.w * bfhi(gw.w));
        *(GAS v4u*)(A + (size_t)row * DM + c) = w; }
}

typedef float f32x16 __attribute__((ext_vector_type(16)));
__device__ __forceinline__ int swap23(int d) { return (d & ~12) | ((d & 4) << 1) | ((d & 8) >> 1); }
constexpr int PREP_ROW = 528;
constexpr int PREP_QS = 0, PREP_KS = 64 * PREP_ROW, PREP_AL = 2 * 64 * PREP_ROW, PREP_TOT = PREP_AL + 4096;
constexpr int N_PREP_A = NCG * 4 * 2, N_PREP_V = NCG * 4;
constexpr int VT_ROW = 1040;

__device__ __forceinline__ void phase_gla_prep(const Frame& F, const Params& p, int l) {
    const bf16* PROJ = (const bf16*)(p.ws + WS_PROJ);
    bf16* QI = (bf16*)(p.ws + WS_QI); bf16* KST = (bf16*)(p.ws + WS_KST); bf16* PM = (bf16*)(p.ws + WS_PM); float* DCB = (float*)(p.ws + WS_DCB); bf16* VT = (bf16*)(p.ws + WS_VT);
    for (int item = F.vcu; item < N_PREP_A + N_PREP_V; item += F.G) {
        if (item < N_PREP_A) {
            const int cg = item >> 3, h = (item >> 1) & 3, dir = item & 1, r0 = cg * 64;
            LAS float* AL = (LAS float*)(F.lds + PREP_AL); LAS float* TOT = (LAS float*)(F.lds + PREP_TOT);
            LAS unsigned short* QS = (LAS unsigned short*)(F.lds + PREP_QS); LAS unsigned short* KS = (LAS unsigned short*)(F.lds + PREP_KS);
            { const int j = F.tid >> 3, r2 = (F.tid & 7) * 2; const unsigned w = *(const GAS unsigned*)(PROJ + (size_t)(r0 + j) * NPROJ + CA + dir * 16 + r2); AL[j * 16 + r2] = bflo(w); AL[j * 16 + r2 + 1] = bfhi(w); }
            const int d = F.tid & 255, jh = F.tid >> 8;
            float w[16];
#pragma unroll
            for (int r = 0; r < 16; ++r) w[r] = p.w_dup[(((size_t)l * 2 + dir) * RANK + r) * 1024 + h * HK + d];
            const float bz = p.b_dup[((size_t)l * 2 + dir) * 1024 + h * HK + d];
            __syncthreads();
            float ex[32]; float run = 0.f;
#pragma unroll
            for (int jo = 0; jo < 32; ++jo) { const LAS f32x4* a = (const LAS f32x4*)(AL + (jh * 32 + jo) * 16); float z = bz;
#pragma unroll
                for (int r4 = 0; r4 < 4; ++r4) { const f32x4 av = a[r4]; z += av.x * w[4 * r4] + av.y * w[4 * r4 + 1] + av.z * w[4 * r4 + 2] + av.w * w[4 * r4 + 3]; }
                ex[jo] = run; run += log_sigmoid_f(z) * 0.0625f; }
            TOT[jh * 256 + d] = run;
            __syncthreads();
            const float t0 = TOT[d], t1 = TOT[256 + d], tot = run;
            const float first = dir ? t1 : t0;
            const float last = t0 + t1;
            const float off = (jh == dir) ? 0.f : first;
            const float Eref = __expf(first), Elr = __expf(last - first);
            const size_t gi = ((size_t)dir * NCG + cg) * 4 + h;
            if (jh == 0) DCB[gi * 256 + d] = __expf(last);
            unsigned kpack[16];
            const int dq = (d & ~15) + swap23(d & 15);
#pragma unroll
            for (int jo = 0; jo < 32; ++jo) { const int j = jh * 32 + jo;
                const float incl = (jo < 31) ? ex[(jo + 1) & 31] : tot;
                const float cum = (dir ? (tot - ex[jo]) : incl) + off;
                const float x = cum - first, e1 = __expf(x), e2 = __expf(-x);
                const bf16* pr = PROJ + (size_t)(r0 + j) * NPROJ;
                const float q = bf2f(pr[CQ + h * HK + d]), k = bf2f(pr[CK + h * HK + d]);
                const float qin = q * e1, kin = k * e2;
                QS[j * (PREP_ROW / 2) + d] = (unsigned short)f2bf(qin); KS[j * (PREP_ROW / 2) + d] = (unsigned short)f2bf(kin);
                QI[((size_t)dir * MTOT + r0 + j) * 1024 + h * HK + dq] = (bf16)f2bf(qin * Eref);
                const unsigned kb = f2bf(kin * Elr); if (jo & 1) kpack[jo >> 1] |= kb << 16; else kpack[jo >> 1] = kb; }
            { GAS v4u* kp = (GAS v4u*)(KST + (gi * 256 + d) * 64 + jh * 32);
#pragma unroll
              for (int c = 0; c < 4; ++c) kp[c] = (v4u){kpack[4 * c], kpack[4 * c + 1], kpack[4 * c + 2], kpack[4 * c + 3]}; }
            __syncthreads();
            { const int ti = F.wave >> 1, fr = F.lane & 15, fq = F.lane >> 4;
#pragma unroll
              for (int q2 = 0; q2 < 2; ++q2) { const int tj = (F.wave & 1) * 2 + q2; f32x4 acc = {0.f, 0.f, 0.f, 0.f};
#pragma unroll
                for (int ks = 0; ks < 8; ++ks) { const bf16x8 a = *(const LAS bf16x8*)(F.lds + PREP_KS + (16 * tj + fr) * PREP_ROW + (32 * ks + 8 * fq) * 2);
                    const bf16x8 bq = *(const LAS bf16x8*)(F.lds + PREP_QS + (16 * ti + fr) * PREP_ROW + (32 * ks + 8 * fq) * 2);
                    acc = __builtin_amdgcn_mfma_f32_16x16x32_bf16(a, bq, acc, 0, 0, 0); }
                const int i = 16 * ti + fr, j0 = 16 * tj + 4 * fq; float v[4];
#pragma unroll
                for (int reg = 0; reg < 4; ++reg) { const int j = j0 + reg; const bool keep = dir ? (j >= i) : (j <= i); v[reg] = keep ? acc[reg] : 0.f; }
                *(GAS u32x2g*)(PM + (gi * 64 + i) * 64 + j0) = (u32x2g){pk2(v[0], v[1]), pk2(v[2], v[3])}; } }
            __syncthreads();
        } else {
            const int it = item - N_PREP_A, cg = it >> 2, h = it & 3, r0 = cg * 64;
#pragma unroll
            for (int k = 0; k < 8; ++k) { const int id = F.tid + NTHREADS * k, row = id >> 6, c = id & 63;
                const v4u x = *(const GAS v4u*)(PROJ + (size_t)(r0 + row) * NPROJ + CV + h * HV + 8 * c); *(LAS v4u*)(F.lds + row * VT_ROW + 16 * c) = x; }
            __syncthreads();
#pragma unroll
            for (int k = 0; k < 8; ++k) { const int id = F.tid + NTHREADS * k, v = id & 511, jb = id >> 9; unsigned e[8];
#pragma unroll
                for (int jj = 0; jj < 8; ++jj) e[jj] = *(const LAS unsigned short*)(F.lds + (8 * jb + jj) * VT_ROW + 2 * v);
                *(GAS v4u*)(VT + (((size_t)cg * 4 + h) * 512 + v) * 64 + 8 * jb) = (v4u){e[0] | (e[1] << 16), e[2] | (e[3] << 16), e[4] | (e[5] << 16), e[6] | (e[7] << 16)}; }
            __syncthreads();
        }
    }
}

#define MFMA32(a, b, c) __builtin_amdgcn_mfma_f32_32x32x16_bf16((a), (b), (c), 0, 0, 0)
__device__ __forceinline__ bf16x8 pack_step(const f32x16& x, int s) {
    v4u pk;
    asm volatile("v_cvt_pk_bf16_f32 %0, %4, %5\n\tv_cvt_pk_bf16_f32 %1, %6, %7\n\tv_cvt_pk_bf16_f32 %2, %8, %9\n\tv_cvt_pk_bf16_f32 %3, %10, %11\n\ts_nop 1"
                 : "=&v"(pk[0]), "=&v"(pk[1]), "=&v"(pk[2]), "=&v"(pk[3])
                 : "v"(x[8 * s]), "v"(x[8 * s + 1]), "v"(x[8 * s + 2]), "v"(x[8 * s + 3]), "v"(x[8 * s + 4]), "v"(x[8 * s + 5]), "v"(x[8 * s + 6]), "v"(x[8 * s + 7]));
    return __builtin_bit_cast(bf16x8, pk);
}
constexpr int SC_RING = 0, SC_EX = 65536, SC_EXSZ = 13312, SC_OST = SC_EX + 2 * SC_EXSZ;
static_assert(SC_OST + 8192 <= RING_BYTES, "scan LDS map");
__device__ __forceinline__ void glds16(const unsigned char* ws, unsigned off, LAS unsigned char* l) { __builtin_amdgcn_global_load_lds((const unsigned*)(ws + off), (LAS unsigned*)l, 16, 0, 0); }
__device__ __forceinline__ int scan_chunk(int n, int b, int dir) { n = n > 67 ? 67 : n; return n < 4 ? 128 + 4 * b + (dir ? 3 - n : n) : 64 * b + (dir ? 67 - n : n - 4); }
#define SC_WAIT_V(n) asm volatile("s_waitcnt vmcnt(" #n ")" ::: "memory")
#define SC_FENCE() asm volatile("" ::: "memory")

__device__ __forceinline__ void phase_gla_scan(const Frame& F, const Params& p) {
    if (F.wave != 0) return;
    const int item = F.vcu; if (item >= 256) return;
    const int g16 = item >> 4, vs = item & 15, b = g16 >> 3, h = (g16 >> 1) & 3, dir = g16 & 1;
    const int lane = F.lane, r = lane & 31, hh = lane >> 5;
    LAS unsigned char* lds = F.lds; const unsigned char* ws = p.ws;
    const unsigned QI0 = (unsigned)(WS_QI + ((size_t)dir * MTOT * 1024 + h * HK) * 2), KST0 = (unsigned)(WS_KST + ((size_t)dir * NCG * 4 + h) * 32768);
    const unsigned PM0 = (unsigned)(WS_PM + ((size_t)dir * NCG * 4 + h) * 8192), DC0 = (unsigned)(WS_DCB + ((size_t)dir * NCG * 4 + h) * 1024), VT0 = (unsigned)(WS_VT + ((size_t)h * 512 + vs * 32) * 128);
    const unsigned O0 = (unsigned)(WS_O + ((size_t)dir * MTOT * DM + h * HV + vs * 32) * 4);
    const unsigned qoff0 = (unsigned)((lane >> 2) * 2048 + 16 * ((lane & 3) ^ ((lane >> 4) & 3)));
    const unsigned koffe = (unsigned)((lane >> 3) * 128 + 16 * ((lane & 7) ^ ((lane >> 4) & 3))), koffo = (unsigned)((lane >> 3) * 128 + 16 * ((lane & 7) ^ (((lane >> 4) & 3) + 4)));
    const unsigned doff = (unsigned)lane * 16u;
    const int xq = (r >> 2) & 3, xk = (r >> 1) & 7;
#define SC_ISSUE_S(cgx, t) do { const unsigned qb_ = QI0 + (unsigned)(cgx) * 131072u + (t) * 64, kb_ = KST0 + (unsigned)(cgx) * 131072u + (t) * 4096; \
        _Pragma("unroll") for (int k_ = 0; k_ < 4; ++k_) glds16(ws, qb_ + k_ * 32768 + qoff0, lds + SC_RING + (t) * 8192 + k_ * 1024); \
        _Pragma("unroll") for (int k_ = 0; k_ < 4; ++k_) glds16(ws, kb_ + k_ * 1024 + ((k_ & 1) ? koffo : koffe), lds + SC_RING + (t) * 8192 + 4096 + k_ * 1024); } while (0)
#define SC_ISSUE_E(cgx, par) do { LAS unsigned char* e_ = lds + SC_EX + (par) * SC_EXSZ; const unsigned pb_ = PM0 + (unsigned)(cgx) * 32768u, vb_ = VT0 + (unsigned)(cgx) * 262144u, db_ = DC0 + (unsigned)(cgx) * 4096u; \
        _Pragma("unroll") for (int k_ = 0; k_ < 8; ++k_) glds16(ws, pb_ + k_ * 1024 + ((k_ & 1) ? koffo : koffe), e_ + k_ * 1024); \
        _Pragma("unroll") for (int k_ = 0; k_ < 4; ++k_) glds16(ws, vb_ + k_ * 1024 + ((k_ & 1) ? koffo : koffe), e_ + 8192 + k_ * 1024); \
        glds16(ws, db_ + doff, e_ + 12288); } while (0)
    f32x16 S[8], o0, o1;
#pragma unroll
    for (int t = 0; t < 8; ++t)
#pragma unroll
        for (int i = 0; i < 16; ++i) S[t][i] = 0.f;
#pragma unroll
    for (int i = 0; i < 16; ++i) { o0[i] = 0.f; o1[i] = 0.f; }
#define SC_DSTAGE(t, E) do { const LAS unsigned char* sl_ = lds + SC_RING + (t) * 8192; \
        { const bf16x8 qa00 = *(const LAS bf16x8*)(sl_ + r * 64 + 16 * ((0 + hh) ^ xq)), qa01 = *(const LAS bf16x8*)(sl_ + r * 64 + 16 * ((2 + hh) ^ xq)); \
          const bf16x8 qa10 = *(const LAS bf16x8*)(sl_ + (32 + r) * 64 + 16 * ((0 + hh) ^ xq)), qa11 = *(const LAS bf16x8*)(sl_ + (32 + r) * 64 + 16 * ((2 + hh) ^ xq)); \
          const bf16x8 sp0 = pack_step(S[t], 0), sp1 = pack_step(S[t], 1); \
          o0 = MFMA32(qa00, sp0, o0); o1 = MFMA32(qa10, sp0, o1); o0 = MFMA32(qa01, sp1, o0); o1 = MFMA32(qa11, sp1, o1); } \
        SC_FENCE(); \
        _Pragma("unroll") for (int g = 0; g < 4; ++g) { const f32x4 dc_ = *(const LAS f32x4*)((E) + 12288 + (32 * (t) + 8 * g + 4 * hh) * 4); \
            S[t][4 * g] *= dc_.x; S[t][4 * g + 1] *= dc_.y; S[t][4 * g + 2] *= dc_.z; S[t][4 * g + 3] *= dc_.w; } \
        SC_FENCE(); \
        _Pragma("unroll") for (int s4 = 0; s4 < 4; ++s4) { const bf16x8 ka_ = *(const LAS bf16x8*)(sl_ + 4096 + r * 128 + 16 * ((2 * s4 + hh) ^ xk)); const bf16x8 vb_ = *(const LAS bf16x8*)((E) + 8192 + r * 128 + 16 * ((2 * s4 + hh) ^ xk)); S[t] = MFMA32(ka_, vb_, S[t]); } \
        SC_FENCE(); } while (0)

    int cg = scan_chunk(0, b, dir);
    SC_ISSUE_E(cg, 0); SC_ISSUE_S(cg, 0); SC_ISSUE_S(cg, 1); SC_ISSUE_S(cg, 2); SC_ISSUE_S(cg, 3);
    for (int n = 0; n < 68; ++n) {
        const int par = n & 1, cgn = scan_chunk(n + 1, b, dir);
        const LAS unsigned char* E = lds + SC_EX + par * SC_EXSZ;
        SC_ISSUE_S(cg, 4); SC_WAIT_V(32);
        SC_DSTAGE(0, E);
        SC_ISSUE_S(cg, 5); SC_WAIT_V(32); SC_DSTAGE(1, E);
        SC_ISSUE_S(cg, 6); SC_WAIT_V(32); SC_DSTAGE(2, E);
        SC_ISSUE_S(cg, 7); SC_WAIT_V(32); SC_DSTAGE(3, E);
        SC_ISSUE_E(cgn, par ^ 1); SC_WAIT_V(37); SC_DSTAGE(4, E);
        SC_ISSUE_S(cgn, 0); SC_WAIT_V(37); SC_DSTAGE(5, E);
        SC_ISSUE_S(cgn, 1); SC_WAIT_V(37); SC_DSTAGE(6, E);
        SC_ISSUE_S(cgn, 2); SC_WAIT_V(37); SC_DSTAGE(7, E);
        SC_ISSUE_S(cgn, 3);
#pragma unroll
        for (int s4 = 0; s4 < 4; ++s4) { const bf16x8 pa0 = *(const LAS bf16x8*)(E + r * 128 + 16 * ((2 * s4 + hh) ^ xk)), pa1 = *(const LAS bf16x8*)(E + (32 + r) * 128 + 16 * ((2 * s4 + hh) ^ xk));
            const bf16x8 vb = *(const LAS bf16x8*)(E + 8192 + r * 128 + 16 * ((2 * s4 + hh) ^ xk)); o0 = MFMA32(pa0, vb, o0); o1 = MFMA32(pa1, vb, o1); }
        SC_FENCE();
        { LAS float* ost = (LAS float*)(lds + SC_OST);
#pragma unroll
          for (int i = 0; i < 16; ++i) { const int row = 8 * (i >> 2) + 4 * hh + (i & 3); ost[row * 32 + r] = o0[i]; ost[(32 + row) * 32 + r] = o1[i]; o0[i] = 0.f; o1[i] = 0.f; }
          asm volatile("s_waitcnt lgkmcnt(0)" ::: "memory");
          const unsigned ob = O0 + (unsigned)cg * (64u * DM * 4u) + (unsigned)((lane >> 3) * (DM * 4) + 16 * (lane & 7));
#pragma unroll
          for (int k = 0; k < 8; ++k) { const f32x4 v = *(const LAS f32x4*)(ost + (8 * k + (lane >> 3)) * 32 + 4 * (lane & 7)); *(GAS f32x4*)(ws + ob + (unsigned)(k * 8 * DM * 4)) = v; }
          asm volatile("s_waitcnt lgkmcnt(0)" ::: "memory"); }
        cg = cgn;
    }
    SC_WAIT_V(0);
#undef SC_ISSUE_S
#undef SC_ISSUE_E
#undef SC_DSTAGE
}

enum { PH_PRO_A = 0, PH_PRO_B, PH_WIN, PH_LA, PH_GLA, PH_GOUT, PH_GO, PH_WOUT, PH_LN0, PH_FFI, PH_FFO, PH_LN1, PH_COUNT };

template <int PH> __device__ __forceinline__ void run_phase(const Frame& F0, const Params& p0, int l) {
    Frame F = F0; asm volatile("" : "+v"(F.tid));
    F.lane = F.tid & 63; F.wave = __builtin_amdgcn_readfirstlane(F.tid >> 6); F.gw = F.vcu * NWAVES + F.wave;
    Params p = p0; asm volatile("" : "+s"(p.ws));
    const int M = (l == DEPTH - 1) ? MLAT : MTOT;
    bf16* H = (bf16*)(p.ws + WS_H); bf16* PROJ = (bf16*)(p.ws + WS_PROJ); bf16* ACT = (bf16*)(p.ws + WS_ACT); float* X = (float*)(p.ws + WS_X); float* V = (float*)(p.ws + WS_V);
    bf16* AGLA = (bf16*)(p.ws + WS_AGLA); bf16* T = (bf16*)(p.ws + WS_T); float* TEMP = (float*)(p.ws + WS_TEMP); bf16* MRG = (bf16*)(p.ws + WS_MRG);
    pg8::StaticOrder S;
    if constexpr (PH == PH_PRO_A) phase_prologue_a(F, p);
    if constexpr (PH == PH_PRO_B) {
        const int ng = F.G / 4, c = (int)blockIdx.x, lyr = c / ng < DEPTH ? c / ng : DEPTH - 1;
        pg8::Gemm g{wlayer(p, lyr, WO_PO), wlayer(p, lyr, WO_PG), DM, 1024, 1024}; S.init(DM, 1024, ng, c < DEPTH * ng ? c % ng : (1 << 20)); EpiBf16Plain E{wlayer(p, lyr, WO_PC), 1024};
        pg8::gemm_phase<EpiBf16Plain, pg8::StaticOrder, true, true>(F.lds, g, S, E);
        phase_prologue_b(F, p); }
    if constexpr (PH == PH_WIN) { pg8::Gemm g{H, wlayer(p, l, WO_IN), MTOT, NPROJ, DM}; S.init(MTOT, NPROJ, F.G, (int)blockIdx.x); EpiProj E{PROJ};
        pg8::gemm_phase<EpiProj, pg8::StaticOrder, true, true>(F.lds, g, S, E); }
    if constexpr (PH == PH_LA) { phase_pool<0>(F, p, F.gw, F.NGW); phase_gla_prep(F, p, l); }
    if constexpr (PH == PH_GLA) { if (F.wave != 0) phase_pool<1>(F, p, F.vcu * 7 + F.wave - 1, F.G * 7); phase_gla_scan(F, p); }
    if constexpr (PH == PH_GOUT) { phase_gout<2>(F, p, l, M);
        pg8::Gemm g{T, wlayer(p, l, WO_PC), MLAT, DM, DPOOL}; S.init(MLAT, DM, F.G, (int)blockIdx.x); EpiGateTemp E{TEMP, PROJ};
        pg8::gemm_phase<EpiGateTemp, pg8::StaticOrder, true, true>(F.lds, g, S, E);
        if (l < DEPTH - 1) small_gemm_ctx(F, T, wlayer(p, l, WO_PC), DPOOL, E); }
    if constexpr (PH == PH_GO) { pg8::Gemm g{AGLA, wlayer(p, l, WO_GO), MLAT, DM, DM}; S.init(MLAT, DM, F.G, (int)blockIdx.x); EpiMerge E{MRG, TEMP, PROJ};
        pg8::gemm_phase<EpiMerge, pg8::StaticOrder, true, true>(F.lds, g, S, E);
        if (l < DEPTH - 1) small_gemm_ctx(F, AGLA, wlayer(p, l, WO_GO), DM, E); }
    if constexpr (PH == PH_WOUT) { pg8::Gemm g{MRG, wlayer(p, l, WO_OUT), MLAT, DM, DM}; S.init(MLAT, DM, F.G, (int)blockIdx.x);
        EpiResid E{V, l == 0 ? p.x : X, l == 0 ? p.ctx : X + (size_t)MLAT * DM, modv(p, l, 0, 2)};
        pg8::gemm_phase<EpiResid, pg8::StaticOrder, true, true>(F.lds, g, S, E);
        if (l < DEPTH - 1) small_gemm_ctx(F, MRG, wlayer(p, l, WO_OUT), DM, E); }
    if constexpr (PH == PH_LN0) phase_ln(F, p, l, 0, M);
    if constexpr (PH == PH_FFI) { pg8::Gemm g{H, wlayer(p, l, WO_FI), M, NFFI, DM}; S.init(M, NFFI, F.G, (int)blockIdx.x); EpiSwiglu E{ACT};
        pg8::gemm_phase<EpiSwiglu, pg8::StaticOrder, true, true>(F.lds, g, S, E); }
    if constexpr (PH == PH_FFO) { pg8::Gemm g{ACT, wlayer(p, l, WO_FO), MLAT, DM, DFF}; S.init(MLAT, DM, F.G, (int)blockIdx.x);
        EpiResid E{V, X, X + (size_t)MLAT * DM, modv(p, l, 0, 5)};
        pg8::gemm_phase<EpiResid, pg8::StaticOrder, true, true>(F.lds, g, S, E);
        if (l < DEPTH - 1) small_gemm_ctx(F, ACT, wlayer(p, l, WO_FO), DFF, E); }
    if constexpr (PH == PH_LN1) phase_ln(F, p, l, 1, M);
}
__device__ __forceinline__ Frame make_frame(unsigned char* lds) {
    Frame F; F.lds = (LAS unsigned char*)lds; F.tid = threadIdx.x; F.lane = F.tid & 63; F.wave = __builtin_amdgcn_readfirstlane(F.tid >> 6);
    F.G = gridDim.x; const int bx = blockIdx.x; F.vcu = (F.G % 8 == 0) ? (bx % 8) * (F.G / 8) + bx / 8 : bx; F.gw = F.vcu * NWAVES + F.wave; F.NGW = F.G * NWAVES;
    return F;
}

constexpr int CW_BAR = 4096;
__device__ __forceinline__ XcdBarrier mkbar(const Params& p, unsigned x, volatile LAS unsigned* st) { unsigned char* w = p.ws; asm volatile("" : "+s"(w), "+s"(x)); XcdBarrier b; b.bar = (unsigned*)(w + WS_CTL) + CW_BAR; b.x = x; b.st = st; return b; }
#define PHASE(ph, l) do { run_phase<ph>(F, p, (l)); xcd_barrier(mkbar(p, bar_x, bar_st)); } while (0)
__global__ void __launch_bounds__(NTHREADS, 2) k_mega(Params p) {
    extern __shared__ __attribute__((aligned(16))) unsigned char lds[];
    const Frame F = make_frame(lds);
    for (int u = F.tid; u < (LDS_BYTES - RING_BYTES) / 4; u += NTHREADS) ((LAS unsigned*)(F.lds + RING_BYTES))[u] = 0u;
    __syncthreads();
    volatile LAS unsigned* const bar_st = (volatile LAS unsigned*)(F.lds + MISC_OFF) + 8;
    const unsigned bar_x = xcd_barrier_post((unsigned*)(p.ws + WS_CTL) + CW_BAR, bar_st).x;
    PHASE(PH_PRO_A, 0);
    PHASE(PH_PRO_B, 0);
    for (int l = 0; l < DEPTH; ++l) {
        PHASE(PH_WIN, l);
        PHASE(PH_LA, l);
        PHASE(PH_GLA, l);
        PHASE(PH_GOUT, l);
        PHASE(PH_GO, l);
        PHASE(PH_WOUT, l);
        PHASE(PH_LN0, l);
        PHASE(PH_FFI, l);
        PHASE(PH_FFO, l);
        if (l < DEPTH - 1) PHASE(PH_LN1, l); else run_phase<PH_LN1>(F, p, l);
    }
}

extern "C" void kernel_launch(void* const* d_in, const int* in_sizes, int n_in, void* d_out, int out_size, void* d_ws, size_t ws_size, hipStream_t stream) {
    static int grid = 0;
    if (grid == 0) {
        if (n_in != 21 || out_size != MLAT * DM || ws_size < WS_END) { fprintf(stderr, "kernel_launch: unexpected problem (n_in %d, out %d, ws %zu, need %zu)\n", n_in, out_size, ws_size, (size_t)WS_END); grid = -1; return; }
        int dev = 0, cus = 0, per_cu = 0;
        if (hipGetDevice(&dev) != hipSuccess || hipDeviceGetAttribute(&cus, hipDeviceAttributeMultiprocessorCount, dev) != hipSuccess) { grid = -1; return; }
        if (hipFuncSetAttribute((const void*)k_mega, hipFuncAttributeMaxDynamicSharedMemorySize, LDS_BYTES) != hipSuccess) { fprintf(stderr, "kernel_launch: hipFuncSetAttribute failed\n"); grid = -1; return; }
        if (hipOccupancyMaxActiveBlocksPerMultiprocessor(&per_cu, (const void*)k_mega, NTHREADS, LDS_BYTES) != hipSuccess || per_cu < 1) fprintf(stderr, "kernel_launch: occupancy query reports %d workgroups per CU\n", per_cu);
        (void)hipGetLastError();
        grid = cus;
    }
    if (grid < 0) return;
    (void)hipMemsetAsync((char*)d_ws + WS_CTL, 0, CTL_BYTES, stream);
    Params p{};
    const float** pp = (const float**)&p;
    for (int i = 0; i < 21; ++i) pp[i] = (const float*)d_in[i];
    p.out = (float*)d_out; p.ws = (unsigned char*)d_ws; p.layer = 0; p.pad = 0;
    hipLaunchKernelGGL(k_mega, dim3(grid), dim3(NTHREADS), LDS_BYTES, stream, p);
}
```

```cpp
#include <hip/hip_runtime.h>
#include <cstdio>
#include <cstdint>
namespace pg8 {
#define PG8_LAS __attribute__((address_space(3)))
typedef unsigned short bf16_t;
typedef short bf16x8 __attribute__((ext_vector_type(8)));
typedef float f32x4 __attribute__((ext_vector_type(4)));
typedef unsigned u32x4 __attribute__((ext_vector_type(4)));
constexpr int BM = 256, BK = 64, HALF = 128, HTB = HALF * BK * 2  , STAGE_BYTES = 8 * HTB, NXCD = 8, WGM = 8;

__host__ __device__ __forceinline__ int lds_byte(int r, int c) { const int st = (r >> 4) * 2 + (c >> 5), rr = r & 15, cc = c & 31, ob = rr * 64 + cc * 2; return st * 1024 + (ob ^ (((ob >> 9) & 1) << 5)); }
__host__ __device__ __forceinline__ void stage_rc(int b, int& R, int& C) { const int st = b / 1024, sb = b % 1024, swz = sb ^ (((sb >> 9) & 1) << 5); R = (st >> 1) * 16 + swz / 64; C = (st & 1) * 32 + (swz % 64) / 2; }
__host__ __device__ __forceinline__ int perm32(int rho) { const int n = rho >> 4, i = rho & 15; return 8 * (i >> 2) + 4 * n + (i & 3); }

struct Unit { int pm, pn; };
struct Gemm { const bf16_t* A; const bf16_t* Bt; int M, N, K; };

struct StaticOrder {
    int nM, nN, nwg, G, c;
    __host__ __device__ void init(int M, int N, int G_, int c_) { nM = M / BM; nN = N / BM; nwg = nM * nN; G = G_; c = c_; }
    __host__ __device__ bool next(int i, Unit& u) const {
        const long L = (long)i * G + c; if (L >= nwg) return false;
        int wgid = (int)L; { const int q = nwg / NXCD, r = nwg % NXCD, xcd = wgid % NXCD, off = wgid / NXCD; wgid = (xcd < r ? xcd * (q + 1) : r * (q + 1) + (xcd - r) * q) + off; }
        const int nig = WGM * nN, gid = wgid / nig, fm = gid * WGM, gsz = (nM - fm) < WGM ? (nM - fm) : WGM;
        u.pm = fm + ((wgid % nig) % gsz); u.pn = (wgid % nig) / gsz; return true;
    }
    __device__ __forceinline__ void a_ready(const Unit&) const {}
    __device__ __forceinline__ void done(const Unit&) const {}
};
__device__ __forceinline__ unsigned cvt_pk_bf16(float lo, float hi) { unsigned r; asm volatile("v_cvt_pk_bf16_f32 %0, %1, %2" : "=v"(r) : "v"(lo), "v"(hi)); return r; }
template <class Epi, class Sched, bool ALIGN_EPI = false, bool SP2 = false>
__device__ __forceinline__ void gemm_phase(PG8_LAS unsigned char* lds, const Gemm g, const Sched& S, const Epi& E) {
    int tid_ = threadIdx.x; asm volatile("" : "+v"(tid_));
    const int tid = tid_, wid = __builtin_amdgcn_readfirstlane(tid >> 6), lane = tid & 63, wr = wid >> 2, wc = wid & 3, fr = lane & 15, fq = lane >> 4;
    const int K = g.K, nt = K / BK;
    unsigned voffA[2], voffB[2];
#pragma unroll
    for (int i = 0; i < 2; ++i) { int R, C; stage_rc(tid * 16 + i * 8192, R, C); const int Rb = Epi::PERM ? ((R & ~31) + perm32(R & 31)) : R;
        voffA[i] = (unsigned)(R * K + C) * 2u; voffB[i] = (unsigned)(Rb * K + C) * 2u; }
    const size_t kstep = (size_t)(BK * 2);
    const size_t hstep = (size_t)HALF * K * 2;
    const size_t tstep = 2 * hstep;
    const unsigned ldsw = (unsigned)wid * 1024u;
    const int aoff = lds_byte(wr * 64 + fr, fq * 8), boff = lds_byte(wc * 32 + fr, fq * 8);
#define PG8_SA(b, h) (((b) * 2 + (h)) * HTB)
#define PG8_SB(b, h) ((4 + (b) * 2 + (h)) * HTB)
#define PG8_STAGE(bufoff, gbase, voff) do { _Pragma("unroll") for (int _i = 0; _i < 2; ++_i) \
        __builtin_amdgcn_global_load_lds((const unsigned*)((const char*)(gbase) + (voff)[_i]), (PG8_LAS unsigned*)(lds + (bufoff) + ldsw + _i * 8192), 16, 0, 0); } while (0)
#define PG8_LDA(dst, b, h) do { _Pragma("unroll") for (int m = 0; m < 4; ++m) _Pragma("unroll") for (int k = 0; k < 2; ++k) dst[m][k] = *(const PG8_LAS bf16x8*)(lds + PG8_SA(b, h) + aoff + m * 2048 + k * 1024); } while (0)
#define PG8_LDB(dst, b, h) do { _Pragma("unroll") for (int n = 0; n < 2; ++n) _Pragma("unroll") for (int k = 0; k < 2; ++k) dst[n][k] = *(const PG8_LAS bf16x8*)(lds + PG8_SB(b, h) + boff + n * 2048 + k * 1024); } while (0)
#define PG8_MMA(ai, bj, At, Bt) do { __builtin_amdgcn_s_setprio(1); _Pragma("unroll") for (int m = 0; m < 4; ++m) _Pragma("unroll") for (int n = 0; n < 2; ++n) _Pragma("unroll") for (int k = 0; k < 2; ++k) \
        acc[ai][bj][m][n] = __builtin_amdgcn_mfma_f32_16x16x32_bf16(Bt[n][k], At[m][k], acc[ai][bj][m][n], 0, 0, 0); __builtin_amdgcn_s_setprio(0); } while (0)
#define PG8_WAIT_V(n) asm volatile("s_waitcnt vmcnt(" #n ")" ::: "memory")
#define PG8_WAIT_L(n) asm volatile("s_waitcnt lgkmcnt(" #n ")" ::: "memory")
#define PG8_BAR __builtin_amdgcn_s_barrier()
#define PG8_SCHED __builtin_amdgcn_sched_barrier(0)
    Unit cur, nxt; int ui = 0;
    if (!S.next(0, cur)) return;
    f32x4 acc[2][2][4][2];
#pragma unroll
    for (int a = 0; a < 2; ++a)
#pragma unroll
        for (int b = 0; b < 2; ++b)
#pragma unroll
            for (int m = 0; m < 4; ++m)
#pragma unroll
                for (int n = 0; n < 2; ++n) acc[a][b][m][n] = (f32x4){0.f, 0.f, 0.f, 0.f};
    bf16x8 At[4][2], B0[2][2], B1[2][2];
    const char* cA = (const char*)g.A + (size_t)cur.pm * tstep; const char* cB = (const char*)g.Bt + (size_t)cur.pn * tstep;
    S.a_ready(cur);
    if constexpr (SP2) {
        PG8_STAGE(PG8_SB(0, 0), cB, voffB); PG8_STAGE(PG8_SB(0, 1), cB + hstep, voffB); PG8_STAGE(PG8_SA(0, 0), cA, voffA); PG8_STAGE(PG8_SA(0, 1), cA + hstep, voffA);
        if (wr == 1) PG8_BAR;
        PG8_WAIT_V(2); PG8_BAR;
        PG8_STAGE(PG8_SB(1, 0), cB + kstep, voffB); PG8_STAGE(PG8_SA(1, 0), cA + kstep, voffA); PG8_STAGE(PG8_SB(1, 1), cB + hstep + kstep, voffB);
        PG8_WAIT_V(6); PG8_BAR;
    } else {
        PG8_STAGE(PG8_SB(0, 0), cB, voffB); PG8_STAGE(PG8_SA(0, 0), cA, voffA); PG8_STAGE(PG8_SB(0, 1), cB + hstep, voffB); PG8_STAGE(PG8_SA(0, 1), cA + hstep, voffA);
        if (wr == 1) PG8_BAR;
        PG8_WAIT_V(4); PG8_BAR;
        PG8_STAGE(PG8_SB(1, 0), cB + kstep, voffB); PG8_STAGE(PG8_SA(1, 0), cA + kstep, voffA); PG8_STAGE(PG8_SB(1, 1), cB + hstep + kstep, voffB);
        PG8_WAIT_V(6); PG8_BAR;
    }
    for (;;) {
        const bool has_next = S.next(ui + 1, nxt);
        const char* nA = has_next ? (const char*)g.A + (size_t)nxt.pm * tstep : cA; const char* nB = has_next ? (const char*)g.Bt + (size_t)nxt.pn * tstep : cB;
        for (int t = 0; t < nt; t += 2) {
            const bool last = (t == nt - 2);
            const char* a1 = cA + (size_t)(t + 1) * kstep;
            const char* a2 = last ? nA : cA + (size_t)(t + 2) * kstep; const char* b2 = last ? nB : cB + (size_t)(t + 2) * kstep;
            const char* a3 = a2 + kstep; const char* b3 = b2 + kstep;
            if (last && has_next) S.a_ready(nxt);
            if constexpr (SP2) {
            PG8_LDB(B0, 0, 0); PG8_LDB(B1, 0, 1); PG8_SCHED; PG8_LDA(At, 0, 0); PG8_STAGE(PG8_SA(1, 1), a1 + hstep, voffA);
            PG8_WAIT_V(8); PG8_WAIT_L(0); PG8_BAR; PG8_MMA(0, 0, At, B0); PG8_MMA(0, 1, At, B1); PG8_BAR; PG8_SCHED;
            PG8_LDA(At, 0, 1); PG8_STAGE(PG8_SB(0, 0), b2, voffB); PG8_STAGE(PG8_SB(0, 1), b2 + hstep, voffB); PG8_STAGE(PG8_SA(0, 0), a2, voffA);
            PG8_WAIT_V(8); PG8_WAIT_L(0); PG8_BAR; PG8_MMA(1, 0, At, B0); PG8_MMA(1, 1, At, B1); PG8_BAR; PG8_SCHED;
            PG8_LDB(B0, 1, 0); PG8_LDB(B1, 1, 1); PG8_SCHED; PG8_LDA(At, 1, 0); PG8_STAGE(PG8_SA(0, 1), a2 + hstep, voffA);
            PG8_WAIT_V(8); PG8_WAIT_L(0); PG8_BAR; PG8_MMA(0, 0, At, B0); PG8_MMA(0, 1, At, B1); PG8_BAR; PG8_SCHED;
            PG8_LDA(At, 1, 1); PG8_STAGE(PG8_SB(1, 0), b3, voffB); PG8_STAGE(PG8_SB(1, 1), b3 + hstep, voffB); PG8_STAGE(PG8_SA(1, 0), a3, voffA);
            PG8_WAIT_V(8); PG8_WAIT_L(0); PG8_BAR; PG8_MMA(1, 0, At, B0); PG8_MMA(1, 1, At, B1); PG8_BAR; PG8_SCHED;
            } else {
            PG8_LDB(B0, 0, 0); PG8_SCHED; PG8_LDA(At, 0, 0); PG8_STAGE(PG8_SA(1, 1), a1 + hstep, voffA);
            PG8_WAIT_L(8); PG8_BAR; PG8_WAIT_L(0); PG8_MMA(0, 0, At, B0); PG8_BAR; PG8_SCHED;
            PG8_LDB(B1, 0, 1); PG8_STAGE(PG8_SB(0, 0), b2, voffB);
            PG8_BAR; PG8_WAIT_L(0); PG8_MMA(0, 1, At, B1); PG8_BAR;
            PG8_LDA(At, 0, 1); PG8_STAGE(PG8_SA(0, 0), a2, voffA);
            PG8_BAR; PG8_WAIT_L(0); PG8_MMA(1, 0, At, B0); PG8_BAR; PG8_SCHED;
            PG8_STAGE(PG8_SB(0, 1), b2 + hstep, voffB);
            PG8_WAIT_V(6); PG8_BAR; PG8_MMA(1, 1, At, B1); PG8_BAR;
            PG8_LDB(B0, 1, 0); PG8_SCHED; PG8_LDA(At, 1, 0); PG8_STAGE(PG8_SA(0, 1), a2 + hstep, voffA);
            PG8_WAIT_L(8); PG8_BAR; PG8_WAIT_L(0); PG8_MMA(0, 0, At, B0); PG8_BAR; PG8_SCHED;
            PG8_LDB(B1, 1, 1); PG8_STAGE(PG8_SB(1, 0), b3, voffB);
            PG8_BAR; PG8_WAIT_L(0); PG8_MMA(0, 1, At, B1); PG8_BAR;
            PG8_LDA(At, 1, 1); PG8_STAGE(PG8_SA(1, 0), a3, voffA);
            PG8_BAR; PG8_WAIT_L(0); PG8_MMA(1, 0, At, B0); PG8_BAR; PG8_SCHED;
            PG8_STAGE(PG8_SB(1, 1), b3 + hstep, voffB);
            PG8_WAIT_V(6); PG8_BAR; PG8_MMA(1, 1, At, B1); PG8_BAR;
            }
        }
        if constexpr (ALIGN_EPI) { if (wr == 0) PG8_BAR; }
        if constexpr (!Epi::AFTER_DRAIN) { E(acc, cur, wr, wc, fr, fq); S.done(cur); }
        if (!has_next) break;
#pragma unroll
        for (int a = 0; a < 2; ++a)
#pragma unroll
            for (int b = 0; b < 2; ++b)
#pragma unroll
                for (int m = 0; m < 4; ++m)
#pragma unroll
                    for (int n = 0; n < 2; ++n) acc[a][b][m][n] = (f32x4){0.f, 0.f, 0.f, 0.f};
        cur = nxt; cA = nA; cB = nB; ++ui;
        if constexpr (ALIGN_EPI) { if (wr == 1) PG8_BAR; }
    }
    PG8_WAIT_V(0);
    if constexpr (!ALIGN_EPI) { if (wr == 0) PG8_BAR; }
    PG8_BAR;
    if constexpr (Epi::AFTER_DRAIN) { E.fused(acc, cur, wr, wc, fr, fq, lds, wid, lane); S.done(cur); }
#undef PG8_SA
#undef PG8_SB
#undef PG8_STAGE
#undef PG8_LDA
#undef PG8_LDB
#undef PG8_MMA
#undef PG8_WAIT_V
#undef PG8_WAIT_L
#undef PG8_BAR
#undef PG8_SCHED
}
}
#define GAS __attribute__((address_space(1)))
#define LAS __attribute__((address_space(3)))
typedef unsigned short bf16;
typedef unsigned v4u __attribute__((ext_vector_type(4)));
typedef float f32x4 __attribute__((ext_vector_type(4)));
typedef short bf16x8 __attribute__((ext_vector_type(8)));
typedef GAS unsigned gu32;
typedef GAS unsigned long long gu64;
#define RLX_AGENT __ATOMIC_RELAXED, __HIP_MEMORY_SCOPE_AGENT
#define LDS_WAIT() asm volatile("s_waitcnt lgkmcnt(0)" ::: "memory")
#define VM_WAIT() asm volatile("s_waitcnt vmcnt(0)" ::: "memory")
__device__ __forceinline__ unsigned long long rt() { return __builtin_amdgcn_s_memrealtime(); }
__device__ __forceinline__ unsigned f2bf(float f) { unsigned u = __builtin_bit_cast(unsigned, f); return (u + 0x7fffu + ((u >> 16) & 1u)) >> 16; }
__device__ __forceinline__ unsigned pk2(float lo, float hi) { return f2bf(lo) | (f2bf(hi) << 16); }

#define XB_TMO      128
#define XB_XCNT(j)  (256  + 64 * (j))
#define XB_XSUB(j)  (1280 + 64 * (j))
#define XB_XGEN(j)  (2304 + 64 * (j))
#define XB_TOP      3328
#define XB_TOPGEN   3392
#define XCD_BAR_WORDS 3456
#define XB_SPIN_CAP (1u << 18)

__device__ __forceinline__ unsigned xb_ld(unsigned* p)              { return __hip_atomic_load(p, __ATOMIC_RELAXED, __HIP_MEMORY_SCOPE_AGENT); }
__device__ __forceinline__ unsigned xb_add(unsigned* p, unsigned v) { return __hip_atomic_fetch_add(p, v, __ATOMIC_RELAXED, __HIP_MEMORY_SCOPE_AGENT); }
__device__ __forceinline__ unsigned xb_xcc_id() { return (unsigned)__builtin_amdgcn_s_getreg((3 << 11) | 20) & 0xFu; }
#define XB_SPIN(cond, bar) do { unsigned _sp = 0; while (cond) { __builtin_amdgcn_s_sleep(1); \
    if ((++_sp & 255u) == 0u) { if (xb_ld(&(bar)[XB_TMO])) break; if (_sp > XB_SPIN_CAP) { atomicAdd(&(bar)[XB_TMO], 1u); break; } } } } while (0)

struct XcdBarrier {
    unsigned* bar; unsigned x;
    volatile LAS unsigned* st;
};

__device__ __forceinline__ XcdBarrier xcd_barrier_post(unsigned* bar, volatile LAS unsigned* st) {
    XcdBarrier b; b.bar = bar; b.x = xb_xcc_id(); b.st = st;
    if (threadIdx.x == 0) (void)xb_add(&bar[XB_XCNT(b.x)], 1u);
    return b;
}
__device__ __forceinline__ void xcd_barrier_complete(unsigned* bar, unsigned x, unsigned& nloc, unsigned& nx) {
    const unsigned G = gridDim.x * gridDim.y * gridDim.z;
    unsigned sum, cnt, mine, sp = 0u;
    for (;;) {
        sum = 0u; cnt = 0u; mine = 0u;
#pragma unroll
        for (unsigned j = 0; j < 16; ++j) { const unsigned c = xb_ld(&bar[XB_XCNT(j)]); sum += c; cnt += (c > 0u) ? 1u : 0u; mine = (j == x) ? c : mine; }
        if (sum == G) break;
        __builtin_amdgcn_s_sleep(1);
        if ((++sp & 255u) == 0u) { if (xb_ld(&bar[XB_TMO])) break; if (sp > XB_SPIN_CAP) { atomicAdd(&bar[XB_TMO], 1u); break; } }
    }
    nloc = mine > 0u ? mine : 1u; nx = cnt > 0u ? cnt : 1u;
}

__device__ __forceinline__ void xcd_barrier(const XcdBarrier& b) {
    asm volatile("s_waitcnt vmcnt(0)" ::: "memory");
    __syncthreads();
    if (threadIdx.x == 0) {
        unsigned* bar = b.bar;
        __builtin_amdgcn_s_waitcnt(0);
        unsigned nloc = b.st[0], nx = b.st[1];
        if (nloc == 0u) { xcd_barrier_complete(bar, b.x, nloc, nx); b.st[0] = nloc; b.st[1] = nx; }
        const unsigned old = xb_add(&bar[XB_XSUB(b.x)], 1u);
        const unsigned gen = old / nloc;
        if (old + 1u == (gen + 1u) * nloc) {
            __builtin_amdgcn_fence(__ATOMIC_RELEASE, "agent");
            asm volatile("s_waitcnt vmcnt(0)" ::: "memory");
            const unsigned og = xb_add(&bar[XB_TOP], 1u);
            const unsigned tg = og / nx;
            if (og + 1u == (tg + 1u) * nx) xb_add(&bar[XB_TOPGEN], 1u);
            else XB_SPIN(xb_ld(&bar[XB_TOPGEN]) == tg, bar);
            __builtin_amdgcn_fence(__ATOMIC_ACQUIRE, "agent");
            xb_add(&bar[XB_XGEN(b.x)], 1u);
            asm volatile("s_waitcnt vmcnt(0)" ::: "memory");
        } else {
            XB_SPIN(xb_ld(&bar[XB_XGEN(b.x)]) == gen, bar);
            __builtin_amdgcn_fence(__ATOMIC_ACQUIRE, "agent");
            asm volatile("s_waitcnt vmcnt(0)" ::: "memory");
        }
    }
    __syncthreads();
}

constexpr int DM = 2048, NBATCH = 2, SEQ = 4096, DEPTH = 4, CTXL = 256;
constexpr int NH = 4, HK = 256, HV = 512, RANK = 16;
constexpr int DPOOL = 1024, DFF = 5632, NMODV = 6 * DM;
constexpr int MLAT = NBATCH * SEQ, MCTX = NBATCH * CTXL, MTOT = MLAT + MCTX;
constexpr int NPROJ = 11520, NPROJ_SRC = 11296, NFFI = 2 * DFF;
constexpr int CQ = 0, CK = 1024, CV = 2048, CG = 4096, CP = 6144, CBG = 7168, CBP = 9216, CA = 11264;
constexpr float ALPHA = 1.6817928305074290f;
constexpr float LN_EPS = 1e-5f, RMS_EPS = 1e-6f;
constexpr int NWAVES = 8, NTHREADS = 512;
constexpr int LDS_BYTES = 163840;
constexpr int RING_BYTES = 131072, MISC_OFF = LDS_BYTES - 256;

constexpr size_t al256(size_t x) { return (x + 255) & ~(size_t)255; }
constexpr size_t WS_CTL = 0, CTL_BYTES = 1u << 20;
constexpr size_t SZ_MODP = (size_t)DEPTH * 8 * 3 * NMODV * 4, SZ_MOD = (size_t)DEPTH * 3 * NMODV * 4;
constexpr size_t WS_MODP = WS_CTL + CTL_BYTES, WS_MOD = al256(WS_MODP + SZ_MODP), WS_W = al256(WS_MOD + SZ_MOD);
constexpr size_t WO_IN = 0, SZ_IN = (size_t)NPROJ * DM * 2;
constexpr size_t WO_GO = WO_IN + SZ_IN, SZ_GO = (size_t)DM * DM * 2;
constexpr size_t WO_PG = WO_GO + SZ_GO, SZ_PG = (size_t)1024 * 1024 * 2;
constexpr size_t WO_PO = WO_PG + SZ_PG, SZ_PO = (size_t)DM * 1024 * 2;
constexpr size_t WO_OUT = WO_PO + SZ_PO, SZ_OUT = (size_t)DM * DM * 2;
constexpr size_t WO_FI = WO_OUT + SZ_OUT, SZ_FI = (size_t)NFFI * DM * 2;
constexpr size_t WO_FO = WO_FI + SZ_FI, SZ_FO = (size_t)DM * DFF * 2;
constexpr size_t WO_PC = WO_FO + SZ_FO;
constexpr size_t W_LAYER = WO_PC + SZ_PO;
constexpr size_t WS_X = al256(WS_W + DEPTH * W_LAYER), SZ_X = (size_t)MTOT * DM * 4;
constexpr size_t WS_V = WS_X + SZ_X;
constexpr size_t WS_H = WS_V + SZ_X, SZ_H = (size_t)MTOT * DM * 2;
constexpr size_t WS_PROJ = WS_H + SZ_H, SZ_PROJ = (size_t)MTOT * NPROJ * 2;
constexpr size_t WS_ACT = WS_PROJ;
constexpr int NCG = MTOT / 64;
constexpr size_t WS_LA = WS_PROJ + SZ_PROJ, SZ_LA = (size_t)2 * MTOT * 1024 * 4;
constexpr size_t WS_QI = WS_LA, SZ_QI = (size_t)2 * MTOT * 1024 * 2;
constexpr size_t WS_KST = WS_QI + SZ_QI, SZ_KST = (size_t)2 * NCG * 4 * 256 * 64 * 2;
constexpr size_t WS_PM = WS_KST + SZ_KST, SZ_PM = (size_t)2 * NCG * 4 * 64 * 64 * 2;
constexpr size_t WS_DCB = WS_PM + SZ_PM, SZ_DCB = (size_t)2 * NCG * 4 * 256 * 4;
constexpr size_t WS_VT = WS_DCB + SZ_DCB, SZ_VT = (size_t)NCG * 4 * 512 * 64 * 2;
constexpr size_t WS_GLAEND = WS_VT + SZ_VT;
static_assert(WS_GLAEND >= WS_LA + SZ_LA, "overlay");
constexpr size_t WS_O = WS_GLAEND, SZ_O = (size_t)MTOT * DM * 4;
constexpr size_t WS_AGLA = WS_O + 2 * SZ_O;
constexpr size_t WS_HM = WS_AGLA + SZ_H, SZ_HM = (size_t)MTOT * 1024 * 4;
constexpr size_t WS_T = WS_HM + SZ_HM, SZ_T = (size_t)MTOT * 1024 * 2;
constexpr size_t WS_U = WS_T + SZ_T;
constexpr size_t WS_TEMP = WS_U + SZ_T;
constexpr size_t WS_MRG = WS_TEMP + SZ_X;
constexpr size_t WS_END = WS_MRG + SZ_H;

struct Params {
    const float *x, *c, *ctx, *c_ctx, *w_ada, *b_ada, *w_in, *w_dup, *b_dup, *gla_gain, *w_pg, *pool_scale, *w_go, *w_po, *w_out, *ln1g, *ln1b, *w_fi, *w_fo, *ln2g, *ln2b;
    float* out; unsigned char* ws; int layer; int pad;
};
typedef float f32x2g __attribute__((ext_vector_type(2)));
typedef unsigned u32x2g __attribute__((ext_vector_type(2)));
struct Frame { LAS unsigned char* lds; int tid, lane, wave, vcu, G, gw, NGW; };

__device__ __forceinline__ bf16* wlayer(const Params& p, int l, size_t off) { return (bf16*)(p.ws + WS_W + (size_t)l * W_LAYER + off); }
__device__ __forceinline__ const float* modv(const Params& p, int l, int mi, int which) { return (const float*)(p.ws + WS_MOD) + ((size_t)l * 3 + mi) * NMODV + (size_t)which * DM; }
__device__ __forceinline__ float bf2f(unsigned short b) { return __builtin_bit_cast(float, (unsigned)b << 16); }
__device__ __forceinline__ float bflo(unsigned w) { return __builtin_bit_cast(float, w << 16); }
__device__ __forceinline__ float bfhi(unsigned w) { return __builtin_bit_cast(float, w & 0xffff0000u); }
__device__ __forceinline__ float fast_sigmoid(float x) { return __builtin_amdgcn_rcpf(1.0f + __expf(-x)); }
__device__ __forceinline__ float wave_sum(float v) {
#pragma unroll
    for (int o = 1; o < 64; o <<= 1) v += __shfl_xor(v, o);
    return v;
}
__device__ __forceinline__ int mod_index(int row) { return row < SEQ ? 0 : (row < MLAT ? 1 : 2); }

struct EpiProj {
    static constexpr bool PERM = true, AFTER_DRAIN = false;
    bf16* O;
    __device__ __forceinline__ void operator()(const pg8::f32x4 (&acc)[2][2][4][2], const pg8::Unit& u, int wr, int wc, int fr, int fq) const {
        const int row0 = u.pm * 256 + wr * 64 + fr, col0 = u.pn * 256 + wc * 32 + 8 * fq;
        const int mode = (u.pn >= 16 && u.pn < 24) ? 1 : ((u.pn >= 28 && u.pn < 44) ? 2 : 0);
#pragma unroll
        for (int ai = 0; ai < 2; ++ai)
#pragma unroll
            for (int m = 0; m < 4; ++m) { bf16* rowp = O + (size_t)(row0 + ai * 128 + m * 16) * NPROJ + col0;
#pragma unroll
                for (int bj = 0; bj < 2; ++bj) { pg8::f32x4 v0 = acc[ai][bj][m][0], v1 = acc[ai][bj][m][1];
                    if (mode != 0) {
#pragma unroll
                        for (int j = 0; j < 4; ++j) { const float s0 = fast_sigmoid(v0[j]), s1 = fast_sigmoid(v1[j]); v0[j] = (mode == 1) ? v0[j] * s0 : s0; v1[j] = (mode == 1) ? v1[j] * s1 : s1; } }
                    pg8::u32x4 w; w.x = pg8::cvt_pk_bf16(v0[0], v0[1]); w.y = pg8::cvt_pk_bf16(v0[2], v0[3]); w.z = pg8::cvt_pk_bf16(v1[0], v1[1]); w.w = pg8::cvt_pk_bf16(v1[2], v1[3]);
                    *(pg8::u32x4*)(rowp + bj * 128) = w; } }
    }
};
struct EpiBf16Plain {
    static constexpr bool PERM = true, AFTER_DRAIN = false;
    bf16* O; int ldc;
    __device__ __forceinline__ void operator()(const pg8::f32x4 (&acc)[2][2][4][2], const pg8::Unit& u, int wr, int wc, int fr, int fq) const {
        const int row0 = u.pm * 256 + wr * 64 + fr, col0 = u.pn * 256 + wc * 32 + 8 * fq;
#pragma unroll
        for (int ai = 0; ai < 2; ++ai)
#pragma unroll
            for (int m = 0; m < 4; ++m) { bf16* rowp = O + (size_t)(row0 + ai * 128 + m * 16) * ldc + col0;
#pragma unroll
                for (int bj = 0; bj < 2; ++bj) { const pg8::f32x4 v0 = acc[ai][bj][m][0], v1 = acc[ai][bj][m][1];
                    pg8::u32x4 w; w.x = pg8::cvt_pk_bf16(v0[0], v0[1]); w.y = pg8::cvt_pk_bf16(v0[2], v0[3]); w.z = pg8::cvt_pk_bf16(v1[0], v1[1]); w.w = pg8::cvt_pk_bf16(v1[2], v1[3]);
                    *(pg8::u32x4*)(rowp + bj * 128) = w; } }
    }
};
struct EpiGateTemp {
    static constexpr bool PERM = true, AFTER_DRAIN = false;
    float* T; const bf16* PROJ;
    __device__ __forceinline__ void operator()(const pg8::f32x4 (&acc)[2][2][4][2], const pg8::Unit& u, int wr, int wc, int fr, int fq) const {
        const int row0 = u.pm * 256 + wr * 64 + fr, col0 = u.pn * 256 + wc * 32 + 8 * fq;
#pragma unroll
        for (int ai = 0; ai < 2; ++ai)
#pragma unroll
            for (int m = 0; m < 4; ++m) { const int row = row0 + ai * 128 + m * 16;
#pragma unroll
                for (int bj = 0; bj < 2; ++bj) { const int c = col0 + bj * 128;
                    const pg8::u32x4 gw = *(const pg8::u32x4*)(PROJ + (size_t)row * NPROJ + CBP + c);
                    pg8::f32x4 v0 = acc[ai][bj][m][0], v1 = acc[ai][bj][m][1];
                    v0[0] *= bflo(gw.x); v0[1] *= bfhi(gw.x); v0[2] *= bflo(gw.y); v0[3] *= bfhi(gw.y);
                    v1[0] *= bflo(gw.z); v1[1] *= bfhi(gw.z); v1[2] *= bflo(gw.w); v1[3] *= bfhi(gw.w);
                    float* tp = T + (size_t)row * DM + c; *(pg8::f32x4*)tp = v0; *(pg8::f32x4*)(tp + 4) = v1; } }
    }
    __device__ __forceinline__ void small(int row, int col, pg8::f32x4 v) const {
        const u32x2g gw = *(const u32x2g*)(PROJ + (size_t)row * NPROJ + CBP + col);
        v[0] *= bflo(gw.x); v[1] *= bfhi(gw.x); v[2] *= bflo(gw.y); v[3] *= bfhi(gw.y); *(pg8::f32x4*)(T + (size_t)row * DM + col) = v; }
};
struct EpiMerge {
    static constexpr bool PERM = true, AFTER_DRAIN = false;
    bf16* O; const float* T; const bf16* PROJ;
    __device__ __forceinline__ void operator()(const pg8::f32x4 (&acc)[2][2][4][2], const pg8::Unit& u, int wr, int wc, int fr, int fq) const {
        const int row0 = u.pm * 256 + wr * 64 + fr, col0 = u.pn * 256 + wc * 32 + 8 * fq;
#pragma unroll
        for (int ai = 0; ai < 2; ++ai)
#pragma unroll
            for (int m = 0; m < 4; ++m) { const int row = row0 + ai * 128 + m * 16;
#pragma unroll
                for (int bj = 0; bj < 2; ++bj) { const int c = col0 + bj * 128;
                    const pg8::u32x4 gw = *(const pg8::u32x4*)(PROJ + (size_t)row * NPROJ + CBG + c);
                    const float* tp = T + (size_t)row * DM + c; const pg8::f32x4 t0 = *(const pg8::f32x4*)tp, t1 = *(const pg8::f32x4*)(tp + 4);
                    pg8::f32x4 v0 = acc[ai][bj][m][0], v1 = acc[ai][bj][m][1];
                    v0[0] = v0[0] * bflo(gw.x) + t0[0]; v0[1] = v0[1] * bfhi(gw.x) + t0[1]; v0[2] = v0[2] * bflo(gw.y) + t0[2]; v0[3] = v0[3] * bfhi(gw.y) + t0[3];
                    v1[0] = v1[0] * bflo(gw.z) + t1[0]; v1[1] = v1[1] * bfhi(gw.z) + t1[1]; v1[2] = v1[2] * bflo(gw.w) + t1[2]; v1[3] = v1[3] * bfhi(gw.w) + t1[3];
                    pg8::u32x4 w; w.x = pg8::cvt_pk_bf16(v0[0], v0[1]); w.y = pg8::cvt_pk_bf16(v0[2], v0[3]); w.z = pg8::cvt_pk_bf16(v1[0], v1[1]); w.w = pg8::cvt_pk_bf16(v1[2], v1[3]);
                    *(pg8::u32x4*)(O + (size_t)row * DM + c) = w; } }
    }
    __device__ __forceinline__ void small(int row, int col, pg8::f32x4 v) const {
        const u32x2g gw = *(const u32x2g*)(PROJ + (size_t)row * NPROJ + CBG + col); const pg8::f32x4 t = *(const pg8::f32x4*)(T + (size_t)row * DM + col);
        v[0] = v[0] * bflo(gw.x) + t[0]; v[1] = v[1] * bfhi(gw.x) + t[1]; v[2] = v[2] * bflo(gw.y) + t[2]; v[3] = v[3] * bfhi(gw.y) + t[3];
        *(u32x2g*)(O + (size_t)row * DM + col) = (u32x2g){pg8::cvt_pk_bf16(v[0], v[1]), pg8::cvt_pk_bf16(v[2], v[3])}; }
};
struct EpiResid {
    static constexpr bool PERM = false, AFTER_DRAIN = false;
    float* V; const float* xlat; const float* xctx; const float* gt0;
    __device__ __forceinline__ void operator()(const pg8::f32x4 (&acc)[2][2][4][2], const pg8::Unit& u, int wr, int wc, int fr, int fq) const {
        const int row0 = u.pm * 256 + wr * 64 + fr, col0 = u.pn * 256 + wc * 32 + 4 * fq;
        const int mi = u.pm < 16 ? 0 : (u.pm < 32 ? 1 : 2);
        const float* gt = gt0 + (size_t)mi * NMODV + col0;
        pg8::f32x4 gv[2][2];
#pragma unroll
        for (int bj = 0; bj < 2; ++bj)
#pragma unroll
            for (int n = 0; n < 2; ++n) gv[bj][n] = *(const pg8::f32x4*)(gt + bj * 128 + n * 16);
#pragma unroll
        for (int ai = 0; ai < 2; ++ai)
#pragma unroll
            for (int m = 0; m < 4; ++m) { const int row = row0 + ai * 128 + m * 16;
                const float* xr = (u.pm < 32 ? xlat + (size_t)row * DM : xctx + (size_t)(row - MLAT) * DM) + col0; float* vr = V + (size_t)row * DM + col0;
#pragma unroll
                for (int bj = 0; bj < 2; ++bj)
#pragma unroll
                    for (int n = 0; n < 2; ++n) { const pg8::f32x4 xv = *(const pg8::f32x4*)(xr + bj * 128 + n * 16);
                        *(pg8::f32x4*)(vr + bj * 128 + n * 16) = xv * ALPHA + gv[bj][n] * acc[ai][bj][m][n]; } }
    }
    __device__ __forceinline__ void small(int row, int col, pg8::f32x4 v) const {
        const pg8::f32x4 g = *(const pg8::f32x4*)(gt0 + (size_t)2 * NMODV + col), xv = *(const pg8::f32x4*)(xctx + (size_t)(row - MLAT) * DM + col);
        *(pg8::f32x4*)(V + (size_t)row * DM + col) = xv * ALPHA + g * v; }
};
struct EpiSwiglu {
    static constexpr bool PERM = true, AFTER_DRAIN = false;
    bf16* O;
    __device__ __forceinline__ void operator()(const pg8::f32x4 (&acc)[2][2][4][2], const pg8::Unit& u, int wr, int wc, int fr, int fq) const {
        const int row0 = u.pm * 256 + wr * 64 + fr, col0 = u.pn * 128 + wc * 32 + 8 * fq;
#pragma unroll
        for (int ai = 0; ai < 2; ++ai)
#pragma unroll
            for (int m = 0; m < 4; ++m) { const int row = row0 + ai * 128 + m * 16;
                pg8::f32x4 a0, a1;
#pragma unroll
                for (int j = 0; j < 4; ++j) { const float g0 = acc[ai][0][m][0][j], g1 = acc[ai][0][m][1][j];
                    a0[j] = g0 * fast_sigmoid(g0) * acc[ai][1][m][0][j]; a1[j] = g1 * fast_sigmoid(g1) * acc[ai][1][m][1][j]; }
                pg8::u32x4 w; w.x = pg8::cvt_pk_bf16(a0[0], a0[1]); w.y = pg8::cvt_pk_bf16(a0[2], a0[3]); w.z = pg8::cvt_pk_bf16(a1[0], a1[1]); w.w = pg8::cvt_pk_bf16(a1[2], a1[3]);
                *(pg8::u32x4*)(O + (size_t)row * DFF + col0) = w; }
    }
};

template <class Epi> __device__ __forceinline__ void small_gemm_ctx(const Frame& F, const bf16* A, const bf16* Bt, int K, const Epi& E) {
    const int c = (int)blockIdx.x; if (c >= 256) return;
    const int rb = MLAT + 64 * (c >> 5), cb = 64 * (c & 31);
    const int fr = F.lane & 15, fq = F.lane >> 4, kw = K >> 3;
    f32x4 acc[4][4];
#pragma unroll
    for (int m = 0; m < 4; ++m)
#pragma unroll
        for (int n = 0; n < 4; ++n) acc[m][n] = (f32x4){0.f, 0.f, 0.f, 0.f};
    const bf16* ap = A + (size_t)(rb + fr) * K + F.wave * kw + 8 * fq; const bf16* bp = Bt + (size_t)(cb + fr) * K + F.wave * kw + 8 * fq;
#pragma unroll 2
    for (int ks = 0; ks < kw; ks += 32) { bf16x8 a[4], b[4];
#pragma unroll
        for (int m = 0; m < 4; ++m) { a[m] = *(const GAS bf16x8*)(ap + (size_t)m * 16 * K + ks); b[m] = *(const GAS bf16x8*)(bp + (size_t)m * 16 * K + ks); }
#pragma unroll
        for (int m = 0; m < 4; ++m)
#pragma unroll
            for (int n = 0; n < 4; ++n) acc[m][n] = __builtin_amdgcn_mfma_f32_16x16x32_bf16(a[m], b[n], acc[m][n], 0, 0, 0); }
    LAS float* part = (LAS float*)F.lds + F.wave * 4096;
#pragma unroll
    for (int m = 0; m < 4; ++m)
#pragma unroll
        for (int n = 0; n < 4; ++n)
#pragma unroll
            for (int reg = 0; reg < 4; ++reg) part[(16 * m + 4 * fq + reg) * 64 + 16 * n + fr] = acc[m][n][reg];
    __syncthreads();
#pragma unroll
    for (int q = 0; q < 2; ++q) { const int idx = F.tid * 2 + q, row = idx >> 4, col = (idx & 15) * 4; f32x4 s = {0.f, 0.f, 0.f, 0.f};
#pragma unroll
        for (int w = 0; w < 8; ++w) s += *(const LAS f32x4*)((LAS float*)F.lds + w * 4096 + row * 64 + col);
        E.small(rb + row, cb + col, s); }
    __syncthreads();
}
__device__ __forceinline__ void transpose_item(const float* W, int N, int k0, int n0, bf16* WT, int ldk, int drow0, float colscale, const float* rowscale, LAS float* scr, int lane) {
#pragma unroll 8
    for (int i = 0; i < 32; ++i) { const int kk = 2 * i + (lane >> 5); float v = W[(size_t)(k0 + kk) * N + n0 + (lane & 31)]; if (rowscale) v *= rowscale[k0 + kk]; scr[kk * 33 + (lane & 31)] = v * colscale; }
    LDS_WAIT(); asm volatile("" ::: "memory");
    const int c = lane & 7;
#pragma unroll
    for (int j = 0; j < 4; ++j) { const int n = (lane >> 3) + 8 * j; const LAS float* s = scr + (8 * c) * 33 + n;
        v4u o; o.x = pk2(s[0 * 33], s[1 * 33]); o.y = pk2(s[2 * 33], s[3 * 33]); o.z = pk2(s[4 * 33], s[5 * 33]); o.w = pk2(s[6 * 33], s[7 * 33]);
        *(GAS v4u*)(WT + (size_t)(drow0 + n) * ldk + k0 + 8 * c) = o; }
    LDS_WAIT(); asm volatile("" ::: "memory");
}
constexpr int IT_IN = 32 * (NPROJ_SRC / 32), IT_GO = 32 * 64, IT_PO = 16 * 64, IT_OUT = 32 * 64, IT_FI = 32 * (NFFI / 32), IT_FO = (DFF / 64) * 64, IT_PG = 1024, IT_ZIN = 224, IT_ZPG = 1024;
constexpr int IT_LAYER = IT_IN + IT_GO + IT_PO + IT_OUT + IT_FI + IT_FO + IT_PG + IT_ZIN + IT_ZPG;
constexpr int IT_MOD = DEPTH * 48 * 8;
__device__ __forceinline__ void phase_prologue_a(const Frame& F, const Params& p) {
    LAS float* scr = (LAS float*)(F.lds + F.wave * 16384);
    for (int it = F.gw; it < IT_MOD; it += F.NGW) {
        const int l = it / 384, r = it % 384, nb = r / 8, kb = r % 8, k0 = 256 * kb, n0 = 256 * nb + 4 * F.lane;
#pragma unroll
        for (int j = 0; j < 4; ++j) { const int k = k0 + F.lane + 64 * j;
            const float c0 = p.c[k], c1 = p.c[DM + k], c2 = p.c_ctx[k];
            scr[(F.lane + 64 * j) * 3 + 0] = c0 / (1.0f + expf(-c0)); scr[(F.lane + 64 * j) * 3 + 1] = c1 / (1.0f + expf(-c1)); scr[(F.lane + 64 * j) * 3 + 2] = c2 / (1.0f + expf(-c2)); }
        LDS_WAIT(); asm volatile("" ::: "memory");
        f32x4 a0 = {0.f, 0.f, 0.f, 0.f}, a1 = a0, a2 = a0;
        const float* wp = p.w_ada + ((size_t)l * DM + k0) * NMODV + n0;
#pragma unroll 8
        for (int kk = 0; kk < 256; ++kk) { const f32x4 w = *(const GAS f32x4*)(wp + (size_t)kk * NMODV); const float s0 = scr[kk * 3], s1 = scr[kk * 3 + 1], s2 = scr[kk * 3 + 2];
            a0 += w * s0; a1 += w * s1; a2 += w * s2; }
        float* mp = (float*)(p.ws + WS_MODP) + ((size_t)(l * 8 + kb) * 3) * NMODV + n0;
        *(GAS f32x4*)(mp) = a0; *(GAS f32x4*)(mp + NMODV) = a1; *(GAS f32x4*)(mp + 2 * NMODV) = a2;
        LDS_WAIT(); asm volatile("" ::: "memory");
    }
    for (int it = F.gw; it < DEPTH * IT_LAYER; it += F.NGW) {
        const int l = it / IT_LAYER; int r = it % IT_LAYER;
        if (r < IT_IN) { const int nblk = NPROJ_SRC / 32, kb = r / nblk, n0 = 32 * (r % nblk);
            int drow; float cs = 1.0f;
            if (n0 < 6144) { drow = n0; if (n0 < 1024) cs = 0.0625f; } else if (n0 < 6176) drow = CA + (n0 - 6144); else if (n0 < 7200) drow = CP + (n0 - 6176); else drow = CBG + (n0 - 7200);
            transpose_item(p.w_in + (size_t)l * DM * NPROJ_SRC, NPROJ_SRC, 64 * kb, n0, wlayer(p, l, WO_IN), DM, drow, cs, nullptr, scr, F.lane); continue; } r -= IT_IN;
        if (r < IT_GO) { transpose_item(p.w_go + (size_t)l * DM * DM, DM, 64 * (r / 64), 32 * (r % 64), wlayer(p, l, WO_GO), DM, 32 * (r % 64), 1.0f, nullptr, scr, F.lane); continue; } r -= IT_GO;
        if (r < IT_PO) { transpose_item(p.w_po + (size_t)l * DPOOL * DM, DM, 64 * (r / 64), 32 * (r % 64), wlayer(p, l, WO_PO), DPOOL, 32 * (r % 64), 1.0f, p.pool_scale + (size_t)l * DPOOL, scr, F.lane); continue; } r -= IT_PO;
        if (r < IT_OUT) { transpose_item(p.w_out + (size_t)l * DM * DM, DM, 64 * (r / 64), 32 * (r % 64), wlayer(p, l, WO_OUT), DM, 32 * (r % 64), 1.0f, nullptr, scr, F.lane); continue; } r -= IT_OUT;
        if (r < IT_FI) { const int nblk = NFFI / 32, kb = r / nblk, n0 = 32 * (r % nblk), up = n0 >= DFF ? 1 : 0, ch = n0 - up * DFF;
            transpose_item(p.w_fi + (size_t)l * DM * NFFI, NFFI, 64 * kb, n0, wlayer(p, l, WO_FI), DM, 256 * (ch / 128) + 128 * up + (ch % 128), 1.0f, nullptr, scr, F.lane); continue; } r -= IT_FI;
        if (r < IT_FO) { transpose_item(p.w_fo + (size_t)l * DFF * DM, DM, 64 * (r / 64), 32 * (r % 64), wlayer(p, l, WO_FO), DFF, 32 * (r % 64), 1.0f, nullptr, scr, F.lane); continue; } r -= IT_FO;
        if (r < IT_PG) { const int g = r >> 8, i = r & 255;
            const f32x4 v = *(const GAS f32x4*)(p.w_pg + (((size_t)l * 4 + g) * 256 + i) * 256 + 4 * F.lane);
            *(GAS u32x2g*)(wlayer(p, l, WO_PG) + (size_t)(256 * g + i) * 1024 + 256 * g + 4 * F.lane) = (u32x2g){pk2(v.x, v.y), pk2(v.z, v.w)}; continue; } r -= IT_PG;
        if (r < IT_ZIN) { GAS v4u* zp = (GAS v4u*)(wlayer(p, l, WO_IN) + (size_t)(NPROJ_SRC + r) * DM);
#pragma unroll
            for (int j = 0; j < 4; ++j) zp[F.lane + 64 * j] = (v4u){0u, 0u, 0u, 0u};
            continue; } r -= IT_ZIN;
        { GAS v4u* zp = (GAS v4u*)(wlayer(p, l, WO_PG) + (size_t)r * 1024); const int g = r >> 8;
#pragma unroll
          for (int j = 0; j < 2; ++j) { const int ch = F.lane + 64 * j; if ((ch >> 5) != g) zp[ch] = (v4u){0u, 0u, 0u, 0u}; } }
    }
}
__device__ __forceinline__ void phase_prologue_b(const Frame& F, const Params& p) {
    const float* MP = (const float*)(p.ws + WS_MODP); float* MO = (float*)(p.ws + WS_MOD);
    for (int e = F.vcu * NTHREADS + F.tid; e < DEPTH * 3 * NMODV; e += F.G * NTHREADS) { const int l = e / (3 * NMODV), r = e % (3 * NMODV), n = r % NMODV;
        float s = p.b_ada[(size_t)l * NMODV + n];
#pragma unroll
        for (int kb = 0; kb < 8; ++kb) s += MP[((size_t)(l * 8 + kb) * 3) * NMODV + r];
        MO[e] = s; }
    LAS float* sm = (LAS float*)F.lds;
    for (int e = F.tid; e < 3 * 2 * DM; e += NTHREADS) { const int mi = e / (2 * DM), r = e % (2 * DM);
        float s = p.b_ada[r];
#pragma unroll
        for (int kb = 0; kb < 8; ++kb) s += MP[((size_t)kb * 3 + mi) * NMODV + r];
        sm[e] = s; }
    __syncthreads();
    bf16* H = (bf16*)(p.ws + WS_H);
    for (int row = F.gw; row < MTOT; row += F.NGW) { const int mi = mod_index(row);
        const float* xr = row < MLAT ? p.x + (size_t)row * DM : p.ctx + (size_t)(row - MLAT) * DM;
        const LAS float* sh = sm + mi * 2 * DM; const LAS float* sc = sh + DM;
        GAS unsigned long long* o8 = (GAS unsigned long long*)(H + (size_t)row * DM) + F.lane;
#pragma unroll
        for (int j = 0; j < 8; ++j) { const int c = 4 * F.lane + 256 * j; const f32x4 v = *(const GAS f32x4*)(xr + c);
            const float y0 = v.x * (1.0f + sc[c]) + sh[c], y1 = v.y * (1.0f + sc[c + 1]) + sh[c + 1], y2 = v.z * (1.0f + sc[c + 2]) + sh[c + 2], y3 = v.w * (1.0f + sc[c + 3]) + sh[c + 3];
            o8[64 * j] = (unsigned long long)pk2(y0, y1) | ((unsigned long long)pk2(y2, y3) << 32); } }
    __syncthreads();
}
__device__ __forceinline__ void phase_ln(const Frame& F, const Params& p, int l, int sub, int M) {
    const float* V = (const float*)(p.ws + WS_V); float* X = (float*)(p.ws + WS_X); bf16* H = (bf16*)(p.ws + WS_H);
    const float* gain = (sub == 0 ? p.ln1g : p.ln2g) + (size_t)l * DM; const float* bias = (sub == 0 ? p.ln1b : p.ln2b) + (size_t)l * DM;
    const bool last = (sub == 1 && l == DEPTH - 1);
    const int lm = sub == 0 ? l : l + 1, wsh = sub == 0 ? 3 : 0, wsc = sub == 0 ? 4 : 1;
    for (int row = F.gw; row < M; row += F.NGW) {
        const GAS f32x4* vr = (const GAS f32x4*)(V + (size_t)row * DM) + F.lane;
        f32x4 v[8]; float s = 0.f;
#pragma unroll
        for (int j = 0; j < 8; ++j) { v[j] = vr[64 * j]; s += (v[j].x + v[j].y) + (v[j].z + v[j].w); }
        const float mean = wave_sum(s) * (1.f / DM); float s2 = 0.f;
#pragma unroll
        for (int j = 0; j < 8; ++j) { v[j] = v[j] - mean; s2 += (v[j].x * v[j].x + v[j].y * v[j].y) + (v[j].z * v[j].z + v[j].w * v[j].w); }
        const float rstd = 1.f / sqrtf(wave_sum(s2) * (1.f / DM) + LN_EPS);
#pragma unroll
        for (int j = 0; j < 8; ++j) { const int c = 4 * F.lane + 256 * j; const f32x4 g = *(const GAS f32x4*)(gain + c), b = *(const GAS f32x4*)(bias + c); v[j] = v[j] * rstd * g + b; }
        if (last) { GAS f32x4* o = (GAS f32x4*)(p.out + (size_t)row * DM) + F.lane;
#pragma unroll
            for (int j = 0; j < 8; ++j) o[64 * j] = v[j];
        } else {
            GAS f32x4* xo = (GAS f32x4*)(X + (size_t)row * DM) + F.lane;
            const int mi = mod_index(row); const float* sh = modv(p, lm, mi, wsh); const float* sc = modv(p, lm, mi, wsc);
            GAS unsigned long long* o8 = (GAS unsigned long long*)(H + (size_t)row * DM) + F.lane;
#pragma unroll
            for (int j = 0; j < 8; ++j) { const int c = 4 * F.lane + 256 * j; xo[64 * j] = v[j];
                const f32x4 a = *(const GAS f32x4*)(sc + c), b = *(const GAS f32x4*)(sh + c); const f32x4 y = v[j] * (a + 1.0f) + b;
                o8[64 * j] = (unsigned long long)pk2(y.x, y.y) | ((unsigned long long)pk2(y.z, y.w) << 32); } }
    }
}
template <int G, int PASS> __device__ __forceinline__ void pool_task(const unsigned char* ws, int base_row, int st, int n, int pos0, int c) {
    constexpr int W = 2 << G, LO = W / 2, HI = W - LO - 1, NIN = 32 + W - 1;
    const bf16* PROJ = (const bf16*)(ws + WS_PROJ); float* HM = (float*)(ws + WS_HM); bf16* T = (bf16*)(ws + WS_T);
    float s0[NIN], s1[NIN];
#pragma unroll
    for (int q = 0; q < NIN; ++q) { const int pos = pos0 - LO + q; const bool ok = pos >= 0 && pos < n; const int row = base_row + (ok ? pos : pos0) * st;
        if (PASS == 0) { const unsigned wv = *(const GAS unsigned*)(PROJ + (size_t)row * NPROJ + CP + c); s0[q] = ok ? bflo(wv) : 0.f; s1[q] = ok ? bfhi(wv) : 0.f; }
        else { const f32x2g hv = *(const GAS f32x2g*)(HM + (size_t)row * DPOOL + c); s0[q] = ok ? hv.x : 0.f; s1[q] = ok ? hv.y : 0.f; } }
#pragma unroll
    for (int q = 1; q < NIN; ++q) { s0[q] += s0[q - 1]; s1[q] += s1[q - 1]; }
#pragma unroll
    for (int i = 0; i < 32; ++i) { const int pos = pos0 + i, row = base_row + pos * st;
        const int cnt = min(pos + HI + 1, n) - max(pos - LO, 0); const float inv = 1.0f / (float)cnt;
        const float m0 = (s0[i + W - 1] - (i > 0 ? s0[i > 0 ? i - 1 : 0] : 0.f)) * inv, m1 = (s1[i + W - 1] - (i > 0 ? s1[i > 0 ? i - 1 : 0] : 0.f)) * inv;
        if (PASS == 0) *(GAS f32x2g*)(HM + (size_t)row * DPOOL + c) = (f32x2g){m0, m1};
        else { const unsigned wv = *(const GAS unsigned*)(PROJ + (size_t)row * NPROJ + CP + c); *(GAS unsigned*)(T + (size_t)row * DPOOL + c) = pk2(m0 - bflo(wv), m1 - bfhi(wv)); } }
}
template <int PASS> __device__ __forceinline__ void pool_dispatch(const unsigned char* ws, int g, int base_row, int st, int n, int pos0, int c) {
    if (g == 0) pool_task<0, PASS>(ws, base_row, st, n, pos0, c); else if (g == 1) pool_task<1, PASS>(ws, base_row, st, n, pos0, c);
    else if (g == 2) pool_task<2, PASS>(ws, base_row, st, n, pos0, c); else pool_task<3, PASS>(ws, base_row, st, n, pos0, c);
}
constexpr int N_POOL_LAT = 128 * 2 * 8, N_POOL_CTX = 2 * 8 * 8, N_POOL_TASKS = N_POOL_LAT + N_POOL_CTX;
template <int PASS> __device__ __forceinline__ void phase_pool(const Frame& F, const Params& p, int wi, int nw) {
    for (int id = wi; id < N_POOL_TASKS; id += nw) {
        if (id < N_POOL_LAT) { const int cb = id & 7, half = (id >> 3) & 1, line = id >> 4, c = cb * 128 + 2 * F.lane;
            if (PASS == 0) pool_dispatch<0>(p.ws, cb >> 1, line * 64, 1, 64, 32 * half, c);
            else pool_dispatch<1>(p.ws, cb >> 1, (line >> 6) * SEQ + (line & 63), 64, 64, 32 * half, c);
        } else { const int id2 = id - N_POOL_LAT, cb = id2 & 7, blk = (id2 >> 3) & 7, b = id2 >> 6, c = cb * 128 + 2 * F.lane;
            if (PASS == 0) pool_dispatch<0>(p.ws, cb >> 1, MLAT + b * CTXL, 1, CTXL, 32 * blk, c);
            else { const bf16* PROJ = (const bf16*)(p.ws + WS_PROJ); const float* HM = (const float*)(p.ws + WS_HM); bf16* T = (bf16*)(p.ws + WS_T);
#pragma unroll 8
                for (int i = 0; i < 32; ++i) { const int row = MLAT + b * CTXL + 32 * blk + i; const f32x2g hv = *(const GAS f32x2g*)(HM + (size_t)row * DPOOL + c);
                    const unsigned wv = *(const GAS unsigned*)(PROJ + (size_t)row * NPROJ + CP + c); *(GAS unsigned*)(T + (size_t)row * DPOOL + c) = pk2(hv.x - bflo(wv), hv.y - bfhi(wv)); } }
        }
    }
}
__device__ __forceinline__ float log_sigmoid_f(float z) { return fminf(z, 0.f) - log1pf(expf(-fabsf(z))); }
__device__ __forceinline__ void phase_la(const Frame& F, const Params& p, int l) {
    const bf16* PROJ = (const bf16*)(p.ws + WS_PROJ); float* LA = (float*)(p.ws + WS_LA);
    for (int task = F.gw; task < MTOT * 2; task += F.NGW) { const int row = task >> 1, dir = task & 1;
        const bf16* ap = PROJ + (size_t)row * NPROJ + CA + dir * 16; float a[16];
#pragma unroll
        for (int r = 0; r < 16; ++r) a[r] = bf2f(ap[r]);
        const float* wu = p.w_dup + ((size_t)l * 2 + dir) * RANK * 1024; const float* bu = p.b_dup + ((size_t)l * 2 + dir) * 1024;
#pragma unroll
        for (int j = 0; j < 4; ++j) { const int d = 4 * F.lane + 256 * j; f32x4 z = *(const GAS f32x4*)(bu + d);
#pragma unroll
            for (int r = 0; r < 16; ++r) z += *(const GAS f32x4*)(wu + (size_t)r * 1024 + d) * a[r];
            f32x4 o; o.x = log_sigmoid_f(z.x) * 0.0625f; o.y = log_sigmoid_f(z.y) * 0.0625f; o.z = log_sigmoid_f(z.z) * 0.0625f; o.w = log_sigmoid_f(z.w) * 0.0625f;
            *(GAS f32x4*)(LA + ((size_t)dir * MTOT + row) * 1024 + d) = o; } }
}
__device__ __forceinline__ void phase_gla_naive(const Frame& F, const Params& p) {
    const bf16* PROJ = (const bf16*)(p.ws + WS_PROJ); const float* LA = (const float*)(p.ws + WS_LA); float* O = (float*)(p.ws + WS_O);
    for (int it = F.gw; it < NBATCH * NH * HV; it += F.NGW) { const int b = it >> 11, h = (it >> 9) & 3, vcol = it & 511;
        for (int dir = 0; dir < 2; ++dir) {
            float S0 = 0.f, S1 = 0.f, S2 = 0.f, S3 = 0.f;
#pragma unroll 4
            for (int step = 0; step < CTXL + SEQ; ++step) {
                int row; if (step < CTXL) { const int t = dir ? CTXL - 1 - step : step; row = MLAT + b * CTXL + t; } else { const int s2 = step - CTXL; const int t = dir ? SEQ - 1 - s2 : s2; row = b * SEQ + t; }
                const bf16* pr = PROJ + (size_t)row * NPROJ;
                const u32x2g qw = *(const GAS u32x2g*)(pr + CQ + h * HK + 4 * F.lane), kw = *(const GAS u32x2g*)(pr + CK + h * HK + 4 * F.lane);
                const f32x4 la = *(const GAS f32x4*)(LA + ((size_t)dir * MTOT + row) * 1024 + h * HK + 4 * F.lane);
                const float vv = bf2f(pr[CV + h * HV + vcol]);
                S0 = expf(la.x) * S0 + bflo(kw.x) * vv; S1 = expf(la.y) * S1 + bfhi(kw.x) * vv; S2 = expf(la.z) * S2 + bflo(kw.y) * vv; S3 = expf(la.w) * S3 + bfhi(kw.y) * vv;
                const float part = wave_sum((bflo(qw.x) * S0 + bfhi(qw.x) * S1) + (bflo(qw.y) * S2 + bfhi(qw.y) * S3));
                if (F.lane == 0) { float* op = O + (size_t)row * DM + h * HV + vcol; *op = dir ? *op + part : part; }
            }
        }
    }
}
template <int NO> __device__ __forceinline__ void phase_gout(const Frame& F, const Params& p, int l, int M) {
    const bf16* PROJ = (const bf16*)(p.ws + WS_PROJ); const float* O = (const float*)(p.ws + WS_O); bf16* A = (bf16*)(p.ws + WS_AGLA);
    const float* gain = p.gla_gain + (size_t)l * DM;
    for (int task = F.gw; task < M * NH; task += F.NGW) { const int row = task >> 2, h = task & 3, c = h * HV + 8 * F.lane;
        f32x4 o0 = *(const GAS f32x4*)(O + (size_t)row * DM + c), o1 = *(const GAS f32x4*)(O + (size_t)row * DM + c + 4);
        if (NO == 2) { o0 += *(const GAS f32x4*)(O + (size_t)(MTOT + row) * DM + c); o1 += *(const GAS f32x4*)(O + (size_t)(MTOT + row) * DM + c + 4); }
        const float ss = wave_sum((o0.x * o0.x + o0.y * o0.y) + (o0.z * o0.z + o0.w * o0.w) + (o1.x * o1.x + o1.y * o1.y) + (o1.z * o1.z + o1.w * o1.w));
        const float r = 1.0f / sqrtf(ss * (1.0f / HV) + RMS_EPS);
        const f32x4 g0 = *(const GAS f32x4*)(gain + c), g1 = *(const GAS f32x4*)(gain + c + 4);
        const v4u gw = *(const GAS v4u*)(PROJ + (size_t)row * NPROJ + CG + c);
        v4u w; w.x = pk2(o0.x * r * g0.x * bflo(gw.x), o0.y * r * g0.y * bfhi(gw.x)); w.y = pk2(o0.z * r * g0.z * bflo(gw.y), o0.w * r * g0.w * bfhi(gw.y));
        w.z = pk2(o1.x * r * g1.x * bflo(gw.z), o1.y * r * g1.y * bfhi(gw.z)); w.w = pk2(o1.z * r * g1.z * bflo(gw.w), o1.w * r * g1.w * bfhi(gw.w));
        *(GAS v4u*)(A + (size_t)row * DM + c) = w; }
}

typedef float f32x16 __attribute__((ext_vector_type(16)));
__device__ __forceinline__ int swap23(int d) { return (d & ~12) | ((d & 4) << 1) | ((d & 8) >> 1); }
constexpr int PREP_ROW = 528;
constexpr int PREP_QS = 0, PREP_KS = 64 * PREP_ROW, PREP_QT = 2 * 64 * PREP_ROW, PREP_AL = 3 * 64 * PREP_ROW, PREP_TOT = PREP_AL + 4096;
constexpr int N_PREP_A = NCG * 4 * 2, N_PREP_V = NCG * 4;
constexpr int VT_ROW = 1040;

__device__ __forceinline__ float log_sigmoid_fast(float z) { return -__logf(1.0f + __expf(-z)); }
__device__ __forceinline__ void phase_gla_prep(const Frame& F, const Params& p, int l) {
    const bf16* PROJ = (const bf16*)(p.ws + WS_PROJ);
    bf16* QI = (bf16*)(p.ws + WS_QI); bf16* KST = (bf16*)(p.ws + WS_KST); bf16* PM = (bf16*)(p.ws + WS_PM); float* DCB = (float*)(p.ws + WS_DCB); bf16* VT = (bf16*)(p.ws + WS_VT);
    for (int item = F.vcu; item < N_PREP_A + N_PREP_V; item += F.G) {
        if (item < N_PREP_A) {
            const int cg = item >> 3, h = (item >> 1) & 3, dir = item & 1, r0 = cg * 64;
            LAS float* AL = (LAS float*)(F.lds + PREP_AL); LAS float* TOT = (LAS float*)(F.lds + PREP_TOT);
            LAS unsigned short* QS = (LAS unsigned short*)(F.lds + PREP_QS); LAS unsigned short* KS = (LAS unsigned short*)(F.lds + PREP_KS); LAS unsigned short* QT = (LAS unsigned short*)(F.lds + PREP_QT);
#pragma unroll
            for (int k = 0; k < 4; ++k) { const int id = F.tid + NTHREADS * k, row = id >> 5, c = id & 31; const bf16* pr = PROJ + (size_t)(r0 + row) * NPROJ + h * HK + 8 * c;
                *(LAS v4u*)(F.lds + PREP_QS + row * PREP_ROW + 16 * c) = *(const GAS v4u*)(pr + CQ); *(LAS v4u*)(F.lds + PREP_KS + row * PREP_ROW + 16 * c) = *(const GAS v4u*)(pr + CK); }
            { const int j = F.tid >> 3, r2 = (F.tid & 7) * 2; const unsigned w = *(const GAS unsigned*)(PROJ + (size_t)(r0 + j) * NPROJ + CA + dir * 16 + r2); AL[j * 16 + r2] = bflo(w); AL[j * 16 + r2 + 1] = bfhi(w); }
            const int d = F.tid & 255, jh = F.tid >> 8;
            float w[16];
#pragma unroll
            for (int r = 0; r < 16; ++r) w[r] = p.w_dup[(((size_t)l * 2 + dir) * RANK + r) * 1024 + h * HK + d];
            const float bz = p.b_dup[((size_t)l * 2 + dir) * 1024 + h * HK + d];
            __syncthreads();
            float ex[32]; float run = 0.f;
#pragma unroll
            for (int jo = 0; jo < 32; ++jo) { const LAS f32x4* a = (const LAS f32x4*)(AL + (jh * 32 + jo) * 16); float z = bz;
#pragma unroll
                for (int r4 = 0; r4 < 4; ++r4) { const f32x4 av = a[r4]; z += av.x * w[4 * r4] + av.y * w[4 * r4 + 1] + av.z * w[4 * r4 + 2] + av.w * w[4 * r4 + 3]; }
                ex[jo] = run; run += log_sigmoid_fast(z) * 0.0625f; }
            TOT[jh * 256 + d] = run;
            __syncthreads();
            const float t0 = TOT[d], t1 = TOT[256 + d], tot = run;
            const float first = dir ? t1 : t0;
            const float last = t0 + t1;
            const float off = (jh == dir) ? 0.f : first;
            const float Eref = __expf(first), Elr = __expf(last - first);
            const size_t gi = ((size_t)dir * NCG + cg) * 4 + h;
            if (jh == 0) DCB[gi * 256 + d] = __expf(last);
            unsigned kpack[16];
#pragma unroll
            for (int jo = 0; jo < 32; ++jo) { const int j = jh * 32 + jo;
                const float incl = (jo < 31) ? ex[(jo + 1) & 31] : tot;
                const float cum = (dir ? (tot - ex[jo]) : incl) + off;
                const float x = cum - first, e1 = __expf(x), e2 = __expf(-x);
                const float q = bf2f(QS[j * (PREP_ROW / 2) + d]), k = bf2f(KS[j * (PREP_ROW / 2) + d]);
                const float qin = q * e1, kin = k * e2;
                QS[j * (PREP_ROW / 2) + d] = (unsigned short)f2bf(qin); KS[j * (PREP_ROW / 2) + d] = (unsigned short)f2bf(kin); QT[j * (PREP_ROW / 2) + d] = (unsigned short)f2bf(qin * Eref);
                const unsigned kb = f2bf(kin * Elr); if (jo & 1) kpack[jo >> 1] |= kb << 16; else kpack[jo >> 1] = kb; }
            { GAS v4u* kp = (GAS v4u*)(KST + (gi * 256 + d) * 64 + jh * 32);
#pragma unroll
              for (int c = 0; c < 4; ++c) kp[c] = (v4u){kpack[4 * c], kpack[4 * c + 1], kpack[4 * c + 2], kpack[4 * c + 3]}; }
            __syncthreads();
#pragma unroll
            for (int k = 0; k < 4; ++k) { const int id = F.tid + NTHREADS * k, row = id >> 5, c = id & 31;
                *(GAS v4u*)(QI + ((size_t)dir * MTOT + r0 + row) * 1024 + h * HK + 8 * c) = *(const LAS v4u*)(F.lds + PREP_QT + row * PREP_ROW + 16 * c); }
            { const int ti = F.wave >> 1, fr = F.lane & 15, fq = F.lane >> 4;
#pragma unroll
              for (int q2 = 0; q2 < 2; ++q2) { const int tj = (F.wave & 1) * 2 + q2; f32x4 acc = {0.f, 0.f, 0.f, 0.f};
#pragma unroll
                for (int ks = 0; ks < 8; ++ks) { const bf16x8 a = *(const LAS bf16x8*)(F.lds + PREP_KS + (16 * tj + fr) * PREP_ROW + (32 * ks + 8 * fq) * 2);
                    const bf16x8 bq = *(const LAS bf16x8*)(F.lds + PREP_QS + (16 * ti + fr) * PREP_ROW + (32 * ks + 8 * fq) * 2);
                    acc = __builtin_amdgcn_mfma_f32_16x16x32_bf16(a, bq, acc, 0, 0, 0); }
                const int i = 16 * ti + fr, j0 = 16 * tj + 4 * fq; float v[4];
#pragma unroll
                for (int reg = 0; reg < 4; ++reg) { const int j = j0 + reg; const bool keep = dir ? (j >= i) : (j <= i); v[reg] = keep ? acc[reg] : 0.f; }
                *(GAS u32x2g*)(PM + (gi * 64 + i) * 64 + j0) = (u32x2g){pk2(v[0], v[1]), pk2(v[2], v[3])}; } }
            __syncthreads();
        } else {
            const int it = item - N_PREP_A, cg = it >> 2, h = it & 3, r0 = cg * 64;
#pragma unroll
            for (int k = 0; k < 8; ++k) { const int id = F.tid + NTHREADS * k, row = id >> 6, c = id & 63;
                const v4u x = *(const GAS v4u*)(PROJ + (size_t)(r0 + row) * NPROJ + CV + h * HV + 8 * c); *(LAS v4u*)(F.lds + row * VT_ROW + 16 * c) = x; }
            __syncthreads();
#pragma unroll
            for (int k = 0; k < 8; ++k) { const int id = F.tid + NTHREADS * k, v = id & 511, jb = id >> 9; unsigned e[8];
#pragma unroll
                for (int jj = 0; jj < 8; ++jj) e[jj] = *(const LAS unsigned short*)(F.lds + (8 * jb + jj) * VT_ROW + 2 * v);
                *(GAS v4u*)(VT + (((size_t)cg * 4 + h) * 512 + v) * 64 + 8 * jb) = (v4u){e[0] | (e[1] << 16), e[2] | (e[3] << 16), e[4] | (e[5] << 16), e[6] | (e[7] << 16)}; }
            __syncthreads();
        }
    }
}

#define MFMA32(a, b, c) __builtin_amdgcn_mfma_f32_32x32x16_bf16((a), (b), (c), 0, 0, 0)
#define MFMA16(a, b, c) __builtin_amdgcn_mfma_f32_16x16x32_bf16((a), (b), (c), 0, 0, 0)
constexpr int S8_QI = 0, S8_EX = 65536, S8_EXSZ = 13312, S8_KST = S8_EX + 2 * S8_EXSZ, S8_ST = S8_KST + 32768, S8_STSZ = 32 * 528, S8_END = S8_ST + 2 * S8_STSZ;
static_assert(S8_END <= MISC_OFF, "scan LDS map");
__device__ __forceinline__ void glds16(const unsigned char* ws, unsigned off, LAS unsigned char* l) { __builtin_amdgcn_global_load_lds((const unsigned*)(ws + off), (LAS unsigned*)l, 16, 0, 0); }
__device__ __forceinline__ int scan_chunk(int n, int b, int dir) { n = n > 67 ? 67 : n; return n < 4 ? 128 + 4 * b + (dir ? 3 - n : n) : 64 * b + (dir ? 67 - n : n - 4); }
#define SC_WAIT_V(n) asm volatile("s_waitcnt vmcnt(" #n ")" ::: "memory")
#define SC_FENCE() asm volatile("" ::: "memory")

__device__ __forceinline__ void phase_gla_scan(const Frame& F, const Params& p) {
    const int item = F.vcu; if (item >= 256) return;
    const int g16 = item >> 4, vs = item & 15, b = g16 >> 3, h = (g16 >> 1) & 3, dir = g16 & 1;
    const int lane = F.lane, w = F.wave, r = lane & 31, hh = lane >> 5, fr = lane & 15, fq = lane >> 4, ti = w >> 1, tv = w & 1;
    LAS unsigned char* lds = F.lds; const unsigned char* ws = p.ws;
    const unsigned QI0 = (unsigned)(WS_QI + ((size_t)dir * MTOT * 1024 + h * HK) * 2), KST0 = (unsigned)(WS_KST + ((size_t)dir * NCG * 4 + h) * 32768) + (unsigned)w * 4096u;
    const unsigned PM0 = (unsigned)(WS_PM + ((size_t)dir * NCG * 4 + h) * 8192), DC0 = (unsigned)(WS_DCB + ((size_t)dir * NCG * 4 + h) * 1024), VT0 = (unsigned)(WS_VT + ((size_t)h * 512 + vs * 32) * 128);
    const unsigned O0 = (unsigned)(WS_O + ((size_t)dir * MTOT * DM + h * HV + vs * 32) * 4);
    unsigned qoff[4];
#pragma unroll
    for (int j = 0; j < 4; ++j) { const int row = 8 * w + 2 * j + (lane >> 5); qoff[j] = (unsigned)(row * 2048 + 16 * ((lane & 31) ^ (row & 15))); }
    const unsigned koffe = (unsigned)((lane >> 3) * 128 + 16 * ((lane & 7) ^ (lane >> 4))), koffo = (unsigned)((lane >> 3) * 128 + 16 * ((lane & 7) ^ ((lane >> 4) + 4)));
    const unsigned kme = (w & 1) ? koffo : koffe;
    const int x16 = fr, xk = (r >> 1) & 7, xf = (fr >> 1) & 7;
    f32x16 S;
#pragma unroll
    for (int i = 0; i < 16; ++i) S[i] = 0.f;
#define S8_ISSUE_SHARED(cgx, par) do { const unsigned qb_ = QI0 + (unsigned)(cgx) * 131072u; LAS unsigned char* e_ = lds + S8_EX + (par) * S8_EXSZ; \
        _Pragma("unroll") for (int j_ = 0; j_ < 4; ++j_) glds16(ws, qb_ + qoff[j_], lds + S8_QI + (par) * 32768 + (8 * w + 2 * j_) * 512); \
        glds16(ws, PM0 + (unsigned)(cgx) * 32768u + (unsigned)w * 1024u + kme, e_ + w * 1024); \
        if (w < 4) glds16(ws, VT0 + (unsigned)(cgx) * 262144u + (unsigned)w * 1024u + kme, e_ + 8192 + w * 1024); \
        else if (w == 4) glds16(ws, DC0 + (unsigned)(cgx) * 4096u + (unsigned)lane * 16u, e_ + 12288); \
        else glds16(ws, PM0 + (unsigned)(cgx) * 32768u + (unsigned)w * 1024u + kme, e_ + w * 1024); } while (0)
#define S8_ISSUE_KST(cgx) do { const unsigned kb_ = KST0 + (unsigned)(cgx) * 131072u; \
        _Pragma("unroll") for (int j_ = 0; j_ < 4; ++j_) glds16(ws, kb_ + j_ * 1024 + ((j_ & 1) ? koffo : koffe), lds + S8_KST + w * 4096 + j_ * 1024); } while (0)
    int cg = scan_chunk(0, b, dir);
    S8_ISSUE_SHARED(cg, 0); S8_ISSUE_KST(cg);
    for (int n = 0; n < 68; ++n) {
        const int par = n & 1, cgn = scan_chunk(n + 1, b, dir);
        LAS unsigned char* st = lds + S8_ST + par * S8_STSZ; const LAS unsigned char* qi = lds + S8_QI + par * 32768; const LAS unsigned char* ex = lds + S8_EX + par * S8_EXSZ;
        SC_WAIT_V(4);
#pragma unroll
        for (int g = 0; g < 4; ++g) *(LAS u32x2g*)(st + r * 528 + (32 * w + 8 * g + 4 * hh) * 2) = (u32x2g){pk2(S[4 * g], S[4 * g + 1]), pk2(S[4 * g + 2], S[4 * g + 3])};
        asm volatile("s_waitcnt lgkmcnt(0)" ::: "memory"); __builtin_amdgcn_s_barrier(); SC_FENCE();
        S8_ISSUE_SHARED(cgn, par ^ 1);
        f32x4 o = {0.f, 0.f, 0.f, 0.f};
#pragma unroll
        for (int ks = 0; ks < 8; ++ks) { const bf16x8 a = *(const LAS bf16x8*)(qi + (16 * ti + fr) * 512 + 16 * ((4 * ks + fq) ^ x16)); const bf16x8 bb = *(const LAS bf16x8*)(st + (16 * tv + fr) * 528 + (32 * ks + 8 * fq) * 2); o = MFMA16(a, bb, o); }
#pragma unroll
        for (int k2 = 0; k2 < 2; ++k2) { const bf16x8 a = *(const LAS bf16x8*)(ex + (16 * ti + fr) * 128 + 16 * ((4 * k2 + fq) ^ xf)); const bf16x8 bb = *(const LAS bf16x8*)(ex + 8192 + (16 * tv + fr) * 128 + 16 * ((4 * k2 + fq) ^ xf)); o = MFMA16(a, bb, o); }
        { const unsigned ob = O0 + (unsigned)cg * (64u * DM * 4u) + (unsigned)((16 * ti + 4 * fq) * (DM * 4) + (16 * tv + fr) * 4);
#pragma unroll
          for (int reg = 0; reg < 4; ++reg) *(GAS float*)(ws + ob + (unsigned)(reg * DM * 4)) = o[reg]; }
        SC_WAIT_V(10);
        SC_FENCE();
#pragma unroll
        for (int g = 0; g < 4; ++g) { const f32x4 dc = *(const LAS f32x4*)(ex + 12288 + (32 * w + 8 * g + 4 * hh) * 4); S[4 * g] *= dc.x; S[4 * g + 1] *= dc.y; S[4 * g + 2] *= dc.z; S[4 * g + 3] *= dc.w; }
#pragma unroll
        for (int s4 = 0; s4 < 4; ++s4) { const bf16x8 ka = *(const LAS bf16x8*)(lds + S8_KST + w * 4096 + r * 128 + 16 * ((2 * s4 + hh) ^ xk)); const bf16x8 vb = *(const LAS bf16x8*)(ex + 8192 + r * 128 + 16 * ((2 * s4 + hh) ^ xk)); S = MFMA32(ka, vb, S); }
        asm volatile("s_waitcnt lgkmcnt(0)" ::: "memory");
        S8_ISSUE_KST(cgn);
        cg = cgn;
    }
    SC_WAIT_V(0);
    __builtin_amdgcn_s_barrier();
#undef S8_ISSUE_SHARED
#undef S8_ISSUE_KST
}

enum { PH_PRO_A = 0, PH_PRO_B, PH_WIN, PH_LA, PH_GLA, PH_GOUT, PH_GO, PH_WOUT, PH_LN0, PH_FFI, PH_FFO, PH_LN1, PH_COUNT };

template <int PH> __device__ __forceinline__ void run_phase(const Frame& F0, const Params& p0, int l) {
    Frame F = F0; asm volatile("" : "+v"(F.tid));
    F.lane = F.tid & 63; F.wave = __builtin_amdgcn_readfirstlane(F.tid >> 6); F.gw = F.vcu * NWAVES + F.wave;
    Params p = p0; asm volatile("" : "+s"(p.ws));
    const int M = (l == DEPTH - 1) ? MLAT : MTOT;
    bf16* H = (bf16*)(p.ws + WS_H); bf16* PROJ = (bf16*)(p.ws + WS_PROJ); bf16* ACT = (bf16*)(p.ws + WS_ACT); float* X = (float*)(p.ws + WS_X); float* V = (float*)(p.ws + WS_V);
    bf16* AGLA = (bf16*)(p.ws + WS_AGLA); bf16* T = (bf16*)(p.ws + WS_T); float* TEMP = (float*)(p.ws + WS_TEMP); bf16* MRG = (bf16*)(p.ws + WS_MRG);
    pg8::StaticOrder S;
    if constexpr (PH == PH_PRO_A) phase_prologue_a(F, p);
    if constexpr (PH == PH_PRO_B) {
        const int ng = F.G / 4, c = (int)blockIdx.x, lyr = c / ng < DEPTH ? c / ng : DEPTH - 1;
        pg8::Gemm g{wlayer(p, lyr, WO_PO), wlayer(p, lyr, WO_PG), DM, 1024, 1024}; S.init(DM, 1024, ng, c < DEPTH * ng ? c % ng : (1 << 20)); EpiBf16Plain E{wlayer(p, lyr, WO_PC), 1024};
        pg8::gemm_phase<EpiBf16Plain, pg8::StaticOrder, true, true>(F.lds, g, S, E);
        phase_prologue_b(F, p); }
    if constexpr (PH == PH_WIN) { pg8::Gemm g{H, wlayer(p, l, WO_IN), MTOT, NPROJ, DM}; S.init(MTOT, NPROJ, F.G, (int)blockIdx.x); EpiProj E{PROJ};
        pg8::gemm_phase<EpiProj, pg8::StaticOrder, true, true>(F.lds, g, S, E); }
    if constexpr (PH == PH_LA) { phase_pool<0>(F, p, F.gw, F.NGW); phase_gla_prep(F, p, l); }
    if constexpr (PH == PH_GLA) { phase_pool<1>(F, p, F.gw, F.NGW); phase_gla_scan(F, p); }
    if constexpr (PH == PH_GOUT) { phase_gout<2>(F, p, l, M);
        pg8::Gemm g{T, wlayer(p, l, WO_PC), MLAT, DM, DPOOL}; S.init(MLAT, DM, F.G, (int)blockIdx.x); EpiGateTemp E{TEMP, PROJ};
        pg8::gemm_phase<EpiGateTemp, pg8::StaticOrder, true, true>(F.lds, g, S, E);
        if (l < DEPTH - 1) small_gemm_ctx(F, T, wlayer(p, l, WO_PC), DPOOL, E); }
    if constexpr (PH == PH_GO) { pg8::Gemm g{AGLA, wlayer(p, l, WO_GO), MLAT, DM, DM}; S.init(MLAT, DM, F.G, (int)blockIdx.x); EpiMerge E{MRG, TEMP, PROJ};
        pg8::gemm_phase<EpiMerge, pg8::StaticOrder, true, true>(F.lds, g, S, E);
        if (l < DEPTH - 1) small_gemm_ctx(F, AGLA, wlayer(p, l, WO_GO), DM, E); }
    if constexpr (PH == PH_WOUT) { pg8::Gemm g{MRG, wlayer(p, l, WO_OUT), MLAT, DM, DM}; S.init(MLAT, DM, F.G, (int)blockIdx.x);
        EpiResid E{V, l == 0 ? p.x : X, l == 0 ? p.ctx : X + (size_t)MLAT * DM, modv(p, l, 0, 2)};
        pg8::gemm_phase<EpiResid, pg8::StaticOrder, true, true>(F.lds, g, S, E);
        if (l < DEPTH - 1) small_gemm_ctx(F, MRG, wlayer(p, l, WO_OUT), DM, E); }
    if constexpr (PH == PH_LN0) phase_ln(F, p, l, 0, M);
    if constexpr (PH == PH_FFI) { pg8::Gemm g{H, wlayer(p, l, WO_FI), M, NFFI, DM}; S.init(M, NFFI, F.G, (int)blockIdx.x); EpiSwiglu E{ACT};
        pg8::gemm_phase<EpiSwiglu, pg8::StaticOrder, true, true>(F.lds, g, S, E); }
    if constexpr (PH == PH_FFO) { pg8::Gemm g{ACT, wlayer(p, l, WO_FO), MLAT, DM, DFF}; S.init(MLAT, DM, F.G, (int)blockIdx.x);
        EpiResid E{V, X, X + (size_t)MLAT * DM, modv(p, l, 0, 5)};
        pg8::gemm_phase<EpiResid, pg8::StaticOrder, true, true>(F.lds, g, S, E);
        if (l < DEPTH - 1) small_gemm_ctx(F, ACT, wlayer(p, l, WO_FO), DFF, E); }
    if constexpr (PH == PH_LN1) phase_ln(F, p, l, 1, M);
}
__device__ __forceinline__ Frame make_frame(unsigned char* lds) {
    Frame F; F.lds = (LAS unsigned char*)lds; F.tid = threadIdx.x; F.lane = F.tid & 63; F.wave = __builtin_amdgcn_readfirstlane(F.tid >> 6);
    F.G = gridDim.x; const int bx = blockIdx.x; F.vcu = (F.G % 8 == 0) ? (bx % 8) * (F.G / 8) + bx / 8 : bx; F.gw = F.vcu * NWAVES + F.wave; F.NGW = F.G * NWAVES;
    return F;
}

constexpr int CW_BAR = 4096;
__device__ __forceinline__ XcdBarrier mkbar(const Params& p, unsigned x, volatile LAS unsigned* st) { unsigned char* w = p.ws; asm volatile("" : "+s"(w), "+s"(x)); XcdBarrier b; b.bar = (unsigned*)(w + WS_CTL) + CW_BAR; b.x = x; b.st = st; return b; }
#define PHASE(ph, l) do { run_phase<ph>(F, p, (l)); xcd_barrier(mkbar(p, bar_x, bar_st)); } while (0)
__global__ void __launch_bounds__(NTHREADS, 2) k_mega(Params p) {
    extern __shared__ __attribute__((aligned(16))) unsigned char lds[];
    const Frame F = make_frame(lds);
    for (int u = F.tid; u < (LDS_BYTES - MISC_OFF) / 4; u += NTHREADS) ((LAS unsigned*)(F.lds + MISC_OFF))[u] = 0u;
    __syncthreads();
    volatile LAS unsigned* const bar_st = (volatile LAS unsigned*)(F.lds + MISC_OFF) + 8;
    const unsigned bar_x = xcd_barrier_post((unsigned*)(p.ws + WS_CTL) + CW_BAR, bar_st).x;
    PHASE(PH_PRO_A, 0);
    PHASE(PH_PRO_B, 0);
    for (int l = 0; l < DEPTH; ++l) {
        PHASE(PH_WIN, l);
        PHASE(PH_LA, l);
        PHASE(PH_GLA, l);
        PHASE(PH_GOUT, l);
        PHASE(PH_GO, l);
        PHASE(PH_WOUT, l);
        PHASE(PH_LN0, l);
        PHASE(PH_FFI, l);
        PHASE(PH_FFO, l);
        if (l < DEPTH - 1) PHASE(PH_LN1, l); else run_phase<PH_LN1>(F, p, l);
    }
}

extern "C" void kernel_launch(void* const* d_in, const int* in_sizes, int n_in, void* d_out, int out_size, void* d_ws, size_t ws_size, hipStream_t stream) {
    static int grid = 0;
    if (grid == 0) {
        if (n_in != 21 || out_size != MLAT * DM || ws_size < WS_END) { fprintf(stderr, "kernel_launch: unexpected problem (n_in %d, out %d, ws %zu, need %zu)\n", n_in, out_size, ws_size, (size_t)WS_END); grid = -1; return; }
        int dev = 0, cus = 0, per_cu = 0;
        if (hipGetDevice(&dev) != hipSuccess || hipDeviceGetAttribute(&cus, hipDeviceAttributeMultiprocessorCount, dev) != hipSuccess) { grid = -1; return; }
        if (hipFuncSetAttribute((const void*)k_mega, hipFuncAttributeMaxDynamicSharedMemorySize, LDS_BYTES) != hipSuccess) { fprintf(stderr, "kernel_launch: hipFuncSetAttribute failed\n"); grid = -1; return; }
        if (hipOccupancyMaxActiveBlocksPerMultiprocessor(&per_cu, (const void*)k_mega, NTHREADS, LDS_BYTES) != hipSuccess || per_cu < 1) fprintf(stderr, "kernel_launch: occupancy query reports %d workgroups per CU\n", per_cu);
        (void)hipGetLastError();
        grid = cus;
    }
    if (grid < 0) return;
    (void)hipMemsetAsync((char*)d_ws + WS_CTL, 0, CTL_BYTES, stream);
    Params p{};
    const float** pp = (const float**)&p;
    for (int i = 0; i < 21; ++i) pp[i] = (const float*)d_in[i];
    p.out = (float*)d_out; p.ws = (unsigned char*)d_ws; p.layer = 0; p.pad = 0;
    hipLaunchKernelGGL(k_mega, dim3(grid), dim3(NTHREADS), LDS_BYTES, stream, p);
}
```

```cpp
#include <hip/hip_runtime.h>
#include <cstdio>
#include <cstdint>
namespace pg8 {
#define PG8_LAS __attribute__((address_space(3)))
typedef unsigned short bf16_t;
typedef short bf16x8 __attribute__((ext_vector_type(8)));
typedef float f32x4 __attribute__((ext_vector_type(4)));
typedef unsigned u32x4 __attribute__((ext_vector_type(4)));
constexpr int BM = 256, BK = 64, HALF = 128, HTB = HALF * BK * 2  , STAGE_BYTES = 8 * HTB, NXCD = 8, WGM = 8;

__host__ __device__ __forceinline__ int lds_byte(int r, int c) { const int st = (r >> 4) * 2 + (c >> 5), rr = r & 15, cc = c & 31, ob = rr * 64 + cc * 2; return st * 1024 + (ob ^ (((ob >> 9) & 1) << 5)); }
__host__ __device__ __forceinline__ void stage_rc(int b, int& R, int& C) { const int st = b / 1024, sb = b % 1024, swz = sb ^ (((sb >> 9) & 1) << 5); R = (st >> 1) * 16 + swz / 64; C = (st & 1) * 32 + (swz % 64) / 2; }
__host__ __device__ __forceinline__ int perm32(int rho) { const int n = rho >> 4, i = rho & 15; return 8 * (i >> 2) + 4 * n + (i & 3); }

struct Unit { int pm, pn; };
struct Gemm { const bf16_t* A; const bf16_t* Bt; int M, N, K; };

struct StaticOrder {
    int nM, nN, nwg, G, c;
    __host__ __device__ void init(int M, int N, int G_, int c_) { nM = M / BM; nN = N / BM; nwg = nM * nN; G = G_; c = c_; }
    __host__ __device__ bool next(int i, Unit& u) const {
        const long L = (long)i * G + c; if (L >= nwg) return false;
        int wgid = (int)L; { const int q = nwg / NXCD, r = nwg % NXCD, xcd = wgid % NXCD, off = wgid / NXCD; wgid = (xcd < r ? xcd * (q + 1) : r * (q + 1) + (xcd - r) * q) + off; }
        const int nig = WGM * nN, gid = wgid / nig, fm = gid * WGM, gsz = (nM - fm) < WGM ? (nM - fm) : WGM;
        u.pm = fm + ((wgid % nig) % gsz); u.pn = (wgid % nig) / gsz; return true;
    }
    __device__ __forceinline__ void a_ready(const Unit&) const {}
    __device__ __forceinline__ void done(const Unit&) const {}
};
__device__ __forceinline__ unsigned cvt_pk_bf16(float lo, float hi) { unsigned r; asm volatile("v_cvt_pk_bf16_f32 %0, %1, %2" : "=v"(r) : "v"(lo), "v"(hi)); return r; }
template <class Epi, class Sched, bool ALIGN_EPI = false, bool SP2 = false>
__device__ __forceinline__ void gemm_phase(PG8_LAS unsigned char* lds, const Gemm g, const Sched& S, const Epi& E) {
    int tid_ = threadIdx.x; asm volatile("" : "+v"(tid_));
    const int tid = tid_, wid = __builtin_amdgcn_readfirstlane(tid >> 6), lane = tid & 63, wr = wid >> 2, wc = wid & 3, fr = lane & 15, fq = lane >> 4;
    const int K = g.K, nt = K / BK;
    unsigned voffA[2], voffB[2];
#pragma unroll
    for (int i = 0; i < 2; ++i) { int R, C; stage_rc(tid * 16 + i * 8192, R, C); const int Rb = Epi::PERM ? ((R & ~31) + perm32(R & 31)) : R;
        voffA[i] = (unsigned)(R * K + C) * 2u; voffB[i] = (unsigned)(Rb * K + C) * 2u; }
    const size_t kstep = (size_t)(BK * 2);
    const size_t hstep = (size_t)HALF * K * 2;
    const size_t tstep = 2 * hstep;
    const unsigned ldsw = (unsigned)wid * 1024u;
    const int aoff = lds_byte(wr * 64 + fr, fq * 8), boff = lds_byte(wc * 32 + fr, fq * 8);
#define PG8_SA(b, h) (((b) * 2 + (h)) * HTB)
#define PG8_SB(b, h) ((4 + (b) * 2 + (h)) * HTB)
#define PG8_STAGE(bufoff, gbase, voff) do { _Pragma("unroll") for (int _i = 0; _i < 2; ++_i) \
        __builtin_amdgcn_global_load_lds((const unsigned*)((const char*)(gbase) + (voff)[_i]), (PG8_LAS unsigned*)(lds + (bufoff) + ldsw + _i * 8192), 16, 0, 0); } while (0)
#define PG8_LDA(dst, b, h) do { _Pragma("unroll") for (int m = 0; m < 4; ++m) _Pragma("unroll") for (int k = 0; k < 2; ++k) dst[m][k] = *(const PG8_LAS bf16x8*)(lds + PG8_SA(b, h) + aoff + m * 2048 + k * 1024); } while (0)
#define PG8_LDB(dst, b, h) do { _Pragma("unroll") for (int n = 0; n < 2; ++n) _Pragma("unroll") for (int k = 0; k < 2; ++k) dst[n][k] = *(const PG8_LAS bf16x8*)(lds + PG8_SB(b, h) + boff + n * 2048 + k * 1024); } while (0)
#define PG8_MMA(ai, bj, At, Bt) do { __builtin_amdgcn_s_setprio(1); _Pragma("unroll") for (int m = 0; m < 4; ++m) _Pragma("unroll") for (int n = 0; n < 2; ++n) _Pragma("unroll") for (int k = 0; k < 2; ++k) \
        acc[ai][bj][m][n] = __builtin_amdgcn_mfma_f32_16x16x32_bf16(Bt[n][k], At[m][k], acc[ai][bj][m][n], 0, 0, 0); __builtin_amdgcn_s_setprio(0); } while (0)
#define PG8_WAIT_V(n) asm volatile("s_waitcnt vmcnt(" #n ")" ::: "memory")
#define PG8_WAIT_L(n) asm volatile("s_waitcnt lgkmcnt(" #n ")" ::: "memory")
#define PG8_BAR __builtin_amdgcn_s_barrier()
#define PG8_SCHED __builtin_amdgcn_sched_barrier(0)
    Unit cur, nxt; int ui = 0;
    if (!S.next(0, cur)) return;
    f32x4 acc[2][2][4][2];
#pragma unroll
    for (int a = 0; a < 2; ++a)
#pragma unroll
        for (int b = 0; b < 2; ++b)
#pragma unroll
            for (int m = 0; m < 4; ++m)
#pragma unroll
                for (int n = 0; n < 2; ++n) acc[a][b][m][n] = (f32x4){0.f, 0.f, 0.f, 0.f};
    bf16x8 At[4][2], B0[2][2], B1[2][2];
    const char* cA = (const char*)g.A + (size_t)cur.pm * tstep; const char* cB = (const char*)g.Bt + (size_t)cur.pn * tstep;
    S.a_ready(cur);
    if constexpr (SP2) {
        PG8_STAGE(PG8_SB(0, 0), cB, voffB); PG8_STAGE(PG8_SB(0, 1), cB + hstep, voffB); PG8_STAGE(PG8_SA(0, 0), cA, voffA); PG8_STAGE(PG8_SA(0, 1), cA + hstep, voffA);
        if (wr == 1) PG8_BAR;
        PG8_WAIT_V(2); PG8_BAR;
        PG8_STAGE(PG8_SB(1, 0), cB + kstep, voffB); PG8_STAGE(PG8_SA(1, 0), cA + kstep, voffA); PG8_STAGE(PG8_SB(1, 1), cB + hstep + kstep, voffB);
        PG8_WAIT_V(6); PG8_BAR;
    } else {
        PG8_STAGE(PG8_SB(0, 0), cB, voffB); PG8_STAGE(PG8_SA(0, 0), cA, voffA); PG8_STAGE(PG8_SB(0, 1), cB + hstep, voffB); PG8_STAGE(PG8_SA(0, 1), cA + hstep, voffA);
        if (wr == 1) PG8_BAR;
        PG8_WAIT_V(4); PG8_BAR;
        PG8_STAGE(PG8_SB(1, 0), cB + kstep, voffB); PG8_STAGE(PG8_SA(1, 0), cA + kstep, voffA); PG8_STAGE(PG8_SB(1, 1), cB + hstep + kstep, voffB);
        PG8_WAIT_V(6); PG8_BAR;
    }
    for (;;) {
        const bool has_next = S.next(ui + 1, nxt);
        const char* nA = has_next ? (const char*)g.A + (size_t)nxt.pm * tstep : cA; const char* nB = has_next ? (const char*)g.Bt + (size_t)nxt.pn * tstep : cB;
        for (int t = 0; t < nt; t += 2) {
            const bool last = (t == nt - 2);
            const char* a1 = cA + (size_t)(t + 1) * kstep;
            const char* a2 = last ? nA : cA + (size_t)(t + 2) * kstep; const char* b2 = last ? nB : cB + (size_t)(t + 2) * kstep;
            const char* a3 = a2 + kstep; const char* b3 = b2 + kstep;
            if (last && has_next) S.a_ready(nxt);
            if constexpr (SP2) {
            PG8_LDB(B0, 0, 0); PG8_LDB(B1, 0, 1); PG8_SCHED; PG8_LDA(At, 0, 0); PG8_STAGE(PG8_SA(1, 1), a1 + hstep, voffA);
            PG8_WAIT_V(8); PG8_WAIT_L(0); PG8_BAR; PG8_MMA(0, 0, At, B0); PG8_MMA(0, 1, At, B1); PG8_BAR; PG8_SCHED;
            PG8_LDA(At, 0, 1); PG8_STAGE(PG8_SB(0, 0), b2, voffB); PG8_STAGE(PG8_SB(0, 1), b2 + hstep, voffB); PG8_STAGE(PG8_SA(0, 0), a2, voffA);
            PG8_WAIT_V(8); PG8_WAIT_L(0); PG8_BAR; PG8_MMA(1, 0, At, B0); PG8_MMA(1, 1, At, B1); PG8_BAR; PG8_SCHED;
            PG8_LDB(B0, 1, 0); PG8_LDB(B1, 1, 1); PG8_SCHED; PG8_LDA(At, 1, 0); PG8_STAGE(PG8_SA(0, 1), a2 + hstep, voffA);
            PG8_WAIT_V(8); PG8_WAIT_L(0); PG8_BAR; PG8_MMA(0, 0, At, B0); PG8_MMA(0, 1, At, B1); PG8_BAR; PG8_SCHED;
            PG8_LDA(At, 1, 1); PG8_STAGE(PG8_SB(1, 0), b3, voffB); PG8_STAGE(PG8_SB(1, 1), b3 + hstep, voffB); PG8_STAGE(PG8_SA(1, 0), a3, voffA);
            PG8_WAIT_V(8); PG8_WAIT_L(0); PG8_BAR; PG8_MMA(1, 0, At, B0); PG8_MMA(1, 1, At, B1); PG8_BAR; PG8_SCHED;
            } else {
            PG8_LDB(B0, 0, 0); PG8_SCHED; PG8_LDA(At, 0, 0); PG8_STAGE(PG8_SA(1, 1), a1 + hstep, voffA);
            PG8_WAIT_L(8); PG8_BAR; PG8_WAIT_L(0); PG8_MMA(0, 0, At, B0); PG8_BAR; PG8_SCHED;
            PG8_LDB(B1, 0, 1); PG8_STAGE(PG8_SB(0, 0), b2, voffB);
            PG8_BAR; PG8_WAIT_L(0); PG8_MMA(0, 1, At, B1); PG8_BAR;
            PG8_LDA(At, 0, 1); PG8_STAGE(PG8_SA(0, 0), a2, voffA);
            PG8_BAR; PG8_WAIT_L(0); PG8_MMA(1, 0, At, B0); PG8_BAR; PG8_SCHED;
            PG8_STAGE(PG8_SB(0, 1), b2 + hstep, voffB);
            PG8_WAIT_V(6); PG8_BAR; PG8_MMA(1, 1, At, B1); PG8_BAR;
            PG8_LDB(B0, 1, 0); PG8_SCHED; PG8_LDA(At, 1, 0); PG8_STAGE(PG8_SA(0, 1), a2 + hstep, voffA);
            PG8_WAIT_L(8); PG8_BAR; PG8_WAIT_L(0); PG8_MMA(0, 0, At, B0); PG8_BAR; PG8_SCHED;
            PG8_LDB(B1, 1, 1); PG8_STAGE(PG8_SB(1, 0), b3, voffB);
            PG8_BAR; PG8_WAIT_L(0); PG8_MMA(0, 1, At, B1); PG8_BAR;
            PG8_LDA(At, 1, 1); PG8_STAGE(PG8_SA(1, 0), a3, voffA);
            PG8_BAR; PG8_WAIT_L(0); PG8_MMA(1, 0, At, B0); PG8_BAR; PG8_SCHED;
            PG8_STAGE(PG8_SB(1, 1), b3 + hstep, voffB);
            PG8_WAIT_V(6); PG8_BAR; PG8_MMA(1, 1, At, B1); PG8_BAR;
            }
        }
        if constexpr (ALIGN_EPI) { if (wr == 0) PG8_BAR; }
        if constexpr (!Epi::AFTER_DRAIN) { E(acc, cur, wr, wc, fr, fq); S.done(cur); }
        if (!has_next) break;
#pragma unroll
        for (int a = 0; a < 2; ++a)
#pragma unroll
            for (int b = 0; b < 2; ++b)
#pragma unroll
                for (int m = 0; m < 4; ++m)
#pragma unroll
                    for (int n = 0; n < 2; ++n) acc[a][b][m][n] = (f32x4){0.f, 0.f, 0.f, 0.f};
        cur = nxt; cA = nA; cB = nB; ++ui;
        if constexpr (ALIGN_EPI) { if (wr == 1) PG8_BAR; }
    }
    PG8_WAIT_V(0);
    if constexpr (!ALIGN_EPI) { if (wr == 0) PG8_BAR; }
    PG8_BAR;
    if constexpr (Epi::AFTER_DRAIN) { E.fused(acc, cur, wr, wc, fr, fq, lds, wid, lane); S.done(cur); }
#undef PG8_SA
#undef PG8_SB
#undef PG8_STAGE
#undef PG8_LDA
#undef PG8_LDB
#undef PG8_MMA
#undef PG8_WAIT_V
#undef PG8_WAIT_L
#undef PG8_BAR
#undef PG8_SCHED
}
}
#define GAS __attribute__((address_space(1)))
#define LAS __attribute__((address_space(3)))
typedef unsigned short bf16;
typedef unsigned v4u __attribute__((ext_vector_type(4)));
typedef float f32x4 __attribute__((ext_vector_type(4)));
typedef short bf16x8 __attribute__((ext_vector_type(8)));
typedef GAS unsigned gu32;
typedef GAS unsigned long long gu64;
#define RLX_AGENT __ATOMIC_RELAXED, __HIP_MEMORY_SCOPE_AGENT
#define LDS_WAIT() asm volatile("s_waitcnt lgkmcnt(0)" ::: "memory")
#define VM_WAIT() asm volatile("s_waitcnt vmcnt(0)" ::: "memory")
__device__ __forceinline__ unsigned long long rt() { return __builtin_amdgcn_s_memrealtime(); }
__device__ __forceinline__ unsigned f2bf(float f) { unsigned u = __builtin_bit_cast(unsigned, f); return (u + 0x7fffu + ((u >> 16) & 1u)) >> 16; }
__device__ __forceinline__ unsigned pk2(float lo, float hi) { return f2bf(lo) | (f2bf(hi) << 16); }

#define XB_TMO      128
#define XB_XCNT(j)  (256  + 64 * (j))
#define XB_XSUB(j)  (1280 + 64 * (j))
#define XB_XGEN(j)  (2304 + 64 * (j))
#define XB_TOP      3328
#define XB_TOPGEN   3392
#define XCD_BAR_WORDS 3456
#define XB_SPIN_CAP (1u << 18)

__device__ __forceinline__ unsigned xb_ld(unsigned* p)              { return __hip_atomic_load(p, __ATOMIC_RELAXED, __HIP_MEMORY_SCOPE_AGENT); }
__device__ __forceinline__ unsigned xb_add(unsigned* p, unsigned v) { return __hip_atomic_fetch_add(p, v, __ATOMIC_RELAXED, __HIP_MEMORY_SCOPE_AGENT); }
__device__ __forceinline__ unsigned xb_xcc_id() { return (unsigned)__builtin_amdgcn_s_getreg((3 << 11) | 20) & 0xFu; }
#define XB_SPIN(cond, bar) do { unsigned _sp = 0; while (cond) { __builtin_amdgcn_s_sleep(1); \
    if ((++_sp & 255u) == 0u) { if (xb_ld(&(bar)[XB_TMO])) break; if (_sp > XB_SPIN_CAP) { atomicAdd(&(bar)[XB_TMO], 1u); break; } } } } while (0)

struct XcdBarrier {
    unsigned* bar; unsigned x;
    volatile LAS unsigned* st;
};

__device__ __forceinline__ XcdBarrier xcd_barrier_post(unsigned* bar, volatile LAS unsigned* st) {
    XcdBarrier b; b.bar = bar; b.x = xb_xcc_id(); b.st = st;
    if (threadIdx.x == 0) (void)xb_add(&bar[XB_XCNT(b.x)], 1u);
    return b;
}
__device__ __forceinline__ void xcd_barrier_complete(unsigned* bar, unsigned x, unsigned& nloc, unsigned& nx) {
    const unsigned G = gridDim.x * gridDim.y * gridDim.z;
    unsigned sum, cnt, mine, sp = 0u;
    for (;;) {
        sum = 0u; cnt = 0u; mine = 0u;
#pragma unroll
        for (unsigned j = 0; j < 16; ++j) { const unsigned c = xb_ld(&bar[XB_XCNT(j)]); sum += c; cnt += (c > 0u) ? 1u : 0u; mine = (j == x) ? c : mine; }
        if (sum == G) break;
        __builtin_amdgcn_s_sleep(1);
        if ((++sp & 255u) == 0u) { if (xb_ld(&bar[XB_TMO])) break; if (sp > XB_SPIN_CAP) { atomicAdd(&bar[XB_TMO], 1u); break; } }
    }
    nloc = mine > 0u ? mine : 1u; nx = cnt > 0u ? cnt : 1u;
}

__device__ __forceinline__ void xcd_barrier(const XcdBarrier& b) {
    asm volatile("s_waitcnt vmcnt(0)" ::: "memory");
    __syncthreads();
    if (threadIdx.x == 0) {
        unsigned* bar = b.bar;
        __builtin_amdgcn_s_waitcnt(0);
        unsigned nloc = b.st[0], nx = b.st[1];
        if (nloc == 0u) { xcd_barrier_complete(bar, b.x, nloc, nx); b.st[0] = nloc; b.st[1] = nx; }
        const unsigned old = xb_add(&bar[XB_XSUB(b.x)], 1u);
        const unsigned gen = old / nloc;
        if (old + 1u == (gen + 1u) * nloc) {
            __builtin_amdgcn_fence(__ATOMIC_RELEASE, "agent");
            asm volatile("s_waitcnt vmcnt(0)" ::: "memory");
            const unsigned og = xb_add(&bar[XB_TOP], 1u);
            const unsigned tg = og / nx;
            if (og + 1u == (tg + 1u) * nx) xb_add(&bar[XB_TOPGEN], 1u);
            else XB_SPIN(xb_ld(&bar[XB_TOPGEN]) == tg, bar);
            __builtin_amdgcn_fence(__ATOMIC_ACQUIRE, "agent");
            xb_add(&bar[XB_XGEN(b.x)], 1u);
            asm volatile("s_waitcnt vmcnt(0)" ::: "memory");
        } else {
            XB_SPIN(xb_ld(&bar[XB_XGEN(b.x)]) == gen, bar);
            __builtin_amdgcn_fence(__ATOMIC_ACQUIRE, "agent");
            asm volatile("s_waitcnt vmcnt(0)" ::: "memory");
        }
    }
    __syncthreads();
}

constexpr int DM = 2048, NBATCH = 2, SEQ = 4096, DEPTH = 4, CTXL = 256;
constexpr int NH = 4, HK = 256, HV = 512, RANK = 16;
constexpr int DPOOL = 1024, DFF = 5632, NMODV = 6 * DM;
constexpr int MLAT = NBATCH * SEQ, MCTX = NBATCH * CTXL, MTOT = MLAT + MCTX;
constexpr int NPROJ = 11520, NPROJ_SRC = 11296, NFFI = 2 * DFF;
constexpr int CQ = 0, CK = 1024, CV = 2048, CG = 4096, CP = 6144, CBG = 7168, CBP = 9216, CA = 11264;
constexpr float ALPHA = 1.6817928305074290f;
constexpr float LN_EPS = 1e-5f, RMS_EPS = 1e-6f;
constexpr int NWAVES = 8, NTHREADS = 512;
constexpr int LDS_BYTES = 163840;
constexpr int RING_BYTES = 131072, MISC_OFF = LDS_BYTES - 256;

constexpr size_t al256(size_t x) { return (x + 255) & ~(size_t)255; }
constexpr size_t WS_CTL = 0, CTL_BYTES = 1u << 20;
constexpr size_t SZ_MODP = (size_t)DEPTH * 8 * 3 * NMODV * 4, SZ_MOD = (size_t)DEPTH * 3 * NMODV * 4;
constexpr size_t WS_MODP = WS_CTL + CTL_BYTES, WS_MOD = al256(WS_MODP + SZ_MODP), WS_W = al256(WS_MOD + SZ_MOD);
constexpr size_t WO_IN = 0, SZ_IN = (size_t)NPROJ * DM * 2;
constexpr size_t WO_GO = WO_IN + SZ_IN, SZ_GO = (size_t)DM * DM * 2;
constexpr size_t WO_PG = WO_GO + SZ_GO, SZ_PG = (size_t)1024 * 1024 * 2;
constexpr size_t WO_PO = WO_PG + SZ_PG, SZ_PO = (size_t)DM * 1024 * 2;
constexpr size_t WO_OUT = WO_PO + SZ_PO, SZ_OUT = (size_t)DM * DM * 2;
constexpr size_t WO_FI = WO_OUT + SZ_OUT, SZ_FI = (size_t)NFFI * DM * 2;
constexpr size_t WO_FO = WO_FI + SZ_FI, SZ_FO = (size_t)DM * DFF * 2;
constexpr size_t WO_PC = WO_FO + SZ_FO;
constexpr size_t W_LAYER = WO_PC + SZ_PO;
constexpr size_t WS_X = al256(WS_W + DEPTH * W_LAYER), SZ_X = (size_t)MTOT * DM * 4;
constexpr size_t WS_V = WS_X + SZ_X;
constexpr size_t WS_H = WS_V + SZ_X, SZ_H = (size_t)MTOT * DM * 2;
constexpr size_t WS_PROJ = WS_H + SZ_H, SZ_PROJ = (size_t)MTOT * NPROJ * 2;
constexpr size_t WS_ACT = WS_PROJ;
constexpr int NCG = MTOT / 64;
constexpr size_t WS_LA = WS_PROJ + SZ_PROJ, SZ_LA = (size_t)2 * MTOT * 1024 * 4;
constexpr size_t WS_QI = WS_LA, SZ_QI = (size_t)2 * MTOT * 1024 * 2;
constexpr size_t WS_KST = WS_QI + SZ_QI, SZ_KST = (size_t)2 * NCG * 4 * 256 * 64 * 2;
constexpr size_t WS_PM = WS_KST + SZ_KST, SZ_PM = (size_t)2 * NCG * 4 * 64 * 64 * 2;
constexpr size_t WS_DCB = WS_PM + SZ_PM, SZ_DCB = (size_t)2 * NCG * 4 * 256 * 4;
constexpr size_t WS_VT = WS_DCB + SZ_DCB, SZ_VT = (size_t)NCG * 4 * 512 * 64 * 2;
constexpr size_t WS_GLAEND = WS_VT + SZ_VT;
static_assert(WS_GLAEND >= WS_LA + SZ_LA, "overlay");
constexpr size_t WS_O = WS_GLAEND, SZ_O = (size_t)MTOT * DM * 4;
constexpr size_t WS_AGLA = WS_O + 2 * SZ_O;
constexpr size_t WS_HM = WS_AGLA + SZ_H, SZ_HM = (size_t)MTOT * 1024 * 4;
constexpr size_t WS_T = WS_HM + SZ_HM, SZ_T = (size_t)MTOT * 1024 * 2;
constexpr size_t WS_U = WS_T + SZ_T;
constexpr size_t WS_TEMP = WS_U + SZ_T;
constexpr size_t WS_MRG = WS_TEMP + SZ_X;
constexpr size_t WS_END = WS_MRG + SZ_H;

struct Params {
    const float *x, *c, *ctx, *c_ctx, *w_ada, *b_ada, *w_in, *w_dup, *b_dup, *gla_gain, *w_pg, *pool_scale, *w_go, *w_po, *w_out, *ln1g, *ln1b, *w_fi, *w_fo, *ln2g, *ln2b;
    float* out; unsigned char* ws; int layer; int pad;
};
typedef float f32x2g __attribute__((ext_vector_type(2)));
typedef unsigned u32x2g __attribute__((ext_vector_type(2)));
struct Frame { LAS unsigned char* lds; int tid, lane, wave, vcu, G, gw, NGW; };

__device__ __forceinline__ bf16* wlayer(const Params& p, int l, size_t off) { return (bf16*)(p.ws + WS_W + (size_t)l * W_LAYER + off); }
__device__ __forceinline__ const float* modv(const Params& p, int l, int mi, int which) { return (const float*)(p.ws + WS_MOD) + ((size_t)l * 3 + mi) * NMODV + (size_t)which * DM; }
__device__ __forceinline__ float bf2f(unsigned short b) { return __builtin_bit_cast(float, (unsigned)b << 16); }
__device__ __forceinline__ float bflo(unsigned w) { return __builtin_bit_cast(float, w << 16); }
__device__ __forceinline__ float bfhi(unsigned w) { return __builtin_bit_cast(float, w & 0xffff0000u); }
__device__ __forceinline__ float fast_sigmoid(float x) { return __builtin_amdgcn_rcpf(1.0f + __expf(-x)); }
__device__ __forceinline__ float wave_sum(float v) {
#pragma unroll
    for (int o = 1; o < 64; o <<= 1) v += __shfl_xor(v, o);
    return v;
}
__device__ __forceinline__ int mod_index(int row) { return row < SEQ ? 0 : (row < MLAT ? 1 : 2); }

struct EpiProj {
    static constexpr bool PERM = true, AFTER_DRAIN = false;
    bf16* O;
    __device__ __forceinline__ void operator()(const pg8::f32x4 (&acc)[2][2][4][2], const pg8::Unit& u, int wr, int wc, int fr, int fq) const {
        const int row0 = u.pm * 256 + wr * 64 + fr, col0 = u.pn * 256 + wc * 32 + 8 * fq;
        const int mode = (u.pn >= 16 && u.pn < 24) ? 1 : ((u.pn >= 28 && u.pn < 44) ? 2 : 0);
#pragma unroll
        for (int ai = 0; ai < 2; ++ai)
#pragma unroll
            for (int m = 0; m < 4; ++m) { bf16* rowp = O + (size_t)(row0 + ai * 128 + m * 16) * NPROJ + col0;
#pragma unroll
                for (int bj = 0; bj < 2; ++bj) { pg8::f32x4 v0 = acc[ai][bj][m][0], v1 = acc[ai][bj][m][1];
                    if (mode != 0) {
#pragma unroll
                        for (int j = 0; j < 4; ++j) { const float s0 = fast_sigmoid(v0[j]), s1 = fast_sigmoid(v1[j]); v0[j] = (mode == 1) ? v0[j] * s0 : s0; v1[j] = (mode == 1) ? v1[j] * s1 : s1; } }
                    pg8::u32x4 w; w.x = pg8::cvt_pk_bf16(v0[0], v0[1]); w.y = pg8::cvt_pk_bf16(v0[2], v0[3]); w.z = pg8::cvt_pk_bf16(v1[0], v1[1]); w.w = pg8::cvt_pk_bf16(v1[2], v1[3]);
                    *(pg8::u32x4*)(rowp + bj * 128) = w; } }
    }
};
struct EpiBf16Plain {
    static constexpr bool PERM = true, AFTER_DRAIN = false;
    bf16* O; int ldc;
    __device__ __forceinline__ void operator()(const pg8::f32x4 (&acc)[2][2][4][2], const pg8::Unit& u, int wr, int wc, int fr, int fq) const {
        const int row0 = u.pm * 256 + wr * 64 + fr, col0 = u.pn * 256 + wc * 32 + 8 * fq;
#pragma unroll
        for (int ai = 0; ai < 2; ++ai)
#pragma unroll
            for (int m = 0; m < 4; ++m) { bf16* rowp = O + (size_t)(row0 + ai * 128 + m * 16) * ldc + col0;
#pragma unroll
                for (int bj = 0; bj < 2; ++bj) { const pg8::f32x4 v0 = acc[ai][bj][m][0], v1 = acc[ai][bj][m][1];
                    pg8::u32x4 w; w.x = pg8::cvt_pk_bf16(v0[0], v0[1]); w.y = pg8::cvt_pk_bf16(v0[2], v0[3]); w.z = pg8::cvt_pk_bf16(v1[0], v1[1]); w.w = pg8::cvt_pk_bf16(v1[2], v1[3]);
                    *(pg8::u32x4*)(rowp + bj * 128) = w; } }
    }
};
struct EpiGateTemp {
    static constexpr bool PERM = true, AFTER_DRAIN = false;
    float* T; const bf16* PROJ;
    __device__ __forceinline__ void operator()(const pg8::f32x4 (&acc)[2][2][4][2], const pg8::Unit& u, int wr, int wc, int fr, int fq) const {
        const int row0 = u.pm * 256 + wr * 64 + fr, col0 = u.pn * 256 + wc * 32 + 8 * fq;
#pragma unroll
        for (int ai = 0; ai < 2; ++ai)
#pragma unroll
            for (int m = 0; m < 4; ++m) { const int row = row0 + ai * 128 + m * 16;
#pragma unroll
                for (int bj = 0; bj < 2; ++bj) { const int c = col0 + bj * 128;
                    const pg8::u32x4 gw = *(const pg8::u32x4*)(PROJ + (size_t)row * NPROJ + CBP + c);
                    pg8::f32x4 v0 = acc[ai][bj][m][0], v1 = acc[ai][bj][m][1];
                    v0[0] *= bflo(gw.x); v0[1] *= bfhi(gw.x); v0[2] *= bflo(gw.y); v0[3] *= bfhi(gw.y);
                    v1[0] *= bflo(gw.z); v1[1] *= bfhi(gw.z); v1[2] *= bflo(gw.w); v1[3] *= bfhi(gw.w);
                    float* tp = T + (size_t)row * DM + c; *(pg8::f32x4*)tp = v0; *(pg8::f32x4*)(tp + 4) = v1; } }
    }
    __device__ __forceinline__ void small(int row, int col, pg8::f32x4 v) const {
        const u32x2g gw = *(const u32x2g*)(PROJ + (size_t)row * NPROJ + CBP + col);
        v[0] *= bflo(gw.x); v[1] *= bfhi(gw.x); v[2] *= bflo(gw.y); v[3] *= bfhi(gw.y); *(pg8::f32x4*)(T + (size_t)row * DM + col) = v; }
};
struct EpiMerge {
    static constexpr bool PERM = true, AFTER_DRAIN = false;
    bf16* O; const float* T; const bf16* PROJ;
    __device__ __forceinline__ void operator()(const pg8::f32x4 (&acc)[2][2][4][2], const pg8::Unit& u, int wr, int wc, int fr, int fq) const {
        const int row0 = u.pm * 256 + wr * 64 + fr, col0 = u.pn * 256 + wc * 32 + 8 * fq;
#pragma unroll
        for (int ai = 0; ai < 2; ++ai)
#pragma unroll
            for (int m = 0; m < 4; ++m) { const int row = row0 + ai * 128 + m * 16;
#pragma unroll
                for (int bj = 0; bj < 2; ++bj) { const int c = col0 + bj * 128;
                    const pg8::u32x4 gw = *(const pg8::u32x4*)(PROJ + (size_t)row * NPROJ + CBG + c);
                    const float* tp = T + (size_t)row * DM + c; const pg8::f32x4 t0 = *(const pg8::f32x4*)tp, t1 = *(const pg8::f32x4*)(tp + 4);
                    pg8::f32x4 v0 = acc[ai][bj][m][0], v1 = acc[ai][bj][m][1];
                    v0[0] = v0[0] * bflo(gw.x) + t0[0]; v0[1] = v0[1] * bfhi(gw.x) + t0[1]; v0[2] = v0[2] * bflo(gw.y) + t0[2]; v0[3] = v0[3] * bfhi(gw.y) + t0[3];
                    v1[0] = v1[0] * bflo(gw.z) + t1[0]; v1[1] = v1[1] * bfhi(gw.z) + t1[1]; v1[2] = v1[2] * bflo(gw.w) + t1[2]; v1[3] = v1[3] * bfhi(gw.w) + t1[3];
                    pg8::u32x4 w; w.x = pg8::cvt_pk_bf16(v0[0], v0[1]); w.y = pg8::cvt_pk_bf16(v0[2], v0[3]); w.z = pg8::cvt_pk_bf16(v1[0], v1[1]); w.w = pg8::cvt_pk_bf16(v1[2], v1[3]);
                    *(pg8::u32x4*)(O + (size_t)row * DM + c) = w; } }
    }
    __device__ __forceinline__ void small(int row, int col, pg8::f32x4 v) const {
        const u32x2g gw = *(const u32x2g*)(PROJ + (size_t)row * NPROJ + CBG + col); const pg8::f32x4 t = *(const pg8::f32x4*)(T + (size_t)row * DM + col);
        v[0] = v[0] * bflo(gw.x) + t[0]; v[1] = v[1] * bfhi(gw.x) + t[1]; v[2] = v[2] * bflo(gw.y) + t[2]; v[3] = v[3] * bfhi(gw.y) + t[3];
        *(u32x2g*)(O + (size_t)row * DM + col) = (u32x2g){pg8::cvt_pk_bf16(v[0], v[1]), pg8::cvt_pk_bf16(v[2], v[3])}; }
};
struct EpiResid {
    static constexpr bool PERM = false, AFTER_DRAIN = false;
    float* V; const float* xlat; const float* xctx; const float* gt0;
    __device__ __forceinline__ void operator()(const pg8::f32x4 (&acc)[2][2][4][2], const pg8::Unit& u, int wr, int wc, int fr, int fq) const {
        const int row0 = u.pm * 256 + wr * 64 + fr, col0 = u.pn * 256 + wc * 32 + 4 * fq;
        const int mi = u.pm < 16 ? 0 : (u.pm < 32 ? 1 : 2);
        const float* gt = gt0 + (size_t)mi * NMODV + col0;
        pg8::f32x4 gv[2][2];
#pragma unroll
        for (int bj = 0; bj < 2; ++bj)
#pragma unroll
            for (int n = 0; n < 2; ++n) gv[bj][n] = *(const pg8::f32x4*)(gt + bj * 128 + n * 16);
#pragma unroll
        for (int ai = 0; ai < 2; ++ai)
#pragma unroll
            for (int m = 0; m < 4; ++m) { const int row = row0 + ai * 128 + m * 16;
                const float* xr = (u.pm < 32 ? xlat + (size_t)row * DM : xctx + (size_t)(row - MLAT) * DM) + col0; float* vr = V + (size_t)row * DM + col0;
#pragma unroll
                for (int bj = 0; bj < 2; ++bj)
#pragma unroll
                    for (int n = 0; n < 2; ++n) { const pg8::f32x4 xv = *(const pg8::f32x4*)(xr + bj * 128 + n * 16);
                        *(pg8::f32x4*)(vr + bj * 128 + n * 16) = xv * ALPHA + gv[bj][n] * acc[ai][bj][m][n]; } }
    }
    __device__ __forceinline__ void small(int row, int col, pg8::f32x4 v) const {
        const pg8::f32x4 g = *(const pg8::f32x4*)(gt0 + (size_t)2 * NMODV + col), xv = *(const pg8::f32x4*)(xctx + (size_t)(row - MLAT) * DM + col);
        *(pg8::f32x4*)(V + (size_t)row * DM + col) = xv * ALPHA + g * v; }
};
struct EpiSwiglu {
    static constexpr bool PERM = true, AFTER_DRAIN = false;
    bf16* O;
    __device__ __forceinline__ void operator()(const pg8::f32x4 (&acc)[2][2][4][2], const pg8::Unit& u, int wr, int wc, int fr, int fq) const {
        const int row0 = u.pm * 256 + wr * 64 + fr, col0 = u.pn * 128 + wc * 32 + 8 * fq;
#pragma unroll
        for (int ai = 0; ai < 2; ++ai)
#pragma unroll
            for (int m = 0; m < 4; ++m) { const int row = row0 + ai * 128 + m * 16;
                pg8::f32x4 a0, a1;
#pragma unroll
                for (int j = 0; j < 4; ++j) { const float g0 = acc[ai][0][m][0][j], g1 = acc[ai][0][m][1][j];
                    a0[j] = g0 * fast_sigmoid(g0) * acc[ai][1][m][0][j]; a1[j] = g1 * fast_sigmoid(g1) * acc[ai][1][m][1][j]; }
                pg8::u32x4 w; w.x = pg8::cvt_pk_bf16(a0[0], a0[1]); w.y = pg8::cvt_pk_bf16(a0[2], a0[3]); w.z = pg8::cvt_pk_bf16(a1[0], a1[1]); w.w = pg8::cvt_pk_bf16(a1[2], a1[3]);
                *(pg8::u32x4*)(O + (size_t)row * DFF + col0) = w; }
    }
};

template <class Epi> __device__ __forceinline__ void small_gemm_ctx(const Frame& F, const bf16* A, const bf16* Bt, int K, const Epi& E) {
    const int c = (int)blockIdx.x; if (c >= 256) return;
    const int rb = MLAT + 64 * (c >> 5), cb = 64 * (c & 31);
    const int fr = F.lane & 15, fq = F.lane >> 4, kw = K >> 3;
    f32x4 acc[4][4];
#pragma unroll
    for (int m = 0; m < 4; ++m)
#pragma unroll
        for (int n = 0; n < 4; ++n) acc[m][n] = (f32x4){0.f, 0.f, 0.f, 0.f};
    const bf16* ap = A + (size_t)(rb + fr) * K + F.wave * kw + 8 * fq; const bf16* bp = Bt + (size_t)(cb + fr) * K + F.wave * kw + 8 * fq;
#define SG_LOAD(a, b, ks) do { _Pragma("unroll") for (int m = 0; m < 4; ++m) { a[m] = *(const GAS bf16x8*)(ap + (size_t)m * 16 * K + (ks)); b[m] = *(const GAS bf16x8*)(bp + (size_t)m * 16 * K + (ks)); } } while (0)
#define SG_MMA(a, b) do { _Pragma("unroll") for (int m = 0; m < 4; ++m) _Pragma("unroll") for (int n = 0; n < 4; ++n) acc[m][n] = __builtin_amdgcn_mfma_f32_16x16x32_bf16(a[m], b[n], acc[m][n], 0, 0, 0); } while (0)
    bf16x8 ax[4], bx[4], ay[4], by[4];
    SG_LOAD(ax, bx, 0);
    for (int ks = 0; ks < kw; ks += 64) {
        SG_LOAD(ay, by, ks + 32); asm volatile("" ::: "memory");
        SG_MMA(ax, bx);
        const int kn = (ks + 64 < kw) ? ks + 64 : ks;
        SG_LOAD(ax, bx, kn); asm volatile("" ::: "memory");
        SG_MMA(ay, by);
    }
#undef SG_LOAD
#undef SG_MMA
    LAS float* part = (LAS float*)F.lds + F.wave * 4096;
#pragma unroll
    for (int m = 0; m < 4; ++m)
#pragma unroll
        for (int n = 0; n < 4; ++n)
#pragma unroll
            for (int reg = 0; reg < 4; ++reg) part[(16 * m + 4 * fq + reg) * 64 + 16 * n + fr] = acc[m][n][reg];
    __syncthreads();
#pragma unroll
    for (int q = 0; q < 2; ++q) { const int idx = F.tid * 2 + q, row = idx >> 4, col = (idx & 15) * 4; f32x4 s = {0.f, 0.f, 0.f, 0.f};
#pragma unroll
        for (int w = 0; w < 8; ++w) s += *(const LAS f32x4*)((LAS float*)F.lds + w * 4096 + row * 64 + col);
        E.small(rb + row, cb + col, s); }
    __syncthreads();
}
__device__ __forceinline__ void transpose_item(const float* W, int N, int k0, int n0, bf16* WT, int ldk, int drow0, float colscale, const float* rowscale, LAS float* scr, int lane) {
    float tv[32];
#pragma unroll
    for (int i = 0; i < 32; ++i) { const int kk = 2 * i + (lane >> 5); tv[i] = W[(size_t)(k0 + kk) * N + n0 + (lane & 31)]; }
    if (rowscale) {
#pragma unroll
        for (int i = 0; i < 32; ++i) tv[i] *= rowscale[k0 + 2 * i + (lane >> 5)]; }
#pragma unroll
    for (int i = 0; i < 32; ++i) { const int kk = 2 * i + (lane >> 5); scr[kk * 33 + (lane & 31)] = tv[i] * colscale; }
    LDS_WAIT(); asm volatile("" ::: "memory");
    const int c = lane & 7;
#pragma unroll
    for (int j = 0; j < 4; ++j) { const int n = (lane >> 3) + 8 * j; const LAS float* s = scr + (8 * c) * 33 + n;
        v4u o; o.x = pk2(s[0 * 33], s[1 * 33]); o.y = pk2(s[2 * 33], s[3 * 33]); o.z = pk2(s[4 * 33], s[5 * 33]); o.w = pk2(s[6 * 33], s[7 * 33]);
        *(GAS v4u*)(WT + (size_t)(drow0 + n) * ldk + k0 + 8 * c) = o; }
    LDS_WAIT(); asm volatile("" ::: "memory");
}
constexpr int IT_IN = 32 * (NPROJ_SRC / 32), IT_GO = 32 * 64, IT_PO = 16 * 64, IT_OUT = 32 * 64, IT_FI = 32 * (NFFI / 32), IT_FO = (DFF / 64) * 64, IT_PG = 1024, IT_ZIN = 224, IT_ZPG = 1024;
constexpr int IT_LAYER = IT_IN + IT_GO + IT_PO + IT_OUT + IT_FI + IT_FO + IT_PG + IT_ZIN + IT_ZPG;
constexpr int IT_MOD = DEPTH * 48 * 8;
__device__ __forceinline__ void phase_prologue_a(const Frame& F, const Params& p) {
    LAS float* scr = (LAS float*)(F.lds + F.wave * 16384);
    for (int it = F.gw; it < IT_MOD; it += F.NGW) {
        const int l = it / 384, r = it % 384, nb = r / 8, kb = r % 8, k0 = 256 * kb, n0 = 256 * nb + 4 * F.lane;
#pragma unroll
        for (int j = 0; j < 4; ++j) { const int k = k0 + F.lane + 64 * j;
            const float c0 = p.c[k], c1 = p.c[DM + k], c2 = p.c_ctx[k];
            scr[(F.lane + 64 * j) * 3 + 0] = c0 / (1.0f + expf(-c0)); scr[(F.lane + 64 * j) * 3 + 1] = c1 / (1.0f + expf(-c1)); scr[(F.lane + 64 * j) * 3 + 2] = c2 / (1.0f + expf(-c2)); }
        LDS_WAIT(); asm volatile("" ::: "memory");
        f32x4 a0 = {0.f, 0.f, 0.f, 0.f}, a1 = a0, a2 = a0;
        const float* wp = p.w_ada + ((size_t)l * DM + k0) * NMODV + n0;
#pragma unroll 16
        for (int kk = 0; kk < 256; ++kk) { const f32x4 w = *(const GAS f32x4*)(wp + (size_t)kk * NMODV); const float s0 = scr[kk * 3], s1 = scr[kk * 3 + 1], s2 = scr[kk * 3 + 2];
            a0 += w * s0; a1 += w * s1; a2 += w * s2; }
        float* mp = (float*)(p.ws + WS_MODP) + ((size_t)(l * 8 + kb) * 3) * NMODV + n0;
        *(GAS f32x4*)(mp) = a0; *(GAS f32x4*)(mp + NMODV) = a1; *(GAS f32x4*)(mp + 2 * NMODV) = a2;
        LDS_WAIT(); asm volatile("" ::: "memory");
    }
    for (int it = F.gw; it < DEPTH * IT_LAYER; it += F.NGW) {
        const int l = it / IT_LAYER; int r = it % IT_LAYER;
        if (r < IT_IN) { const int nblk = NPROJ_SRC / 32, kb = r / nblk, n0 = 32 * (r % nblk);
            int drow; float cs = 1.0f;
            if (n0 < 6144) { drow = n0; if (n0 < 1024) cs = 0.0625f; } else if (n0 < 6176) drow = CA + (n0 - 6144); else if (n0 < 7200) drow = CP + (n0 - 6176); else drow = CBG + (n0 - 7200);
            transpose_item(p.w_in + (size_t)l * DM * NPROJ_SRC, NPROJ_SRC, 64 * kb, n0, wlayer(p, l, WO_IN), DM, drow, cs, nullptr, scr, F.lane); continue; } r -= IT_IN;
        if (r < IT_GO) { transpose_item(p.w_go + (size_t)l * DM * DM, DM, 64 * (r / 64), 32 * (r % 64), wlayer(p, l, WO_GO), DM, 32 * (r % 64), 1.0f, nullptr, scr, F.lane); continue; } r -= IT_GO;
        if (r < IT_PO) { transpose_item(p.w_po + (size_t)l * DPOOL * DM, DM, 64 * (r / 64), 32 * (r % 64), wlayer(p, l, WO_PO), DPOOL, 32 * (r % 64), 1.0f, p.pool_scale + (size_t)l * DPOOL, scr, F.lane); continue; } r -= IT_PO;
        if (r < IT_OUT) { transpose_item(p.w_out + (size_t)l * DM * DM, DM, 64 * (r / 64), 32 * (r % 64), wlayer(p, l, WO_OUT), DM, 32 * (r % 64), 1.0f, nullptr, scr, F.lane); continue; } r -= IT_OUT;
        if (r < IT_FI) { const int nblk = NFFI / 32, kb = r / nblk, n0 = 32 * (r % nblk), up = n0 >= DFF ? 1 : 0, ch = n0 - up * DFF;
            transpose_item(p.w_fi + (size_t)l * DM * NFFI, NFFI, 64 * kb, n0, wlayer(p, l, WO_FI), DM, 256 * (ch / 128) + 128 * up + (ch % 128), 1.0f, nullptr, scr, F.lane); continue; } r -= IT_FI;
        if (r < IT_FO) { transpose_item(p.w_fo + (size_t)l * DFF * DM, DM, 64 * (r / 64), 32 * (r % 64), wlayer(p, l, WO_FO), DFF, 32 * (r % 64), 1.0f, nullptr, scr, F.lane); continue; } r -= IT_FO;
        if (r < IT_PG) { const int g = r >> 8, i = r & 255;
            const f32x4 v = *(const GAS f32x4*)(p.w_pg + (((size_t)l * 4 + g) * 256 + i) * 256 + 4 * F.lane);
            *(GAS u32x2g*)(wlayer(p, l, WO_PG) + (size_t)(256 * g + i) * 1024 + 256 * g + 4 * F.lane) = (u32x2g){pk2(v.x, v.y), pk2(v.z, v.w)}; continue; } r -= IT_PG;
        if (r < IT_ZIN) { GAS v4u* zp = (GAS v4u*)(wlayer(p, l, WO_IN) + (size_t)(NPROJ_SRC + r) * DM);
#pragma unroll
            for (int j = 0; j < 4; ++j) zp[F.lane + 64 * j] = (v4u){0u, 0u, 0u, 0u};
            continue; } r -= IT_ZIN;
        { GAS v4u* zp = (GAS v4u*)(wlayer(p, l, WO_PG) + (size_t)r * 1024); const int g = r >> 8;
#pragma unroll
          for (int j = 0; j < 2; ++j) { const int ch = F.lane + 64 * j; if ((ch >> 5) != g) zp[ch] = (v4u){0u, 0u, 0u, 0u}; } }
    }
}
__device__ __forceinline__ void phase_prologue_b(const Frame& F, const Params& p) {
    const float* MP = (const float*)(p.ws + WS_MODP); float* MO = (float*)(p.ws + WS_MOD);
    for (int e = F.vcu * NTHREADS + F.tid; e < DEPTH * 3 * NMODV; e += F.G * NTHREADS) { const int l = e / (3 * NMODV), r = e % (3 * NMODV), n = r % NMODV;
        float s = p.b_ada[(size_t)l * NMODV + n];
#pragma unroll
        for (int kb = 0; kb < 8; ++kb) s += MP[((size_t)(l * 8 + kb) * 3) * NMODV + r];
        MO[e] = s; }
    LAS float* sm = (LAS float*)F.lds;
    for (int e = F.tid; e < 3 * 2 * DM; e += NTHREADS) { const int mi = e / (2 * DM), r = e % (2 * DM);
        float s = p.b_ada[r];
#pragma unroll
        for (int kb = 0; kb < 8; ++kb) s += MP[((size_t)kb * 3 + mi) * NMODV + r];
        sm[e] = s; }
    __syncthreads();
    bf16* H = (bf16*)(p.ws + WS_H);
    for (int row = F.gw; row < MTOT; row += F.NGW) { const int mi = mod_index(row);
        const float* xr = row < MLAT ? p.x + (size_t)row * DM : p.ctx + (size_t)(row - MLAT) * DM;
        const LAS float* sh = sm + mi * 2 * DM; const LAS float* sc = sh + DM;
        GAS unsigned long long* o8 = (GAS unsigned long long*)(H + (size_t)row * DM) + F.lane;
#pragma unroll
        for (int j = 0; j < 8; ++j) { const int c = 4 * F.lane + 256 * j; const f32x4 v = *(const GAS f32x4*)(xr + c);
            const float y0 = v.x * (1.0f + sc[c]) + sh[c], y1 = v.y * (1.0f + sc[c + 1]) + sh[c + 1], y2 = v.z * (1.0f + sc[c + 2]) + sh[c + 2], y3 = v.w * (1.0f + sc[c + 3]) + sh[c + 3];
            o8[64 * j] = (unsigned long long)pk2(y0, y1) | ((unsigned long long)pk2(y2, y3) << 32); } }
    __syncthreads();
}
__device__ __forceinline__ void ln_row_finish(const Frame& F, const Params& p, f32x4 (&v)[8], float mean, float rstd, const float* gain, const float* bias, int row, bool last, int lm, int wsh, int wsc) {
    float* X = (float*)(p.ws + WS_X); bf16* H = (bf16*)(p.ws + WS_H);
#pragma unroll
    for (int j = 0; j < 8; ++j) { const int c = 4 * F.lane + 256 * j; const f32x4 g = *(const GAS f32x4*)(gain + c), b = *(const GAS f32x4*)(bias + c); v[j] = (v[j] - mean) * rstd * g + b; }
    if (last) { GAS f32x4* o = (GAS f32x4*)(p.out + (size_t)row * DM) + F.lane;
#pragma unroll
        for (int j = 0; j < 8; ++j) o[64 * j] = v[j];
    } else {
        GAS f32x4* xo = (GAS f32x4*)(X + (size_t)row * DM) + F.lane;
        const int mi = mod_index(row); const float* sh = modv(p, lm, mi, wsh); const float* sc = modv(p, lm, mi, wsc);
        GAS unsigned long long* o8 = (GAS unsigned long long*)(H + (size_t)row * DM) + F.lane;
#pragma unroll
        for (int j = 0; j < 8; ++j) { const int c = 4 * F.lane + 256 * j; xo[64 * j] = v[j];
            const f32x4 a = *(const GAS f32x4*)(sc + c), b = *(const GAS f32x4*)(sh + c); const f32x4 y = v[j] * (a + 1.0f) + b;
            o8[64 * j] = (unsigned long long)pk2(y.x, y.y) | ((unsigned long long)pk2(y.z, y.w) << 32); } }
}
__device__ __forceinline__ void phase_ln(const Frame& F, const Params& p, int l, int sub, int M) {
    const float* V = (const float*)(p.ws + WS_V);
    const float* gain = (sub == 0 ? p.ln1g : p.ln2g) + (size_t)l * DM; const float* bias = (sub == 0 ? p.ln1b : p.ln2b) + (size_t)l * DM;
    const bool last = (sub == 1 && l == DEPTH - 1);
    const int lm = sub == 0 ? l : l + 1, wsh = sub == 0 ? 3 : 0, wsc = sub == 0 ? 4 : 1;
    for (int row = F.gw; row < M; row += 2 * F.NGW) {
        const int row2 = row + F.NGW; const bool two = row2 < M; const int rb = two ? row2 : row;
        const GAS f32x4* va = (const GAS f32x4*)(V + (size_t)row * DM) + F.lane; const GAS f32x4* vb = (const GAS f32x4*)(V + (size_t)rb * DM) + F.lane;
        f32x4 a[8], b[8]; float sa = 0.f, sb = 0.f;
#pragma unroll
        for (int j = 0; j < 8; ++j) { a[j] = va[64 * j]; b[j] = vb[64 * j]; }
#pragma unroll
        for (int j = 0; j < 8; ++j) { sa += (a[j].x + a[j].y) + (a[j].z + a[j].w); sb += (b[j].x + b[j].y) + (b[j].z + b[j].w); }
        const float ma = wave_sum(sa) * (1.f / DM), mb = wave_sum(sb) * (1.f / DM); float qa = 0.f, qb = 0.f;
#pragma unroll
        for (int j = 0; j < 8; ++j) { const f32x4 da = a[j] - ma, db = b[j] - mb; qa += (da.x * da.x + da.y * da.y) + (da.z * da.z + da.w * da.w); qb += (db.x * db.x + db.y * db.y) + (db.z * db.z + db.w * db.w); }
        const float ra = 1.f / sqrtf(wave_sum(qa) * (1.f / DM) + LN_EPS), rb2 = 1.f / sqrtf(wave_sum(qb) * (1.f / DM) + LN_EPS);
        ln_row_finish(F, p, a, ma, ra, gain, bias, row, last, lm, wsh, wsc);
        if (two) ln_row_finish(F, p, b, mb, rb2, gain, bias, row2, last, lm, wsh, wsc);
    }
}
template <int G, int PASS> __device__ __forceinline__ void pool_task(const unsigned char* ws, int base_row, int st, int n, int pos0, int c) {
    constexpr int W = 2 << G, LO = W / 2, HI = W - LO - 1, NIN = 32 + W - 1;
    const bf16* PROJ = (const bf16*)(ws + WS_PROJ); float* HM = (float*)(ws + WS_HM); bf16* T = (bf16*)(ws + WS_T);
    float s0[NIN], s1[NIN];
#pragma unroll
    for (int q = 0; q < NIN; ++q) { const int pos = pos0 - LO + q; const bool ok = pos >= 0 && pos < n; const int row = base_row + (ok ? pos : pos0) * st;
        if (PASS == 0) { const unsigned wv = *(const GAS unsigned*)(PROJ + (size_t)row * NPROJ + CP + c); s0[q] = ok ? bflo(wv) : 0.f; s1[q] = ok ? bfhi(wv) : 0.f; }
        else { const f32x2g hv = *(const GAS f32x2g*)(HM + (size_t)row * DPOOL + c); s0[q] = ok ? hv.x : 0.f; s1[q] = ok ? hv.y : 0.f; } }
#pragma unroll
    for (int q = 1; q < NIN; ++q) { s0[q] += s0[q - 1]; s1[q] += s1[q - 1]; }
#pragma unroll
    for (int i = 0; i < 32; ++i) { const int pos = pos0 + i, row = base_row + pos * st;
        const int cnt = min(pos + HI + 1, n) - max(pos - LO, 0); const float inv = 1.0f / (float)cnt;
        const float m0 = (s0[i + W - 1] - (i > 0 ? s0[i > 0 ? i - 1 : 0] : 0.f)) * inv, m1 = (s1[i + W - 1] - (i > 0 ? s1[i > 0 ? i - 1 : 0] : 0.f)) * inv;
        if (PASS == 0) *(GAS f32x2g*)(HM + (size_t)row * DPOOL + c) = (f32x2g){m0, m1};
        else { const unsigned wv = *(const GAS unsigned*)(PROJ + (size_t)row * NPROJ + CP + c); *(GAS unsigned*)(T + (size_t)row * DPOOL + c) = pk2(m0 - bflo(wv), m1 - bfhi(wv)); } }
}
template <int PASS> __device__ __forceinline__ void pool_dispatch(const unsigned char* ws, int g, int base_row, int st, int n, int pos0, int c) {
    if (g == 0) pool_task<0, PASS>(ws, base_row, st, n, pos0, c); else if (g == 1) pool_task<1, PASS>(ws, base_row, st, n, pos0, c);
    else if (g == 2) pool_task<2, PASS>(ws, base_row, st, n, pos0, c); else pool_task<3, PASS>(ws, base_row, st, n, pos0, c);
}
constexpr int N_POOL_LAT = 128 * 2 * 8, N_POOL_CTX = 2 * 8 * 8, N_POOL_TASKS = N_POOL_LAT + N_POOL_CTX;
template <int PASS> __device__ __forceinline__ void phase_pool(const Frame& F, const Params& p, int wi, int nw) {
    for (int id = wi; id < N_POOL_TASKS; id += nw) {
        if (id < N_POOL_LAT) { const int cb = id & 7, half = (id >> 3) & 1, line = id >> 4, c = cb * 128 + 2 * F.lane;
            if (PASS == 0) pool_dispatch<0>(p.ws, cb >> 1, line * 64, 1, 64, 32 * half, c);
            else pool_dispatch<1>(p.ws, cb >> 1, (line >> 6) * SEQ + (line & 63), 64, 64, 32 * half, c);
        } else { const int id2 = id - N_POOL_LAT, cb = id2 & 7, blk = (id2 >> 3) & 7, b = id2 >> 6, c = cb * 128 + 2 * F.lane;
            if (PASS == 0) pool_dispatch<0>(p.ws, cb >> 1, MLAT + b * CTXL, 1, CTXL, 32 * blk, c);
            else { const bf16* PROJ = (const bf16*)(p.ws + WS_PROJ); const float* HM = (const float*)(p.ws + WS_HM); bf16* T = (bf16*)(p.ws + WS_T);
#pragma unroll 8
                for (int i = 0; i < 32; ++i) { const int row = MLAT + b * CTXL + 32 * blk + i; const f32x2g hv = *(const GAS f32x2g*)(HM + (size_t)row * DPOOL + c);
                    const unsigned wv = *(const GAS unsigned*)(PROJ + (size_t)row * NPROJ + CP + c); *(GAS unsigned*)(T + (size_t)row * DPOOL + c) = pk2(hv.x - bflo(wv), hv.y - bfhi(wv)); } }
        }
    }
}
__device__ __forceinline__ float log_sigmoid_f(float z) { return fminf(z, 0.f) - log1pf(expf(-fabsf(z))); }
__device__ __forceinline__ void phase_la(const Frame& F, const Params& p, int l) {
    const bf16* PROJ = (const bf16*)(p.ws + WS_PROJ); float* LA = (float*)(p.ws + WS_LA);
    for (int task = F.gw; task < MTOT * 2; task += F.NGW) { const int row = task >> 1, dir = task & 1;
        const bf16* ap = PROJ + (size_t)row * NPROJ + CA + dir * 16; float a[16];
#pragma unroll
        for (int r = 0; r < 16; ++r) a[r] = bf2f(ap[r]);
        const float* wu = p.w_dup + ((size_t)l * 2 + dir) * RANK * 1024; const float* bu = p.b_dup + ((size_t)l * 2 + dir) * 1024;
#pragma unroll
        for (int j = 0; j < 4; ++j) { const int d = 4 * F.lane + 256 * j; f32x4 z = *(const GAS f32x4*)(bu + d);
#pragma unroll
            for (int r = 0; r < 16; ++r) z += *(const GAS f32x4*)(wu + (size_t)r * 1024 + d) * a[r];
            f32x4 o; o.x = log_sigmoid_f(z.x) * 0.0625f; o.y = log_sigmoid_f(z.y) * 0.0625f; o.z = log_sigmoid_f(z.z) * 0.0625f; o.w = log_sigmoid_f(z.w) * 0.0625f;
            *(GAS f32x4*)(LA + ((size_t)dir * MTOT + row) * 1024 + d) = o; } }
}
__device__ __forceinline__ void phase_gla_naive(const Frame& F, const Params& p) {
    const bf16* PROJ = (const bf16*)(p.ws + WS_PROJ); const float* LA = (const float*)(p.ws + WS_LA); float* O = (float*)(p.ws + WS_O);
    for (int it = F.gw; it < NBATCH * NH * HV; it += F.NGW) { const int b = it >> 11, h = (it >> 9) & 3, vcol = it & 511;
        for (int dir = 0; dir < 2; ++dir) {
            float S0 = 0.f, S1 = 0.f, S2 = 0.f, S3 = 0.f;
#pragma unroll 4
            for (int step = 0; step < CTXL + SEQ; ++step) {
                int row; if (step < CTXL) { const int t = dir ? CTXL - 1 - step : step; row = MLAT + b * CTXL + t; } else { const int s2 = step - CTXL; const int t = dir ? SEQ - 1 - s2 : s2; row = b * SEQ + t; }
                const bf16* pr = PROJ + (size_t)row * NPROJ;
                const u32x2g qw = *(const GAS u32x2g*)(pr + CQ + h * HK + 4 * F.lane), kw = *(const GAS u32x2g*)(pr + CK + h * HK + 4 * F.lane);
                const f32x4 la = *(const GAS f32x4*)(LA + ((size_t)dir * MTOT + row) * 1024 + h * HK + 4 * F.lane);
                const float vv = bf2f(pr[CV + h * HV + vcol]);
                S0 = expf(la.x) * S0 + bflo(kw.x) * vv; S1 = expf(la.y) * S1 + bfhi(kw.x) * vv; S2 = expf(la.z) * S2 + bflo(kw.y) * vv; S3 = expf(la.w) * S3 + bfhi(kw.y) * vv;
                const float part = wave_sum((bflo(qw.x) * S0 + bfhi(qw.x) * S1) + (bflo(qw.y) * S2 + bfhi(qw.y) * S3));
                if (F.lane == 0) { float* op = O + (size_t)row * DM + h * HV + vcol; *op = dir ? *op + part : part; }
            }
        }
    }
}
template <int NO> __device__ __forceinline__ void phase_gout(const Frame& F, const Params& p, int l, int M) {
    const bf16* PROJ = (const bf16*)(p.ws + WS_PROJ); const float* O = (const float*)(p.ws + WS_O); bf16* A = (bf16*)(p.ws + WS_AGLA);
    const float* gain = p.gla_gain + (size_t)l * DM;
    for (int task = F.gw; task < M * NH; task += F.NGW) { const int row = task >> 2, h = task & 3, c = h * HV + 8 * F.lane;
        f32x4 o0 = *(const GAS f32x4*)(O + (size_t)row * DM + c), o1 = *(const GAS f32x4*)(O + (size_t)row * DM + c + 4);
        if (NO == 2) { o0 += *(const GAS f32x4*)(O + (size_t)(MTOT + row) * DM + c); o1 += *(const GAS f32x4*)(O + (size_t)(MTOT + row) * DM + c + 4); }
        const float ss = wave_sum((o0.x * o0.x + o0.y * o0.y) + (o0.z * o0.z + o0.w * o0.w) + (o1.x * o1.x + o1.y * o1.y) + (o1.z * o1.z + o1.w * o1.w));
        const float r = 1.0f / sqrtf(ss * (1.0f / HV) + RMS_EPS);
        const f32x4 g0 = *(const GAS f32x4*)(gain + c), g1 = *(const GAS f32x4*)(gain + c + 4);
        const v4u gw = *(const GAS v4u*)(PROJ + (size_t)row * NPROJ + CG + c);
        v4u w; w.x = pk2(o0.x * r * g0.x * bflo(gw.x), o0.y * r * g0.y * bfhi(gw.x)); w.y = pk2(o0.z * r * g0.z * bflo(gw.y), o0.w * r * g0.w * bfhi(gw.y));
        w.z = pk2(o1.x * r * g1.x * bflo(gw.z), o1.y * r * g1.y * bfhi(gw.z)); w.w = pk2(o1.z * r * g1.z * bflo(gw.w), o1.w * r * g1.w * bfhi(gw.w));
        *(GAS v4u*)(A + (size_t)row * DM + c) = w; }
}

typedef float f32x16 __attribute__((ext_vector_type(16)));
__device__ __forceinline__ int swap23(int d) { return (d & ~12) | ((d & 4) << 1) | ((d & 8) >> 1); }
constexpr int PREP_ROW = 528;
constexpr int PREP_QS = 0, PREP_KS = 64 * PREP_ROW, PREP_QT = 2 * 64 * PREP_ROW, PREP_AL = 3 * 64 * PREP_ROW, PREP_TOT = PREP_AL + 4096;
constexpr int N_PREP_A = NCG * 4 * 2, N_PREP_V = NCG * 4;
constexpr int VT_ROW = 1040;

__device__ __forceinline__ float log_sigmoid_fast(float z) { return -__logf(1.0f + __expf(-z)); }
__device__ __forceinline__ void phase_gla_prep(const Frame& F, const Params& p, int l) {
    const bf16* PROJ = (const bf16*)(p.ws + WS_PROJ);
    bf16* QI = (bf16*)(p.ws + WS_QI); bf16* KST = (bf16*)(p.ws + WS_KST); bf16* PM = (bf16*)(p.ws + WS_PM); float* DCB = (float*)(p.ws + WS_DCB); bf16* VT = (bf16*)(p.ws + WS_VT);
    for (int item = F.vcu; item < N_PREP_A + N_PREP_V; item += F.G) {
        if (item < N_PREP_A) {
            const int cg = item >> 3, h = (item >> 1) & 3, dir = item & 1, r0 = cg * 64;
            LAS float* AL = (LAS float*)(F.lds + PREP_AL); LAS float* TOT = (LAS float*)(F.lds + PREP_TOT);
            LAS unsigned short* QS = (LAS unsigned short*)(F.lds + PREP_QS); LAS unsigned short* KS = (LAS unsigned short*)(F.lds + PREP_KS); LAS unsigned short* QT = (LAS unsigned short*)(F.lds + PREP_QT);
#pragma unroll
            for (int k = 0; k < 4; ++k) { const int id = F.tid + NTHREADS * k, row = id >> 5, c = id & 31; const bf16* pr = PROJ + (size_t)(r0 + row) * NPROJ + h * HK + 8 * c;
                *(LAS v4u*)(F.lds + PREP_QS + row * PREP_ROW + 16 * c) = *(const GAS v4u*)(pr + CQ); *(LAS v4u*)(F.lds + PREP_KS + row * PREP_ROW + 16 * c) = *(const GAS v4u*)(pr + CK); }
            { const int j = F.tid >> 3, r2 = (F.tid & 7) * 2; const unsigned w = *(const GAS unsigned*)(PROJ + (size_t)(r0 + j) * NPROJ + CA + dir * 16 + r2); AL[j * 16 + r2] = bflo(w); AL[j * 16 + r2 + 1] = bfhi(w); }
            const int d = F.tid & 255, jh = F.tid >> 8;
            float w[16];
#pragma unroll
            for (int r = 0; r < 16; ++r) w[r] = p.w_dup[(((size_t)l * 2 + dir) * RANK + r) * 1024 + h * HK + d];
            const float bz = p.b_dup[((size_t)l * 2 + dir) * 1024 + h * HK + d];
            __syncthreads();
            float ex[32]; float run = 0.f;
#pragma unroll
            for (int jo = 0; jo < 32; ++jo) { const LAS f32x4* a = (const LAS f32x4*)(AL + (jh * 32 + jo) * 16); float z = bz;
#pragma unroll
                for (int r4 = 0; r4 < 4; ++r4) { const f32x4 av = a[r4]; z += av.x * w[4 * r4] + av.y * w[4 * r4 + 1] + av.z * w[4 * r4 + 2] + av.w * w[4 * r4 + 3]; }
                ex[jo] = run; run += log_sigmoid_fast(z) * 0.0625f; }
            TOT[jh * 256 + d] = run;
            __syncthreads();
            const float t0 = TOT[d], t1 = TOT[256 + d], tot = run;
            const float first = dir ? t1 : t0;
            const float last = t0 + t1;
            const float off = (jh == dir) ? 0.f : first;
            const float Eref = __expf(first), Elr = __expf(last - first);
            const size_t gi = ((size_t)dir * NCG + cg) * 4 + h;
            if (jh == 0) DCB[gi * 256 + d] = __expf(last);
            unsigned kpack[16];
#pragma unroll
            for (int jo = 0; jo < 32; ++jo) { const int j = jh * 32 + jo;
                const float incl = (jo < 31) ? ex[(jo + 1) & 31] : tot;
                const float cum = (dir ? (tot - ex[jo]) : incl) + off;
                const float x = cum - first, e1 = __expf(x), e2 = __expf(-x);
                const float q = bf2f(QS[j * (PREP_ROW / 2) + d]), k = bf2f(KS[j * (PREP_ROW / 2) + d]);
                const float qin = q * e1, kin = k * e2;
                const unsigned qk = pg8::cvt_pk_bf16(qin, kin), qe = pg8::cvt_pk_bf16(qin * Eref, kin * Elr);
                QS[j * (PREP_ROW / 2) + d] = (unsigned short)qk; KS[j * (PREP_ROW / 2) + d] = (unsigned short)(qk >> 16); QT[j * (PREP_ROW / 2) + d] = (unsigned short)qe;
                if (jo & 1) kpack[jo >> 1] |= qe & 0xffff0000u; else kpack[jo >> 1] = qe >> 16; }
            { GAS v4u* kp = (GAS v4u*)(KST + (gi * 256 + d) * 64 + jh * 32);
#pragma unroll
              for (int c = 0; c < 4; ++c) kp[c] = (v4u){kpack[4 * c], kpack[4 * c + 1], kpack[4 * c + 2], kpack[4 * c + 3]}; }
            __syncthreads();
#pragma unroll
            for (int k = 0; k < 4; ++k) { const int id = F.tid + NTHREADS * k, row = id >> 5, c = id & 31;
                *(GAS v4u*)(QI + ((size_t)dir * MTOT + r0 + row) * 1024 + h * HK + 8 * c) = *(const LAS v4u*)(F.lds + PREP_QT + row * PREP_ROW + 16 * c); }
            { const int ti = F.wave >> 1, fr = F.lane & 15, fq = F.lane >> 4;
#pragma unroll
              for (int q2 = 0; q2 < 2; ++q2) { const int tj = (F.wave & 1) * 2 + q2; f32x4 acc = {0.f, 0.f, 0.f, 0.f};
#pragma unroll
                for (int ks = 0; ks < 8; ++ks) { const bf16x8 a = *(const LAS bf16x8*)(F.lds + PREP_KS + (16 * tj + fr) * PREP_ROW + (32 * ks + 8 * fq) * 2);
                    const bf16x8 bq = *(const LAS bf16x8*)(F.lds + PREP_QS + (16 * ti + fr) * PREP_ROW + (32 * ks + 8 * fq) * 2);
                    acc = __builtin_amdgcn_mfma_f32_16x16x32_bf16(a, bq, acc, 0, 0, 0); }
                const int i = 16 * ti + fr, j0 = 16 * tj + 4 * fq; float v[4];
#pragma unroll
                for (int reg = 0; reg < 4; ++reg) { const int j = j0 + reg; const bool keep = dir ? (j >= i) : (j <= i); v[reg] = keep ? acc[reg] : 0.f; }
                *(GAS u32x2g*)(PM + (gi * 64 + i) * 64 + j0) = (u32x2g){pk2(v[0], v[1]), pk2(v[2], v[3])}; } }
            __syncthreads();
        } else {
            const int it = item - N_PREP_A, cg = it >> 2, h = it & 3, r0 = cg * 64;
#pragma unroll
            for (int k = 0; k < 8; ++k) { const int id = F.tid + NTHREADS * k, row = id >> 6, c = id & 63;
                const v4u x = *(const GAS v4u*)(PROJ + (size_t)(r0 + row) * NPROJ + CV + h * HV + 8 * c); *(LAS v4u*)(F.lds + row * VT_ROW + 16 * c) = x; }
            __syncthreads();
#pragma unroll
            for (int k = 0; k < 8; ++k) { const int id = F.tid + NTHREADS * k, v = id & 511, jb = id >> 9; unsigned e[8];
#pragma unroll
                for (int jj = 0; jj < 8; ++jj) e[jj] = *(const LAS unsigned short*)(F.lds + (8 * jb + jj) * VT_ROW + 2 * v);
                *(GAS v4u*)(VT + (((size_t)cg * 4 + h) * 512 + v) * 64 + 8 * jb) = (v4u){e[0] | (e[1] << 16), e[2] | (e[3] << 16), e[4] | (e[5] << 16), e[6] | (e[7] << 16)}; }
            __syncthreads();
        }
    }
}

#define MFMA32(a, b, c) __builtin_amdgcn_mfma_f32_32x32x16_bf16((a), (b), (c), 0, 0, 0)
#define MFMA16(a, b, c) __builtin_amdgcn_mfma_f32_16x16x32_bf16((a), (b), (c), 0, 0, 0)
constexpr int S8_QI = 0, S8_EX = 65536, S8_EXSZ = 13312, S8_KST = S8_EX + 2 * S8_EXSZ, S8_ST = S8_KST + 32768, S8_STSZ = 32 * 528, S8_END = S8_ST + 2 * S8_STSZ;
static_assert(S8_END <= MISC_OFF, "scan LDS map");
__device__ __forceinline__ void glds16(const unsigned char* ws, unsigned off, LAS unsigned char* l) { __builtin_amdgcn_global_load_lds((const unsigned*)(ws + off), (LAS unsigned*)l, 16, 0, 0); }
__device__ __forceinline__ int scan_chunk(int n, int b, int dir) { n = n > 67 ? 67 : n; return n < 4 ? 128 + 4 * b + (dir ? 3 - n : n) : 64 * b + (dir ? 67 - n : n - 4); }
#define SC_WAIT_V(n) asm volatile("s_waitcnt vmcnt(" #n ")" ::: "memory")
#define SC_FENCE() asm volatile("" ::: "memory")

__device__ __forceinline__ void phase_gla_scan(const Frame& F, const Params& p) {
    const int item = F.vcu; if (item >= 256) return;
    const int g16 = item >> 4, vs = item & 15, b = g16 >> 3, h = (g16 >> 1) & 3, dir = g16 & 1;
    const int lane = F.lane, w = F.wave, r = lane & 31, hh = lane >> 5, fr = lane & 15, fq = lane >> 4, ti = w >> 1, tv = w & 1;
    LAS unsigned char* lds = F.lds; const unsigned char* ws = p.ws;
    const unsigned QI0 = (unsigned)(WS_QI + ((size_t)dir * MTOT * 1024 + h * HK) * 2), KST0 = (unsigned)(WS_KST + ((size_t)dir * NCG * 4 + h) * 32768) + (unsigned)w * 4096u;
    const unsigned PM0 = (unsigned)(WS_PM + ((size_t)dir * NCG * 4 + h) * 8192), DC0 = (unsigned)(WS_DCB + ((size_t)dir * NCG * 4 + h) * 1024), VT0 = (unsigned)(WS_VT + ((size_t)h * 512 + vs * 32) * 128);
    const unsigned O0 = (unsigned)(WS_O + ((size_t)dir * MTOT * DM + h * HV + vs * 32) * 4);
    unsigned qoff[4];
#pragma unroll
    for (int j = 0; j < 4; ++j) { const int row = 8 * w + 2 * j + (lane >> 5); qoff[j] = (unsigned)(row * 2048 + 16 * ((lane & 31) ^ (row & 15))); }
    const unsigned koffe = (unsigned)((lane >> 3) * 128 + 16 * ((lane & 7) ^ (lane >> 4))), koffo = (unsigned)((lane >> 3) * 128 + 16 * ((lane & 7) ^ ((lane >> 4) + 4)));
    const unsigned kme = (w & 1) ? koffo : koffe;
    const int x16 = fr, xk = (r >> 1) & 7, xf = (fr >> 1) & 7;
    f32x16 S;
#pragma unroll
    for (int i = 0; i < 16; ++i) S[i] = 0.f;
#define S8_ISSUE_SHARED(cgx, par) do { const unsigned qb_ = QI0 + (unsigned)(cgx) * 131072u; LAS unsigned char* e_ = lds + S8_EX + (par) * S8_EXSZ; \
        _Pragma("unroll") for (int j_ = 0; j_ < 4; ++j_) glds16(ws, qb_ + qoff[j_], lds + S8_QI + (par) * 32768 + (8 * w + 2 * j_) * 512); \
        glds16(ws, PM0 + (unsigned)(cgx) * 32768u + (unsigned)w * 1024u + kme, e_ + w * 1024); \
        if (w < 4) glds16(ws, VT0 + (unsigned)(cgx) * 262144u + (unsigned)w * 1024u + kme, e_ + 8192 + w * 1024); \
        else if (w == 4) glds16(ws, DC0 + (unsigned)(cgx) * 4096u + (unsigned)lane * 16u, e_ + 12288); \
        else glds16(ws, PM0 + (unsigned)(cgx) * 32768u + (unsigned)w * 1024u + kme, e_ + w * 1024); } while (0)
#define S8_ISSUE_KST(cgx) do { const unsigned kb_ = KST0 + (unsigned)(cgx) * 131072u; \
        _Pragma("unroll") for (int j_ = 0; j_ < 4; ++j_) glds16(ws, kb_ + j_ * 1024 + ((j_ & 1) ? koffo : koffe), lds + S8_KST + w * 4096 + j_ * 1024); } while (0)
    int cg = scan_chunk(0, b, dir);
    S8_ISSUE_SHARED(cg, 0); S8_ISSUE_KST(cg);
    for (int n = 0; n < 68; ++n) {
        const int par = n & 1, cgn = scan_chunk(n + 1, b, dir);
        LAS unsigned char* st = lds + S8_ST + par * S8_STSZ; const LAS unsigned char* qi = lds + S8_QI + par * 32768; const LAS unsigned char* ex = lds + S8_EX + par * S8_EXSZ;
        SC_WAIT_V(4);
#pragma unroll
        for (int g = 0; g < 4; ++g) *(LAS u32x2g*)(st + r * 528 + (32 * w + 8 * g + 4 * hh) * 2) = (u32x2g){pk2(S[4 * g], S[4 * g + 1]), pk2(S[4 * g + 2], S[4 * g + 3])};
        asm volatile("s_waitcnt lgkmcnt(0)" ::: "memory"); __builtin_amdgcn_s_barrier(); SC_FENCE();
        S8_ISSUE_SHARED(cgn, par ^ 1);
        f32x4 o = {0.f, 0.f, 0.f, 0.f};
#pragma unroll
        for (int ks = 0; ks < 8; ++ks) { const bf16x8 a = *(const LAS bf16x8*)(qi + (16 * ti + fr) * 512 + 16 * ((4 * ks + fq) ^ x16)); const bf16x8 bb = *(const LAS bf16x8*)(st + (16 * tv + fr) * 528 + (32 * ks + 8 * fq) * 2); o = MFMA16(a, bb, o); }
#pragma unroll
        for (int k2 = 0; k2 < 2; ++k2) { const bf16x8 a = *(const LAS bf16x8*)(ex + (16 * ti + fr) * 128 + 16 * ((4 * k2 + fq) ^ xf)); const bf16x8 bb = *(const LAS bf16x8*)(ex + 8192 + (16 * tv + fr) * 128 + 16 * ((4 * k2 + fq) ^ xf)); o = MFMA16(a, bb, o); }
        { const unsigned ob = O0 + (unsigned)cg * (64u * DM * 4u) + (unsigned)((16 * ti + 4 * fq) * (DM * 4) + (16 * tv + fr) * 4);
#pragma unroll
          for (int reg = 0; reg < 4; ++reg) *(GAS float*)(ws + ob + (unsigned)(reg * DM * 4)) = o[reg]; }
        SC_WAIT_V(10);
        SC_FENCE();
#pragma unroll
        for (int g = 0; g < 4; ++g) { const f32x4 dc = *(const LAS f32x4*)(ex + 12288 + (32 * w + 8 * g + 4 * hh) * 4); S[4 * g] *= dc.x; S[4 * g + 1] *= dc.y; S[4 * g + 2] *= dc.z; S[4 * g + 3] *= dc.w; }
#pragma unroll
        for (int s4 = 0; s4 < 4; ++s4) { const bf16x8 ka = *(const LAS bf16x8*)(lds + S8_KST + w * 4096 + r * 128 + 16 * ((2 * s4 + hh) ^ xk)); const bf16x8 vb = *(const LAS bf16x8*)(ex + 8192 + r * 128 + 16 * ((2 * s4 + hh) ^ xk)); S = MFMA32(ka, vb, S); }
        asm volatile("s_waitcnt lgkmcnt(0)" ::: "memory");
        S8_ISSUE_KST(cgn);
        cg = cgn;
    }
    SC_WAIT_V(0);
    __builtin_amdgcn_s_barrier();
#undef S8_ISSUE_SHARED
#undef S8_ISSUE_KST
}

enum { PH_PRO_A = 0, PH_PRO_B, PH_WIN, PH_LA, PH_GLA, PH_GOUT, PH_GO, PH_WOUT, PH_LN0, PH_FFI, PH_FFO, PH_LN1, PH_COUNT };

template <int PH> __device__ __forceinline__ void run_phase(const Frame& F0, const Params& p0, int l) {
    Frame F = F0; asm volatile("" : "+v"(F.tid));
    F.lane = F.tid & 63; F.wave = __builtin_amdgcn_readfirstlane(F.tid >> 6); F.gw = F.vcu * NWAVES + F.wave;
    Params p = p0; asm volatile("" : "+s"(p.ws));
    const int M = (l == DEPTH - 1) ? MLAT : MTOT;
    bf16* H = (bf16*)(p.ws + WS_H); bf16* PROJ = (bf16*)(p.ws + WS_PROJ); bf16* ACT = (bf16*)(p.ws + WS_ACT); float* X = (float*)(p.ws + WS_X); float* V = (float*)(p.ws + WS_V);
    bf16* AGLA = (bf16*)(p.ws + WS_AGLA); bf16* T = (bf16*)(p.ws + WS_T); float* TEMP = (float*)(p.ws + WS_TEMP); bf16* MRG = (bf16*)(p.ws + WS_MRG);
    pg8::StaticOrder S;
    if constexpr (PH == PH_PRO_A) phase_prologue_a(F, p);
    if constexpr (PH == PH_PRO_B) {
        const int ng = F.G / 4, c = (int)blockIdx.x, lyr = c / ng < DEPTH ? c / ng : DEPTH - 1;
        pg8::Gemm g{wlayer(p, lyr, WO_PO), wlayer(p, lyr, WO_PG), DM, 1024, 1024}; S.init(DM, 1024, ng, c < DEPTH * ng ? c % ng : (1 << 20)); EpiBf16Plain E{wlayer(p, lyr, WO_PC), 1024};
        pg8::gemm_phase<EpiBf16Plain, pg8::StaticOrder, true, true>(F.lds, g, S, E);
        phase_prologue_b(F, p); }
    if constexpr (PH == PH_WIN) { pg8::Gemm g{H, wlayer(p, l, WO_IN), MTOT, NPROJ, DM}; S.init(MTOT, NPROJ, F.G, (int)blockIdx.x); EpiProj E{PROJ};
        pg8::gemm_phase<EpiProj, pg8::StaticOrder, true, true>(F.lds, g, S, E); }
    if constexpr (PH == PH_LA) { phase_pool<0>(F, p, F.gw, F.NGW); phase_gla_prep(F, p, l); }
    if constexpr (PH == PH_GLA) { phase_pool<1>(F, p, F.gw, F.NGW); phase_gla_scan(F, p); }
    if constexpr (PH == PH_GOUT) { phase_gout<2>(F, p, l, M);
        pg8::Gemm g{T, wlayer(p, l, WO_PC), MLAT, DM, DPOOL}; S.init(MLAT, DM, F.G, (int)blockIdx.x); EpiGateTemp E{TEMP, PROJ};
        pg8::gemm_phase<EpiGateTemp, pg8::StaticOrder, true, true>(F.lds, g, S, E);
        if (l < DEPTH - 1) small_gemm_ctx(F, T, wlayer(p, l, WO_PC), DPOOL, E); }
    if constexpr (PH == PH_GO) { pg8::Gemm g{AGLA, wlayer(p, l, WO_GO), MLAT, DM, DM}; S.init(MLAT, DM, F.G, (int)blockIdx.x); EpiMerge E{MRG, TEMP, PROJ};
        pg8::gemm_phase<EpiMerge, pg8::StaticOrder, true, true>(F.lds, g, S, E);
        if (l < DEPTH - 1) small_gemm_ctx(F, AGLA, wlayer(p, l, WO_GO), DM, E); }
    if constexpr (PH == PH_WOUT) { pg8::Gemm g{MRG, wlayer(p, l, WO_OUT), MLAT, DM, DM}; S.init(MLAT, DM, F.G, (int)blockIdx.x);
        EpiResid E{V, l == 0 ? p.x : X, l == 0 ? p.ctx : X + (size_t)MLAT * DM, modv(p, l, 0, 2)};
        pg8::gemm_phase<EpiResid, pg8::StaticOrder, true, true>(F.lds, g, S, E);
        if (l < DEPTH - 1) small_gemm_ctx(F, MRG, wlayer(p, l, WO_OUT), DM, E); }
    if constexpr (PH == PH_LN0) phase_ln(F, p, l, 0, M);
    if constexpr (PH == PH_FFI) { pg8::Gemm g{H, wlayer(p, l, WO_FI), M, NFFI, DM}; S.init(M, NFFI, F.G, (int)blockIdx.x); EpiSwiglu E{ACT};
        pg8::gemm_phase<EpiSwiglu, pg8::StaticOrder, true, true>(F.lds, g, S, E); }
    if constexpr (PH == PH_FFO) { pg8::Gemm g{ACT, wlayer(p, l, WO_FO), MLAT, DM, DFF}; S.init(MLAT, DM, F.G, (int)blockIdx.x);
        EpiResid E{V, X, X + (size_t)MLAT * DM, modv(p, l, 0, 5)};
        pg8::gemm_phase<EpiResid, pg8::StaticOrder, true, true>(F.lds, g, S, E);
        if (l < DEPTH - 1) small_gemm_ctx(F, ACT, wlayer(p, l, WO_FO), DFF, E); }
    if constexpr (PH == PH_LN1) phase_ln(F, p, l, 1, M);
}
__device__ __forceinline__ Frame make_frame(unsigned char* lds) {
    Frame F; F.lds = (LAS unsigned char*)lds; F.tid = threadIdx.x; F.lane = F.tid & 63; F.wave = __builtin_amdgcn_readfirstlane(F.tid >> 6);
    F.G = gridDim.x; const int bx = blockIdx.x; F.vcu = (F.G % 8 == 0) ? (bx % 8) * (F.G / 8) + bx / 8 : bx; F.gw = F.vcu * NWAVES + F.wave; F.NGW = F.G * NWAVES;
    return F;
}

constexpr int CW_BAR = 4096;
__device__ __forceinline__ XcdBarrier mkbar(const Params& p, unsigned x, volatile LAS unsigned* st) { unsigned char* w = p.ws; asm volatile("" : "+s"(w), "+s"(x)); XcdBarrier b; b.bar = (unsigned*)(w + WS_CTL) + CW_BAR; b.x = x; b.st = st; return b; }
#define PHASE(ph, l) do { run_phase<ph>(F, p, (l)); xcd_barrier(mkbar(p, bar_x, bar_st)); } while (0)
__global__ void __launch_bounds__(NTHREADS, 2) k_mega(Params p) {
    extern __shared__ __attribute__((aligned(16))) unsigned char lds[];
    const Frame F = make_frame(lds);
    for (int u = F.tid; u < (LDS_BYTES - MISC_OFF) / 4; u += NTHREADS) ((LAS unsigned*)(F.lds + MISC_OFF))[u] = 0u;
    __syncthreads();
    volatile LAS unsigned* const bar_st = (volatile LAS unsigned*)(F.lds + MISC_OFF) + 8;
    const unsigned bar_x = xcd_barrier_post((unsigned*)(p.ws + WS_CTL) + CW_BAR, bar_st).x;
    PHASE(PH_PRO_A, 0);
    PHASE(PH_PRO_B, 0);
    for (int l = 0; l < DEPTH; ++l) {
        PHASE(PH_WIN, l);
        PHASE(PH_LA, l);
        PHASE(PH_GLA, l);
        PHASE(PH_GOUT, l);
        PHASE(PH_GO, l);
        PHASE(PH_WOUT, l);
        PHASE(PH_LN0, l);
        PHASE(PH_FFI, l);
        PHASE(PH_FFO, l);
        if (l < DEPTH - 1) PHASE(PH_LN1, l); else run_phase<PH_LN1>(F, p, l);
    }
}

extern "C" void kernel_launch(void* const* d_in, const int* in_sizes, int n_in, void* d_out, int out_size, void* d_ws, size_t ws_size, hipStream_t stream) {
    static int grid = 0;
    if (grid == 0) {
        if (n_in != 21 || out_size != MLAT * DM || ws_size < WS_END) { fprintf(stderr, "kernel_launch: unexpected problem (n_in %d, out %d, ws %zu, need %zu)\n", n_in, out_size, ws_size, (size_t)WS_END); grid = -1; return; }
        int dev = 0, cus = 0, per_cu = 0;
        if (hipGetDevice(&dev) != hipSuccess || hipDeviceGetAttribute(&cus, hipDeviceAttributeMultiprocessorCount, dev) != hipSuccess) { grid = -1; return; }
        if (hipFuncSetAttribute((const void*)k_mega, hipFuncAttributeMaxDynamicSharedMemorySize, LDS_BYTES) != hipSuccess) { fprintf(stderr, "kernel_launch: hipFuncSetAttribute failed\n"); grid = -1; return; }
        if (hipOccupancyMaxActiveBlocksPerMultiprocessor(&per_cu, (const void*)k_mega, NTHREADS, LDS_BYTES) != hipSuccess || per_cu < 1) fprintf(stderr, "kernel_launch: occupancy query reports %d workgroups per CU\n", per_cu);
        (void)hipGetLastError();
        grid = cus;
    }
    if (grid < 0) return;
    (void)hipMemsetAsync((char*)d_ws + WS_CTL, 0, CTL_BYTES, stream);
    Params p{};
    const float** pp = (const float**)&p;
    for (int i = 0; i < 21; ++i) pp[i] = (const float*)d_in[i];
    p.out = (float*)d_out; p.ws = (unsigned char*)d_ws; p.layer = 0; p.pad = 0;
    hipLaunchKernelGGL(k_mega, dim3(grid), dim3(NTHREADS), LDS_BYTES, stream, p);
}
```

```cpp
#include <hip/hip_runtime.h>
#include <cstdio>
#include <cstdint>
namespace pg8 {
#define PG8_LAS __attribute__((address_space(3)))
typedef unsigned short bf16_t;
typedef short bf16x8 __attribute__((ext_vector_type(8)));
typedef float f32x4 __attribute__((ext_vector_type(4)));
typedef unsigned u32x4 __attribute__((ext_vector_type(4)));
constexpr int BM = 256, BK = 64, HALF = 128, HTB = HALF * BK * 2  , STAGE_BYTES = 8 * HTB, NXCD = 8, WGM = 8;

__host__ __device__ __forceinline__ int lds_byte(int r, int c) { const int st = (r >> 4) * 2 + (c >> 5), rr = r & 15, cc = c & 31, ob = rr * 64 + cc * 2; return st * 1024 + (ob ^ (((ob >> 9) & 1) << 5)); }
__host__ __device__ __forceinline__ void stage_rc(int b, int& R, int& C) { const int st = b / 1024, sb = b % 1024, swz = sb ^ (((sb >> 9) & 1) << 5); R = (st >> 1) * 16 + swz / 64; C = (st & 1) * 32 + (swz % 64) / 2; }
__host__ __device__ __forceinline__ int perm32(int rho) { const int n = rho >> 4, i = rho & 15; return 8 * (i >> 2) + 4 * n + (i & 3); }

struct Unit { int pm, pn; };
struct Gemm { const bf16_t* A; const bf16_t* Bt; int M, N, K; };

struct StaticOrder {
    int nM, nN, nwg, G, c;
    __host__ __device__ void init(int M, int N, int G_, int c_) { nM = M / BM; nN = N / BM; nwg = nM * nN; G = G_; c = c_; }
    __host__ __device__ bool next(int i, Unit& u) const {
        const long L = (long)i * G + c; if (L >= nwg) return false;
        int wgid = (int)L; { const int q = nwg / NXCD, r = nwg % NXCD, xcd = wgid % NXCD, off = wgid / NXCD; wgid = (xcd < r ? xcd * (q + 1) : r * (q + 1) + (xcd - r) * q) + off; }
        const int nig = WGM * nN, gid = wgid / nig, fm = gid * WGM, gsz = (nM - fm) < WGM ? (nM - fm) : WGM;
        u.pm = fm + ((wgid % nig) % gsz); u.pn = (wgid % nig) / gsz; return true;
    }
    __device__ __forceinline__ void a_ready(const Unit&) const {}
    __device__ __forceinline__ void done(const Unit&) const {}
};
__device__ __forceinline__ unsigned cvt_pk_bf16(float lo, float hi) { unsigned r; asm volatile("v_cvt_pk_bf16_f32 %0, %1, %2" : "=v"(r) : "v"(lo), "v"(hi)); return r; }
template <class Epi, class Sched, bool ALIGN_EPI = false, bool SP2 = false>
__device__ __forceinline__ void gemm_phase(PG8_LAS unsigned char* lds, const Gemm g, const Sched& S, const Epi& E) {
    int tid_ = threadIdx.x; asm volatile("" : "+v"(tid_));
    const int tid = tid_, wid = __builtin_amdgcn_readfirstlane(tid >> 6), lane = tid & 63, wr = wid >> 2, wc = wid & 3, fr = lane & 15, fq = lane >> 4;
    const int K = g.K, nt = K / BK;
    unsigned voffA[2], voffB[2];
#pragma unroll
    for (int i = 0; i < 2; ++i) { int R, C; stage_rc(tid * 16 + i * 8192, R, C); const int Rb = Epi::PERM ? ((R & ~31) + perm32(R & 31)) : R;
        voffA[i] = (unsigned)(R * K + C) * 2u; voffB[i] = (unsigned)(Rb * K + C) * 2u; }
    const size_t kstep = (size_t)(BK * 2);
    const size_t hstep = (size_t)HALF * K * 2;
    const size_t tstep = 2 * hstep;
    const unsigned ldsw = (unsigned)wid * 1024u;
    const int aoff = lds_byte(wr * 64 + fr, fq * 8), boff = lds_byte(wc * 32 + fr, fq * 8);
#define PG8_SA(b, h) (((b) * 2 + (h)) * HTB)
#define PG8_SB(b, h) ((4 + (b) * 2 + (h)) * HTB)
#define PG8_STAGE(bufoff, gbase, voff) do { _Pragma("unroll") for (int _i = 0; _i < 2; ++_i) \
        __builtin_amdgcn_global_load_lds((const unsigned*)((const char*)(gbase) + (voff)[_i]), (PG8_LAS unsigned*)(lds + (bufoff) + ldsw + _i * 8192), 16, 0, 0); } while (0)
#define PG8_LDA(dst, b, h) do { _Pragma("unroll") for (int m = 0; m < 4; ++m) _Pragma("unroll") for (int k = 0; k < 2; ++k) dst[m][k] = *(const PG8_LAS bf16x8*)(lds + PG8_SA(b, h) + aoff + m * 2048 + k * 1024); } while (0)
#define PG8_LDB(dst, b, h) do { _Pragma("unroll") for (int n = 0; n < 2; ++n) _Pragma("unroll") for (int k = 0; k < 2; ++k) dst[n][k] = *(const PG8_LAS bf16x8*)(lds + PG8_SB(b, h) + boff + n * 2048 + k * 1024); } while (0)
#define PG8_MMA(ai, bj, At, Bt) do { __builtin_amdgcn_s_setprio(1); _Pragma("unroll") for (int m = 0; m < 4; ++m) _Pragma("unroll") for (int n = 0; n < 2; ++n) _Pragma("unroll") for (int k = 0; k < 2; ++k) \
        acc[ai][bj][m][n] = __builtin_amdgcn_mfma_f32_16x16x32_bf16(Bt[n][k], At[m][k], acc[ai][bj][m][n], 0, 0, 0); __builtin_amdgcn_s_setprio(0); } while (0)
#define PG8_WAIT_V(n) asm volatile("s_waitcnt vmcnt(" #n ")" ::: "memory")
#define PG8_WAIT_L(n) asm volatile("s_waitcnt lgkmcnt(" #n ")" ::: "memory")
#define PG8_BAR __builtin_amdgcn_s_barrier()
#define PG8_SCHED __builtin_amdgcn_sched_barrier(0)
    Unit cur, nxt; int ui = 0;
    if (!S.next(0, cur)) return;
    f32x4 acc[2][2][4][2];
#pragma unroll
    for (int a = 0; a < 2; ++a)
#pragma unroll
        for (int b = 0; b < 2; ++b)
#pragma unroll
            for (int m = 0; m < 4; ++m)
#pragma unroll
                for (int n = 0; n < 2; ++n) acc[a][b][m][n] = (f32x4){0.f, 0.f, 0.f, 0.f};
    bf16x8 At[4][2], B0[2][2], B1[2][2];
    const char* cA = (const char*)g.A + (size_t)cur.pm * tstep; const char* cB = (const char*)g.Bt + (size_t)cur.pn * tstep;
    S.a_ready(cur);
    if constexpr (SP2) {
        PG8_STAGE(PG8_SB(0, 0), cB, voffB); PG8_STAGE(PG8_SB(0, 1), cB + hstep, voffB); PG8_STAGE(PG8_SA(0, 0), cA, voffA); PG8_STAGE(PG8_SA(0, 1), cA + hstep, voffA);
        if (wr == 1) PG8_BAR;
        PG8_WAIT_V(2); PG8_BAR;
        PG8_STAGE(PG8_SB(1, 0), cB + kstep, voffB); PG8_STAGE(PG8_SA(1, 0), cA + kstep, voffA); PG8_STAGE(PG8_SB(1, 1), cB + hstep + kstep, voffB);
        PG8_WAIT_V(6); PG8_BAR;
    } else {
        PG8_STAGE(PG8_SB(0, 0), cB, voffB); PG8_STAGE(PG8_SA(0, 0), cA, voffA); PG8_STAGE(PG8_SB(0, 1), cB + hstep, voffB); PG8_STAGE(PG8_SA(0, 1), cA + hstep, voffA);
        if (wr == 1) PG8_BAR;
        PG8_WAIT_V(4); PG8_BAR;
        PG8_STAGE(PG8_SB(1, 0), cB + kstep, voffB); PG8_STAGE(PG8_SA(1, 0), cA + kstep, voffA); PG8_STAGE(PG8_SB(1, 1), cB + hstep + kstep, voffB);
        PG8_WAIT_V(6); PG8_BAR;
    }
    for (;;) {
        const bool has_next = S.next(ui + 1, nxt);
        const char* nA = has_next ? (const char*)g.A + (size_t)nxt.pm * tstep : cA; const char* nB = has_next ? (const char*)g.Bt + (size_t)nxt.pn * tstep : cB;
        for (int t = 0; t < nt; t += 2) {
            const bool last = (t == nt - 2);
            const char* a1 = cA + (size_t)(t + 1) * kstep;
            const char* a2 = last ? nA : cA + (size_t)(t + 2) * kstep; const char* b2 = last ? nB : cB + (size_t)(t + 2) * kstep;
            const char* a3 = a2 + kstep; const char* b3 = b2 + kstep;
            if (last && has_next) S.a_ready(nxt);
            if constexpr (SP2) {
            PG8_LDB(B0, 0, 0); PG8_LDB(B1, 0, 1); PG8_SCHED; PG8_LDA(At, 0, 0); PG8_STAGE(PG8_SA(1, 1), a1 + hstep, voffA);
            PG8_WAIT_V(8); PG8_WAIT_L(0); PG8_BAR; PG8_MMA(0, 0, At, B0); PG8_MMA(0, 1, At, B1); PG8_BAR; PG8_SCHED;
            PG8_LDA(At, 0, 1); PG8_STAGE(PG8_SB(0, 0), b2, voffB); PG8_STAGE(PG8_SB(0, 1), b2 + hstep, voffB); PG8_STAGE(PG8_SA(0, 0), a2, voffA);
            PG8_WAIT_V(8); PG8_WAIT_L(0); PG8_BAR; PG8_MMA(1, 0, At, B0); PG8_MMA(1, 1, At, B1); PG8_BAR; PG8_SCHED;
            PG8_LDB(B0, 1, 0); PG8_LDB(B1, 1, 1); PG8_SCHED; PG8_LDA(At, 1, 0); PG8_STAGE(PG8_SA(0, 1), a2 + hstep, voffA);
            PG8_WAIT_V(8); PG8_WAIT_L(0); PG8_BAR; PG8_MMA(0, 0, At, B0); PG8_MMA(0, 1, At, B1); PG8_BAR; PG8_SCHED;
            PG8_LDA(At, 1, 1); PG8_STAGE(PG8_SB(1, 0), b3, voffB); PG8_STAGE(PG8_SB(1, 1), b3 + hstep, voffB); PG8_STAGE(PG8_SA(1, 0), a3, voffA);
            PG8_WAIT_V(8); PG8_WAIT_L(0); PG8_BAR; PG8_MMA(1, 0, At, B0); PG8_MMA(1, 1, At, B1); PG8_BAR; PG8_SCHED;
            } else {
            PG8_LDB(B0, 0, 0); PG8_SCHED; PG8_LDA(At, 0, 0); PG8_STAGE(PG8_SA(1, 1), a1 + hstep, voffA);
            PG8_WAIT_L(8); PG8_BAR; PG8_WAIT_L(0); PG8_MMA(0, 0, At, B0); PG8_BAR; PG8_SCHED;
            PG8_LDB(B1, 0, 1); PG8_STAGE(PG8_SB(0, 0), b2, voffB);
            PG8_BAR; PG8_WAIT_L(0); PG8_MMA(0, 1, At, B1); PG8_BAR;
            PG8_LDA(At, 0, 1); PG8_STAGE(PG8_SA(0, 0), a2, voffA);
            PG8_BAR; PG8_WAIT_L(0); PG8_MMA(1, 0, At, B0); PG8_BAR; PG8_SCHED;
            PG8_STAGE(PG8_SB(0, 1), b2 + hstep, voffB);
            PG8_WAIT_V(6); PG8_BAR; PG8_MMA(1, 1, At, B1); PG8_BAR;
            PG8_LDB(B0, 1, 0); PG8_SCHED; PG8_LDA(At, 1, 0); PG8_STAGE(PG8_SA(0, 1), a2 + hstep, voffA);
            PG8_WAIT_L(8); PG8_BAR; PG8_WAIT_L(0); PG8_MMA(0, 0, At, B0); PG8_BAR; PG8_SCHED;
            PG8_LDB(B1, 1, 1); PG8_STAGE(PG8_SB(1, 0), b3, voffB);
            PG8_BAR; PG8_WAIT_L(0); PG8_MMA(0, 1, At, B1); PG8_BAR;
            PG8_LDA(At, 1, 1); PG8_STAGE(PG8_SA(1, 0), a3, voffA);
            PG8_BAR; PG8_WAIT_L(0); PG8_MMA(1, 0, At, B0); PG8_BAR; PG8_SCHED;
            PG8_STAGE(PG8_SB(1, 1), b3 + hstep, voffB);
            PG8_WAIT_V(6); PG8_BAR; PG8_MMA(1, 1, At, B1); PG8_BAR;
            }
        }
        if constexpr (ALIGN_EPI) { if (wr == 0) PG8_BAR; }
        if constexpr (!Epi::AFTER_DRAIN) { E(acc, cur, wr, wc, fr, fq); S.done(cur); }
        if (!has_next) break;
#pragma unroll
        for (int a = 0; a < 2; ++a)
#pragma unroll
            for (int b = 0; b < 2; ++b)
#pragma unroll
                for (int m = 0; m < 4; ++m)
#pragma unroll
                    for (int n = 0; n < 2; ++n) acc[a][b][m][n] = (f32x4){0.f, 0.f, 0.f, 0.f};
        cur = nxt; cA = nA; cB = nB; ++ui;
        if constexpr (ALIGN_EPI) { if (wr == 1) PG8_BAR; }
    }
    PG8_WAIT_V(0);
    if constexpr (!ALIGN_EPI) { if (wr == 0) PG8_BAR; }
    PG8_BAR;
    if constexpr (Epi::AFTER_DRAIN) { E.fused(acc, cur, wr, wc, fr, fq, lds, wid, lane); S.done(cur); }
#undef PG8_SA
#undef PG8_SB
#undef PG8_STAGE
#undef PG8_LDA
#undef PG8_LDB
#undef PG8_MMA
#undef PG8_WAIT_V
#undef PG8_WAIT_L
#undef PG8_BAR
#undef PG8_SCHED
}
}
#define GAS __attribute__((address_space(1)))
#define LAS __attribute__((address_space(3)))
typedef unsigned short bf16;
typedef unsigned v4u __attribute__((ext_vector_type(4)));
typedef float f32x4 __attribute__((ext_vector_type(4)));
typedef short bf16x8 __attribute__((ext_vector_type(8)));
typedef GAS unsigned gu32;
typedef GAS unsigned long long gu64;
#define RLX_AGENT __ATOMIC_RELAXED, __HIP_MEMORY_SCOPE_AGENT
#define LDS_WAIT() asm volatile("s_waitcnt lgkmcnt(0)" ::: "memory")
#define VM_WAIT() asm volatile("s_waitcnt vmcnt(0)" ::: "memory")
__device__ __forceinline__ unsigned long long rt() { return __builtin_amdgcn_s_memrealtime(); }
__device__ __forceinline__ unsigned f2bf(float f) { unsigned u = __builtin_bit_cast(unsigned, f); return (u + 0x7fffu + ((u >> 16) & 1u)) >> 16; }
__device__ __forceinline__ unsigned pk2(float lo, float hi) { return f2bf(lo) | (f2bf(hi) << 16); }

#define XB_TMO      128
#define XB_XCNT(j)  (256  + 64 * (j))
#define XB_XSUB(j)  (1280 + 64 * (j))
#define XB_XGEN(j)  (2304 + 64 * (j))
#define XB_TOP      3328
#define XB_TOPGEN   3392
#define XCD_BAR_WORDS 3456
#define XB_SPIN_CAP (1u << 18)

__device__ __forceinline__ unsigned xb_ld(unsigned* p)              { return __hip_atomic_load(p, __ATOMIC_RELAXED, __HIP_MEMORY_SCOPE_AGENT); }
__device__ __forceinline__ unsigned xb_add(unsigned* p, unsigned v) { return __hip_atomic_fetch_add(p, v, __ATOMIC_RELAXED, __HIP_MEMORY_SCOPE_AGENT); }
__device__ __forceinline__ unsigned xb_xcc_id() { return (unsigned)__builtin_amdgcn_s_getreg((3 << 11) | 20) & 0xFu; }
#define XB_SPIN(cond, bar) do { unsigned _sp = 0; while (cond) { __builtin_amdgcn_s_sleep(1); \
    if ((++_sp & 255u) == 0u) { if (xb_ld(&(bar)[XB_TMO])) break; if (_sp > XB_SPIN_CAP) { atomicAdd(&(bar)[XB_TMO], 1u); break; } } } } while (0)

struct XcdBarrier {
    unsigned* bar; unsigned x;
    volatile LAS unsigned* st;
};

__device__ __forceinline__ XcdBarrier xcd_barrier_post(unsigned* bar, volatile LAS unsigned* st) {
    XcdBarrier b; b.bar = bar; b.x = xb_xcc_id(); b.st = st;
    if (threadIdx.x == 0) (void)xb_add(&bar[XB_XCNT(b.x)], 1u);
    return b;
}
__device__ __forceinline__ void xcd_barrier_complete(unsigned* bar, unsigned x, unsigned& nloc, unsigned& nx) {
    const unsigned G = gridDim.x * gridDim.y * gridDim.z;
    unsigned sum, cnt, mine, sp = 0u;
    for (;;) {
        sum = 0u; cnt = 0u; mine = 0u;
#pragma unroll
        for (unsigned j = 0; j < 16; ++j) { const unsigned c = xb_ld(&bar[XB_XCNT(j)]); sum += c; cnt += (c > 0u) ? 1u : 0u; mine = (j == x) ? c : mine; }
        if (sum == G) break;
        __builtin_amdgcn_s_sleep(1);
        if ((++sp & 255u) == 0u) { if (xb_ld(&bar[XB_TMO])) break; if (sp > XB_SPIN_CAP) { atomicAdd(&bar[XB_TMO], 1u); break; } }
    }
    nloc = mine > 0u ? mine : 1u; nx = cnt > 0u ? cnt : 1u;
}

__device__ __forceinline__ void xcd_barrier(const XcdBarrier& b) {
    asm volatile("s_waitcnt vmcnt(0)" ::: "memory");
    __syncthreads();
    if (threadIdx.x == 0) {
        unsigned* bar = b.bar;
        __builtin_amdgcn_s_waitcnt(0);
        unsigned nloc = b.st[0], nx = b.st[1];
        if (nloc == 0u) { xcd_barrier_complete(bar, b.x, nloc, nx); b.st[0] = nloc; b.st[1] = nx; }
        const unsigned old = xb_add(&bar[XB_XSUB(b.x)], 1u);
        const unsigned gen = old / nloc;
        if (old + 1u == (gen + 1u) * nloc) {
            __builtin_amdgcn_fence(__ATOMIC_RELEASE, "agent");
            asm volatile("s_waitcnt vmcnt(0)" ::: "memory");
            const unsigned og = xb_add(&bar[XB_TOP], 1u);
            const unsigned tg = og / nx;
            if (og + 1u == (tg + 1u) * nx) xb_add(&bar[XB_TOPGEN], 1u);
            else XB_SPIN(xb_ld(&bar[XB_TOPGEN]) == tg, bar);
            __builtin_amdgcn_fence(__ATOMIC_ACQUIRE, "agent");
            xb_add(&bar[XB_XGEN(b.x)], 1u);
            asm volatile("s_waitcnt vmcnt(0)" ::: "memory");
        } else {
            XB_SPIN(xb_ld(&bar[XB_XGEN(b.x)]) == gen, bar);
            __builtin_amdgcn_fence(__ATOMIC_ACQUIRE, "agent");
            asm volatile("s_waitcnt vmcnt(0)" ::: "memory");
        }
    }
    __syncthreads();
}

constexpr int DM = 2048, NBATCH = 2, SEQ = 4096, DEPTH = 4, CTXL = 256;
constexpr int NH = 4, HK = 256, HV = 512, RANK = 16;
constexpr int DPOOL = 1024, DFF = 5632, NMODV = 6 * DM;
constexpr int MLAT = NBATCH * SEQ, MCTX = NBATCH * CTXL, MTOT = MLAT + MCTX;
constexpr int NPROJ = 11520, NPROJ_SRC = 11296, NFFI = 2 * DFF;
constexpr int CQ = 0, CK = 1024, CV = 2048, CG = 4096, CP = 6144, CBG = 7168, CBP = 9216, CA = 11264;
constexpr float ALPHA = 1.6817928305074290f;
constexpr float LN_EPS = 1e-5f, RMS_EPS = 1e-6f;
constexpr int NWAVES = 8, NTHREADS = 512;
constexpr int LDS_BYTES = 163840;
constexpr int RING_BYTES = 131072, MISC_OFF = LDS_BYTES - 256;

constexpr size_t al256(size_t x) { return (x + 255) & ~(size_t)255; }
constexpr size_t WS_CTL = 0, CTL_BYTES = 1u << 20;
constexpr size_t SZ_MODP = (size_t)DEPTH * 8 * 3 * NMODV * 4, SZ_MOD = (size_t)DEPTH * 3 * NMODV * 4;
constexpr size_t WS_MODP = WS_CTL + CTL_BYTES, WS_MOD = al256(WS_MODP + SZ_MODP), WS_W = al256(WS_MOD + SZ_MOD);
constexpr size_t WO_IN = 0, SZ_IN = (size_t)NPROJ * DM * 2;
constexpr size_t WO_GO = WO_IN + SZ_IN, SZ_GO = (size_t)DM * DM * 2;
constexpr size_t WO_PG = WO_GO + SZ_GO, SZ_PG = (size_t)1024 * 1024 * 2;
constexpr size_t WO_PO = WO_PG + SZ_PG, SZ_PO = (size_t)DM * 1024 * 2;
constexpr size_t WO_OUT = WO_PO + SZ_PO, SZ_OUT = (size_t)DM * DM * 2;
constexpr size_t WO_FI = WO_OUT + SZ_OUT, SZ_FI = (size_t)NFFI * DM * 2;
constexpr size_t WO_FO = WO_FI + SZ_FI, SZ_FO = (size_t)DM * DFF * 2;
constexpr size_t WO_PC = WO_FO + SZ_FO;
constexpr size_t W_LAYER = WO_PC + SZ_PO;
constexpr size_t WS_X = al256(WS_W + DEPTH * W_LAYER), SZ_X = (size_t)MTOT * DM * 4;
constexpr size_t WS_V = WS_X + SZ_X;
constexpr size_t WS_H = WS_V + SZ_X, SZ_H = (size_t)MTOT * DM * 2;
constexpr size_t WS_PROJ = WS_H + SZ_H, SZ_PROJ = (size_t)MTOT * NPROJ * 2;
constexpr size_t WS_ACT = WS_PROJ;
constexpr int NCG = MTOT / 64;
constexpr size_t WS_LA = WS_PROJ + SZ_PROJ, SZ_LA = (size_t)2 * MTOT * 1024 * 4;
constexpr size_t WS_QI = WS_LA, SZ_QI = (size_t)2 * MTOT * 1024 * 2;
constexpr size_t WS_KST = WS_QI + SZ_QI, SZ_KST = (size_t)2 * NCG * 4 * 256 * 64 * 2;
constexpr size_t WS_PM = WS_KST + SZ_KST, SZ_PM = (size_t)2 * NCG * 4 * 64 * 64 * 2;
constexpr size_t WS_DCB = WS_PM + SZ_PM, SZ_DCB = (size_t)2 * NCG * 4 * 256 * 4;
constexpr size_t WS_VT = WS_DCB + SZ_DCB, SZ_VT = (size_t)NCG * 4 * 512 * 64 * 2;
constexpr size_t WS_GLAEND = WS_VT + SZ_VT;
static_assert(WS_GLAEND >= WS_LA + SZ_LA, "overlay");
constexpr size_t WS_O = WS_GLAEND, SZ_O = (size_t)MTOT * DM * 4;
constexpr size_t WS_AGLA = WS_O + 2 * SZ_O;
constexpr size_t WS_HM = WS_AGLA + SZ_H, SZ_HM = (size_t)MTOT * 1024 * 4;
constexpr size_t WS_T = WS_HM + SZ_HM, SZ_T = (size_t)MTOT * 1024 * 2;
constexpr size_t WS_U = WS_T + SZ_T;
constexpr size_t WS_TEMP = WS_U + SZ_T;
constexpr size_t WS_MRG = WS_TEMP + SZ_X;
constexpr size_t WS_END = WS_MRG + SZ_H;

struct Params {
    const float *x, *c, *ctx, *c_ctx, *w_ada, *b_ada, *w_in, *w_dup, *b_dup, *gla_gain, *w_pg, *pool_scale, *w_go, *w_po, *w_out, *ln1g, *ln1b, *w_fi, *w_fo, *ln2g, *ln2b;
    float* out; unsigned char* ws; int layer; int pad;
};
typedef float f32x2g __attribute__((ext_vector_type(2)));
typedef unsigned u32x2g __attribute__((ext_vector_type(2)));
struct Frame { LAS unsigned char* lds; int tid, lane, wave, vcu, G, gw, NGW; };

__device__ __forceinline__ bf16* wlayer(const Params& p, int l, size_t off) { return (bf16*)(p.ws + WS_W + (size_t)l * W_LAYER + off); }
__device__ __forceinline__ const float* modv(const Params& p, int l, int mi, int which) { return (const float*)(p.ws + WS_MOD) + ((size_t)l * 3 + mi) * NMODV + (size_t)which * DM; }
__device__ __forceinline__ float bf2f(unsigned short b) { return __builtin_bit_cast(float, (unsigned)b << 16); }
__device__ __forceinline__ float bflo(unsigned w) { return __builtin_bit_cast(float, w << 16); }
__device__ __forceinline__ float bfhi(unsigned w) { return __builtin_bit_cast(float, w & 0xffff0000u); }
__device__ __forceinline__ float fast_sigmoid(float x) { return __builtin_amdgcn_rcpf(1.0f + __expf(-x)); }
__device__ __forceinline__ float wave_sum(float v) {
#pragma unroll
    for (int o = 1; o < 64; o <<= 1) v += __shfl_xor(v, o);
    return v;
}
__device__ __forceinline__ int mod_index(int row) { return row < SEQ ? 0 : (row < MLAT ? 1 : 2); }

struct EpiProj {
    static constexpr bool PERM = true, AFTER_DRAIN = false;
    bf16* O;
    __device__ __forceinline__ void operator()(const pg8::f32x4 (&acc)[2][2][4][2], const pg8::Unit& u, int wr, int wc, int fr, int fq) const {
        const int row0 = u.pm * 256 + wr * 64 + fr, col0 = u.pn * 256 + wc * 32 + 8 * fq;
        const int mode = (u.pn >= 16 && u.pn < 24) ? 1 : ((u.pn >= 28 && u.pn < 44) ? 2 : 0);
#pragma unroll
        for (int ai = 0; ai < 2; ++ai)
#pragma unroll
            for (int m = 0; m < 4; ++m) { bf16* rowp = O + (size_t)(row0 + ai * 128 + m * 16) * NPROJ + col0;
#pragma unroll
                for (int bj = 0; bj < 2; ++bj) { pg8::f32x4 v0 = acc[ai][bj][m][0], v1 = acc[ai][bj][m][1];
                    if (mode != 0) {
#pragma unroll
                        for (int j = 0; j < 4; ++j) { const float s0 = fast_sigmoid(v0[j]), s1 = fast_sigmoid(v1[j]); v0[j] = (mode == 1) ? v0[j] * s0 : s0; v1[j] = (mode == 1) ? v1[j] * s1 : s1; } }
                    pg8::u32x4 w; w.x = pg8::cvt_pk_bf16(v0[0], v0[1]); w.y = pg8::cvt_pk_bf16(v0[2], v0[3]); w.z = pg8::cvt_pk_bf16(v1[0], v1[1]); w.w = pg8::cvt_pk_bf16(v1[2], v1[3]);
                    *(pg8::u32x4*)(rowp + bj * 128) = w; } }
    }
};
struct EpiBf16Plain {
    static constexpr bool PERM = true, AFTER_DRAIN = false;
    bf16* O; int ldc;
    __device__ __forceinline__ void operator()(const pg8::f32x4 (&acc)[2][2][4][2], const pg8::Unit& u, int wr, int wc, int fr, int fq) const {
        const int row0 = u.pm * 256 + wr * 64 + fr, col0 = u.pn * 256 + wc * 32 + 8 * fq;
#pragma unroll
        for (int ai = 0; ai < 2; ++ai)
#pragma unroll
            for (int m = 0; m < 4; ++m) { bf16* rowp = O + (size_t)(row0 + ai * 128 + m * 16) * ldc + col0;
#pragma unroll
                for (int bj = 0; bj < 2; ++bj) { const pg8::f32x4 v0 = acc[ai][bj][m][0], v1 = acc[ai][bj][m][1];
                    pg8::u32x4 w; w.x = pg8::cvt_pk_bf16(v0[0], v0[1]); w.y = pg8::cvt_pk_bf16(v0[2], v0[3]); w.z = pg8::cvt_pk_bf16(v1[0], v1[1]); w.w = pg8::cvt_pk_bf16(v1[2], v1[3]);
                    *(pg8::u32x4*)(rowp + bj * 128) = w; } }
    }
};
struct EpiGateTemp {
    static constexpr bool PERM = true, AFTER_DRAIN = false;
    float* T; const bf16* PROJ;
    __device__ __forceinline__ void operator()(const pg8::f32x4 (&acc)[2][2][4][2], const pg8::Unit& u, int wr, int wc, int fr, int fq) const {
        const int row0 = u.pm * 256 + wr * 64 + fr, col0 = u.pn * 256 + wc * 32 + 8 * fq;
#pragma unroll
        for (int ai = 0; ai < 2; ++ai)
#pragma unroll
            for (int m = 0; m < 4; ++m) { const int row = row0 + ai * 128 + m * 16;
#pragma unroll
                for (int bj = 0; bj < 2; ++bj) { const int c = col0 + bj * 128;
                    const pg8::u32x4 gw = *(const pg8::u32x4*)(PROJ + (size_t)row * NPROJ + CBP + c);
                    pg8::f32x4 v0 = acc[ai][bj][m][0], v1 = acc[ai][bj][m][1];
                    v0[0] *= bflo(gw.x); v0[1] *= bfhi(gw.x); v0[2] *= bflo(gw.y); v0[3] *= bfhi(gw.y);
                    v1[0] *= bflo(gw.z); v1[1] *= bfhi(gw.z); v1[2] *= bflo(gw.w); v1[3] *= bfhi(gw.w);
                    float* tp = T + (size_t)row * DM + c; *(pg8::f32x4*)tp = v0; *(pg8::f32x4*)(tp + 4) = v1; } }
    }
    __device__ __forceinline__ void small(int row, int col, pg8::f32x4 v) const {
        const u32x2g gw = *(const u32x2g*)(PROJ + (size_t)row * NPROJ + CBP + col);
        v[0] *= bflo(gw.x); v[1] *= bfhi(gw.x); v[2] *= bflo(gw.y); v[3] *= bfhi(gw.y); *(pg8::f32x4*)(T + (size_t)row * DM + col) = v; }
};
struct EpiMerge {
    static constexpr bool PERM = true, AFTER_DRAIN = false;
    bf16* O; const float* T; const bf16* PROJ;
    __device__ __forceinline__ void operator()(const pg8::f32x4 (&acc)[2][2][4][2], const pg8::Unit& u, int wr, int wc, int fr, int fq) const {
        const int row0 = u.pm * 256 + wr * 64 + fr, col0 = u.pn * 256 + wc * 32 + 8 * fq;
#pragma unroll
        for (int ai = 0; ai < 2; ++ai)
#pragma unroll
            for (int m = 0; m < 4; ++m) { const int row = row0 + ai * 128 + m * 16;
#pragma unroll
                for (int bj = 0; bj < 2; ++bj) { const int c = col0 + bj * 128;
                    const pg8::u32x4 gw = *(const pg8::u32x4*)(PROJ + (size_t)row * NPROJ + CBG + c);
                    const float* tp = T + (size_t)row * DM + c; const pg8::f32x4 t0 = *(const pg8::f32x4*)tp, t1 = *(const pg8::f32x4*)(tp + 4);
                    pg8::f32x4 v0 = acc[ai][bj][m][0], v1 = acc[ai][bj][m][1];
                    v0[0] = v0[0] * bflo(gw.x) + t0[0]; v0[1] = v0[1] * bfhi(gw.x) + t0[1]; v0[2] = v0[2] * bflo(gw.y) + t0[2]; v0[3] = v0[3] * bfhi(gw.y) + t0[3];
                    v1[0] = v1[0] * bflo(gw.z) + t1[0]; v1[1] = v1[1] * bfhi(gw.z) + t1[1]; v1[2] = v1[2] * bflo(gw.w) + t1[2]; v1[3] = v1[3] * bfhi(gw.w) + t1[3];
                    pg8::u32x4 w; w.x = pg8::cvt_pk_bf16(v0[0], v0[1]); w.y = pg8::cvt_pk_bf16(v0[2], v0[3]); w.z = pg8::cvt_pk_bf16(v1[0], v1[1]); w.w = pg8::cvt_pk_bf16(v1[2], v1[3]);
                    *(pg8::u32x4*)(O + (size_t)row * DM + c) = w; } }
    }
    __device__ __forceinline__ void small(int row, int col, pg8::f32x4 v) const {
        const u32x2g gw = *(const u32x2g*)(PROJ + (size_t)row * NPROJ + CBG + col); const pg8::f32x4 t = *(const pg8::f32x4*)(T + (size_t)row * DM + col);
        v[0] = v[0] * bflo(gw.x) + t[0]; v[1] = v[1] * bfhi(gw.x) + t[1]; v[2] = v[2] * bflo(gw.y) + t[2]; v[3] = v[3] * bfhi(gw.y) + t[3];
        *(u32x2g*)(O + (size_t)row * DM + col) = (u32x2g){pg8::cvt_pk_bf16(v[0], v[1]), pg8::cvt_pk_bf16(v[2], v[3])}; }
};
struct EpiResid {
    static constexpr bool PERM = false, AFTER_DRAIN = false;
    float* V; const float* xlat; const float* xctx; const float* gt0;
    __device__ __forceinline__ void operator()(const pg8::f32x4 (&acc)[2][2][4][2], const pg8::Unit& u, int wr, int wc, int fr, int fq) const {
        const int row0 = u.pm * 256 + wr * 64 + fr, col0 = u.pn * 256 + wc * 32 + 4 * fq;
        const int mi = u.pm < 16 ? 0 : (u.pm < 32 ? 1 : 2);
        const float* gt = gt0 + (size_t)mi * NMODV + col0;
        pg8::f32x4 gv[2][2];
#pragma unroll
        for (int bj = 0; bj < 2; ++bj)
#pragma unroll
            for (int n = 0; n < 2; ++n) gv[bj][n] = *(const pg8::f32x4*)(gt + bj * 128 + n * 16);
#pragma unroll
        for (int ai = 0; ai < 2; ++ai)
#pragma unroll
            for (int m = 0; m < 4; ++m) { const int row = row0 + ai * 128 + m * 16;
                const float* xr = (u.pm < 32 ? xlat + (size_t)row * DM : xctx + (size_t)(row - MLAT) * DM) + col0; float* vr = V + (size_t)row * DM + col0;
#pragma unroll
                for (int bj = 0; bj < 2; ++bj)
#pragma unroll
                    for (int n = 0; n < 2; ++n) { const pg8::f32x4 xv = *(const pg8::f32x4*)(xr + bj * 128 + n * 16);
                        *(pg8::f32x4*)(vr + bj * 128 + n * 16) = xv * ALPHA + gv[bj][n] * acc[ai][bj][m][n]; } }
    }
    __device__ __forceinline__ void small(int row, int col, pg8::f32x4 v) const {
        const pg8::f32x4 g = *(const pg8::f32x4*)(gt0 + (size_t)2 * NMODV + col), xv = *(const pg8::f32x4*)(xctx + (size_t)(row - MLAT) * DM + col);
        *(pg8::f32x4*)(V + (size_t)row * DM + col) = xv * ALPHA + g * v; }
};
struct EpiSwiglu {
    static constexpr bool PERM = true, AFTER_DRAIN = false;
    bf16* O;
    __device__ __forceinline__ void operator()(const pg8::f32x4 (&acc)[2][2][4][2], const pg8::Unit& u, int wr, int wc, int fr, int fq) const {
        const int row0 = u.pm * 256 + wr * 64 + fr, col0 = u.pn * 128 + wc * 32 + 8 * fq;
#pragma unroll
        for (int ai = 0; ai < 2; ++ai)
#pragma unroll
            for (int m = 0; m < 4; ++m) { const int row = row0 + ai * 128 + m * 16;
                pg8::f32x4 a0, a1;
#pragma unroll
                for (int j = 0; j < 4; ++j) { const float g0 = acc[ai][0][m][0][j], g1 = acc[ai][0][m][1][j];
                    a0[j] = g0 * fast_sigmoid(g0) * acc[ai][1][m][0][j]; a1[j] = g1 * fast_sigmoid(g1) * acc[ai][1][m][1][j]; }
                pg8::u32x4 w; w.x = pg8::cvt_pk_bf16(a0[0], a0[1]); w.y = pg8::cvt_pk_bf16(a0[2], a0[3]); w.z = pg8::cvt_pk_bf16(a1[0], a1[1]); w.w = pg8::cvt_pk_bf16(a1[2], a1[3]);
                *(pg8::u32x4*)(O + (size_t)row * DFF + col0) = w; }
    }
};

template <class Epi> __device__ __forceinline__ void small_gemm_ctx(const Frame& F, const bf16* A, const bf16* Bt, int K, const Epi& E) {
    const int c = (int)blockIdx.x; if (c >= 256) return;
    const int rb = MLAT + 64 * (c >> 5), cb = 64 * (c & 31);
    const int fr = F.lane & 15, fq = F.lane >> 4, kw = K >> 3;
    f32x4 acc[4][4];
#pragma unroll
    for (int m = 0; m < 4; ++m)
#pragma unroll
        for (int n = 0; n < 4; ++n) acc[m][n] = (f32x4){0.f, 0.f, 0.f, 0.f};
    const bf16* ap = A + (size_t)(rb + fr) * K + F.wave * kw + 8 * fq; const bf16* bp = Bt + (size_t)(cb + fr) * K + F.wave * kw + 8 * fq;
#define SG_LOAD(a, b, ks) do { _Pragma("unroll") for (int m = 0; m < 4; ++m) { a[m] = *(const GAS bf16x8*)(ap + (size_t)m * 16 * K + (ks)); b[m] = *(const GAS bf16x8*)(bp + (size_t)m * 16 * K + (ks)); } } while (0)
#define SG_MMA(a, b) do { _Pragma("unroll") for (int m = 0; m < 4; ++m) _Pragma("unroll") for (int n = 0; n < 4; ++n) acc[m][n] = __builtin_amdgcn_mfma_f32_16x16x32_bf16(a[m], b[n], acc[m][n], 0, 0, 0); } while (0)
    bf16x8 ax[4], bx[4], ay[4], by[4];
    SG_LOAD(ax, bx, 0);
    for (int ks = 0; ks < kw; ks += 64) {
        SG_LOAD(ay, by, ks + 32); asm volatile("" ::: "memory");
        SG_MMA(ax, bx);
        const int kn = (ks + 64 < kw) ? ks + 64 : ks;
        SG_LOAD(ax, bx, kn); asm volatile("" ::: "memory");
        SG_MMA(ay, by);
    }
#undef SG_LOAD
#undef SG_MMA
    LAS float* part = (LAS float*)F.lds + F.wave * 4096;
#pragma unroll
    for (int m = 0; m < 4; ++m)
#pragma unroll
        for (int n = 0; n < 4; ++n)
#pragma unroll
            for (int reg = 0; reg < 4; ++reg) part[(16 * m + 4 * fq + reg) * 64 + 16 * n + fr] = acc[m][n][reg];
    __syncthreads();
#pragma unroll
    for (int q = 0; q < 2; ++q) { const int idx = F.tid * 2 + q, row = idx >> 4, col = (idx & 15) * 4; f32x4 s = {0.f, 0.f, 0.f, 0.f};
#pragma unroll
        for (int w = 0; w < 8; ++w) s += *(const LAS f32x4*)((LAS float*)F.lds + w * 4096 + row * 64 + col);
        E.small(rb + row, cb + col, s); }
    __syncthreads();
}
__device__ __forceinline__ void transpose_item(const float* W, int N, int k0, int n0, bf16* WT, int ldk, int drow0, float colscale, const float* rowscale, LAS float* scr, int lane) {
    float tv[32];
#pragma unroll
    for (int i = 0; i < 32; ++i) { const int kk = 2 * i + (lane >> 5); tv[i] = W[(size_t)(k0 + kk) * N + n0 + (lane & 31)]; }
    if (rowscale) {
#pragma unroll
        for (int i = 0; i < 32; ++i) tv[i] *= rowscale[k0 + 2 * i + (lane >> 5)]; }
#pragma unroll
    for (int i = 0; i < 32; ++i) { const int kk = 2 * i + (lane >> 5); scr[kk * 33 + (lane & 31)] = tv[i] * colscale; }
    LDS_WAIT(); asm volatile("" ::: "memory");
    const int c = lane & 7;
#pragma unroll
    for (int j = 0; j < 4; ++j) { const int n = (lane >> 3) + 8 * j; const LAS float* s = scr + (8 * c) * 33 + n;
        v4u o; o.x = pk2(s[0 * 33], s[1 * 33]); o.y = pk2(s[2 * 33], s[3 * 33]); o.z = pk2(s[4 * 33], s[5 * 33]); o.w = pk2(s[6 * 33], s[7 * 33]);
        *(GAS v4u*)(WT + (size_t)(drow0 + n) * ldk + k0 + 8 * c) = o; }
    LDS_WAIT(); asm volatile("" ::: "memory");
}
constexpr int IT_IN = 32 * (NPROJ_SRC / 32), IT_GO = 32 * 64, IT_PO = 16 * 64, IT_OUT = 32 * 64, IT_FI = 32 * (NFFI / 32), IT_FO = (DFF / 64) * 64, IT_PG = 1024, IT_ZIN = 224, IT_ZPG = 1024;
constexpr int IT_LAYER = IT_IN + IT_GO + IT_PO + IT_OUT + IT_FI + IT_FO + IT_PG + IT_ZIN + IT_ZPG;
constexpr int IT_MOD = DEPTH * 48 * 8;
__device__ __forceinline__ void phase_prologue_a(const Frame& F, const Params& p) {
    LAS float* scr = (LAS float*)(F.lds + F.wave * 16384);
    for (int it = F.gw; it < IT_MOD; it += F.NGW) {
        const int l = it / 384, r = it % 384, nb = r / 8, kb = r % 8, k0 = 256 * kb, n0 = 256 * nb + 4 * F.lane;
#pragma unroll
        for (int j = 0; j < 4; ++j) { const int k = k0 + F.lane + 64 * j;
            const float c0 = p.c[k], c1 = p.c[DM + k], c2 = p.c_ctx[k];
            scr[(F.lane + 64 * j) * 3 + 0] = c0 / (1.0f + expf(-c0)); scr[(F.lane + 64 * j) * 3 + 1] = c1 / (1.0f + expf(-c1)); scr[(F.lane + 64 * j) * 3 + 2] = c2 / (1.0f + expf(-c2)); }
        LDS_WAIT(); asm volatile("" ::: "memory");
        f32x4 a0 = {0.f, 0.f, 0.f, 0.f}, a1 = a0, a2 = a0;
        const float* wp = p.w_ada + ((size_t)l * DM + k0) * NMODV + n0;
#pragma unroll 16
        for (int kk = 0; kk < 256; ++kk) { const f32x4 w = *(const GAS f32x4*)(wp + (size_t)kk * NMODV); const float s0 = scr[kk * 3], s1 = scr[kk * 3 + 1], s2 = scr[kk * 3 + 2];
            a0 += w * s0; a1 += w * s1; a2 += w * s2; }
        float* mp = (float*)(p.ws + WS_MODP) + ((size_t)(l * 8 + kb) * 3) * NMODV + n0;
        *(GAS f32x4*)(mp) = a0; *(GAS f32x4*)(mp + NMODV) = a1; *(GAS f32x4*)(mp + 2 * NMODV) = a2;
        LDS_WAIT(); asm volatile("" ::: "memory");
    }
    for (int it = F.gw; it < DEPTH * IT_LAYER; it += F.NGW) {
        const int l = it / IT_LAYER; int r = it % IT_LAYER;
        if (r < IT_IN) { const int nblk = NPROJ_SRC / 32, kb = r / nblk, n0 = 32 * (r % nblk);
            int drow; float cs = 1.0f;
            if (n0 < 6144) { drow = n0; if (n0 < 1024) cs = 0.0625f; } else if (n0 < 6176) drow = CA + (n0 - 6144); else if (n0 < 7200) drow = CP + (n0 - 6176); else drow = CBG + (n0 - 7200);
            transpose_item(p.w_in + (size_t)l * DM * NPROJ_SRC, NPROJ_SRC, 64 * kb, n0, wlayer(p, l, WO_IN), DM, drow, cs, nullptr, scr, F.lane); continue; } r -= IT_IN;
        if (r < IT_GO) { transpose_item(p.w_go + (size_t)l * DM * DM, DM, 64 * (r / 64), 32 * (r % 64), wlayer(p, l, WO_GO), DM, 32 * (r % 64), 1.0f, nullptr, scr, F.lane); continue; } r -= IT_GO;
        if (r < IT_PO) { transpose_item(p.w_po + (size_t)l * DPOOL * DM, DM, 64 * (r / 64), 32 * (r % 64), wlayer(p, l, WO_PO), DPOOL, 32 * (r % 64), 1.0f, p.pool_scale + (size_t)l * DPOOL, scr, F.lane); continue; } r -= IT_PO;
        if (r < IT_OUT) { transpose_item(p.w_out + (size_t)l * DM * DM, DM, 64 * (r / 64), 32 * (r % 64), wlayer(p, l, WO_OUT), DM, 32 * (r % 64), 1.0f, nullptr, scr, F.lane); continue; } r -= IT_OUT;
        if (r < IT_FI) { const int nblk = NFFI / 32, kb = r / nblk, n0 = 32 * (r % nblk), up = n0 >= DFF ? 1 : 0, ch = n0 - up * DFF;
            transpose_item(p.w_fi + (size_t)l * DM * NFFI, NFFI, 64 * kb, n0, wlayer(p, l, WO_FI), DM, 256 * (ch / 128) + 128 * up + (ch % 128), 1.0f, nullptr, scr, F.lane); continue; } r -= IT_FI;
        if (r < IT_FO) { transpose_item(p.w_fo + (size_t)l * DFF * DM, DM, 64 * (r / 64), 32 * (r % 64), wlayer(p, l, WO_FO), DFF, 32 * (r % 64), 1.0f, nullptr, scr, F.lane); continue; } r -= IT_FO;
        if (r < IT_PG) { const int g = r >> 8, i = r & 255;
            const f32x4 v = *(const GAS f32x4*)(p.w_pg + (((size_t)l * 4 + g) * 256 + i) * 256 + 4 * F.lane);
            *(GAS u32x2g*)(wlayer(p, l, WO_PG) + (size_t)(256 * g + i) * 1024 + 256 * g + 4 * F.lane) = (u32x2g){pk2(v.x, v.y), pk2(v.z, v.w)}; continue; } r -= IT_PG;
        if (r < IT_ZIN) { GAS v4u* zp = (GAS v4u*)(wlayer(p, l, WO_IN) + (size_t)(NPROJ_SRC + r) * DM);
#pragma unroll
            for (int j = 0; j < 4; ++j) zp[F.lane + 64 * j] = (v4u){0u, 0u, 0u, 0u};
            continue; } r -= IT_ZIN;
        { GAS v4u* zp = (GAS v4u*)(wlayer(p, l, WO_PG) + (size_t)r * 1024); const int g = r >> 8;
#pragma unroll
          for (int j = 0; j < 2; ++j) { const int ch = F.lane + 64 * j; if ((ch >> 5) != g) zp[ch] = (v4u){0u, 0u, 0u, 0u}; } }
    }
}
__device__ __forceinline__ void phase_prologue_b(const Frame& F, const Params& p) {
    const float* MP = (const float*)(p.ws + WS_MODP); float* MO = (float*)(p.ws + WS_MOD);
    for (int e = F.vcu * NTHREADS + F.tid; e < DEPTH * 3 * NMODV; e += F.G * NTHREADS) { const int l = e / (3 * NMODV), r = e % (3 * NMODV), n = r % NMODV;
        float s = p.b_ada[(size_t)l * NMODV + n];
#pragma unroll
        for (int kb = 0; kb < 8; ++kb) s += MP[((size_t)(l * 8 + kb) * 3) * NMODV + r];
        MO[e] = s; }
    LAS float* sm = (LAS float*)F.lds;
    for (int e = F.tid; e < 3 * 2 * DM; e += NTHREADS) { const int mi = e / (2 * DM), r = e % (2 * DM);
        float s = p.b_ada[r];
#pragma unroll
        for (int kb = 0; kb < 8; ++kb) s += MP[((size_t)kb * 3 + mi) * NMODV + r];
        sm[e] = s; }
    __syncthreads();
    bf16* H = (bf16*)(p.ws + WS_H);
    for (int row = F.gw; row < MTOT; row += F.NGW) { const int mi = mod_index(row);
        const float* xr = row < MLAT ? p.x + (size_t)row * DM : p.ctx + (size_t)(row - MLAT) * DM;
        const LAS float* sh = sm + mi * 2 * DM; const LAS float* sc = sh + DM;
        GAS unsigned long long* o8 = (GAS unsigned long long*)(H + (size_t)row * DM) + F.lane;
#pragma unroll
        for (int j = 0; j < 8; ++j) { const int c = 4 * F.lane + 256 * j; const f32x4 v = *(const GAS f32x4*)(xr + c);
            const float y0 = v.x * (1.0f + sc[c]) + sh[c], y1 = v.y * (1.0f + sc[c + 1]) + sh[c + 1], y2 = v.z * (1.0f + sc[c + 2]) + sh[c + 2], y3 = v.w * (1.0f + sc[c + 3]) + sh[c + 3];
            o8[64 * j] = (unsigned long long)pk2(y0, y1) | ((unsigned long long)pk2(y2, y3) << 32); } }
    __syncthreads();
}
__device__ __forceinline__ void ln_row_finish(const Frame& F, const Params& p, f32x4 (&v)[8], float mean, float rstd, const float* gain, const float* bias, int row, bool last, int lm, int wsh, int wsc) {
    float* X = (float*)(p.ws + WS_X); bf16* H = (bf16*)(p.ws + WS_H);
#pragma unroll
    for (int j = 0; j < 8; ++j) { const int c = 4 * F.lane + 256 * j; const f32x4 g = *(const GAS f32x4*)(gain + c), b = *(const GAS f32x4*)(bias + c); v[j] = (v[j] - mean) * rstd * g + b; }
    if (last) { GAS f32x4* o = (GAS f32x4*)(p.out + (size_t)row * DM) + F.lane;
#pragma unroll
        for (int j = 0; j < 8; ++j) o[64 * j] = v[j];
    } else {
        GAS f32x4* xo = (GAS f32x4*)(X + (size_t)row * DM) + F.lane;
        const int mi = mod_index(row); const float* sh = modv(p, lm, mi, wsh); const float* sc = modv(p, lm, mi, wsc);
        GAS unsigned long long* o8 = (GAS unsigned long long*)(H + (size_t)row * DM) + F.lane;
#pragma unroll
        for (int j = 0; j < 8; ++j) { const int c = 4 * F.lane + 256 * j; xo[64 * j] = v[j];
            const f32x4 a = *(const GAS f32x4*)(sc + c), b = *(const GAS f32x4*)(sh + c); const f32x4 y = v[j] * (a + 1.0f) + b;
            o8[64 * j] = (unsigned long long)pk2(y.x, y.y) | ((unsigned long long)pk2(y.z, y.w) << 32); } }
}
__device__ __forceinline__ void phase_ln(const Frame& F, const Params& p, int l, int sub, int M) {
    const float* V = (const float*)(p.ws + WS_V);
    const float* gain = (sub == 0 ? p.ln1g : p.ln2g) + (size_t)l * DM; const float* bias = (sub == 0 ? p.ln1b : p.ln2b) + (size_t)l * DM;
    const bool last = (sub == 1 && l == DEPTH - 1);
    const int lm = sub == 0 ? l : l + 1, wsh = sub == 0 ? 3 : 0, wsc = sub == 0 ? 4 : 1;
    for (int row = F.gw; row < M; row += 2 * F.NGW) {
        const int row2 = row + F.NGW; const bool two = row2 < M; const int rb = two ? row2 : row;
        const GAS f32x4* va = (const GAS f32x4*)(V + (size_t)row * DM) + F.lane; const GAS f32x4* vb = (const GAS f32x4*)(V + (size_t)rb * DM) + F.lane;
        f32x4 a[8], b[8]; float sa = 0.f, sb = 0.f;
#pragma unroll
        for (int j = 0; j < 8; ++j) { a[j] = va[64 * j]; b[j] = vb[64 * j]; }
#pragma unroll
        for (int j = 0; j < 8; ++j) { sa += (a[j].x + a[j].y) + (a[j].z + a[j].w); sb += (b[j].x + b[j].y) + (b[j].z + b[j].w); }
        const float ma = wave_sum(sa) * (1.f / DM), mb = wave_sum(sb) * (1.f / DM); float qa = 0.f, qb = 0.f;
#pragma unroll
        for (int j = 0; j < 8; ++j) { const f32x4 da = a[j] - ma, db = b[j] - mb; qa += (da.x * da.x + da.y * da.y) + (da.z * da.z + da.w * da.w); qb += (db.x * db.x + db.y * db.y) + (db.z * db.z + db.w * db.w); }
        const float ra = 1.f / sqrtf(wave_sum(qa) * (1.f / DM) + LN_EPS), rb2 = 1.f / sqrtf(wave_sum(qb) * (1.f / DM) + LN_EPS);
        ln_row_finish(F, p, a, ma, ra, gain, bias, row, last, lm, wsh, wsc);
        if (two) ln_row_finish(F, p, b, mb, rb2, gain, bias, row2, last, lm, wsh, wsc);
    }
}
template <int G, int PASS> __device__ __forceinline__ void pool_task(const unsigned char* ws, int base_row, int st, int n, int pos0, int c) {
    constexpr int W = 2 << G, LO = W / 2, HI = W - LO - 1, NIN = 32 + W - 1;
    const bf16* PROJ = (const bf16*)(ws + WS_PROJ); float* HM = (float*)(ws + WS_HM); bf16* T = (bf16*)(ws + WS_T);
    float s0[NIN], s1[NIN];
#pragma unroll
    for (int q = 0; q < NIN; ++q) { const int pos = pos0 - LO + q; const bool ok = pos >= 0 && pos < n; const int row = base_row + (ok ? pos : pos0) * st;
        if (PASS == 0) { const unsigned wv = *(const GAS unsigned*)(PROJ + (size_t)row * NPROJ + CP + c); s0[q] = ok ? bflo(wv) : 0.f; s1[q] = ok ? bfhi(wv) : 0.f; }
        else { const f32x2g hv = *(const GAS f32x2g*)(HM + (size_t)row * DPOOL + c); s0[q] = ok ? hv.x : 0.f; s1[q] = ok ? hv.y : 0.f; } }
#pragma unroll
    for (int q = 1; q < NIN; ++q) { s0[q] += s0[q - 1]; s1[q] += s1[q - 1]; }
#pragma unroll
    for (int i = 0; i < 32; ++i) { const int pos = pos0 + i, row = base_row + pos * st;
        const int cnt = min(pos + HI + 1, n) - max(pos - LO, 0); const float inv = 1.0f / (float)cnt;
        const float m0 = (s0[i + W - 1] - (i > 0 ? s0[i > 0 ? i - 1 : 0] : 0.f)) * inv, m1 = (s1[i + W - 1] - (i > 0 ? s1[i > 0 ? i - 1 : 0] : 0.f)) * inv;
        if (PASS == 0) *(GAS f32x2g*)(HM + (size_t)row * DPOOL + c) = (f32x2g){m0, m1};
        else { const unsigned wv = *(const GAS unsigned*)(PROJ + (size_t)row * NPROJ + CP + c); *(GAS unsigned*)(T + (size_t)row * DPOOL + c) = pk2(m0 - bflo(wv), m1 - bfhi(wv)); } }
}
template <int PASS> __device__ __forceinline__ void pool_dispatch(const unsigned char* ws, int g, int base_row, int st, int n, int pos0, int c) {
    if (g == 0) pool_task<0, PASS>(ws, base_row, st, n, pos0, c); else if (g == 1) pool_task<1, PASS>(ws, base_row, st, n, pos0, c);
    else if (g == 2) pool_task<2, PASS>(ws, base_row, st, n, pos0, c); else pool_task<3, PASS>(ws, base_row, st, n, pos0, c);
}
constexpr int N_POOL_LAT = 128 * 2 * 8, N_POOL_CTX = 2 * 8 * 8, N_POOL_TASKS = N_POOL_LAT + N_POOL_CTX;
template <int PASS> __device__ __forceinline__ void phase_pool(const Frame& F, const Params& p, int wi, int nw) {
    for (int id = wi; id < N_POOL_TASKS; id += nw) {
        if (id < N_POOL_LAT) { const int cb = id & 7, half = (id >> 3) & 1, line = id >> 4, c = cb * 128 + 2 * F.lane;
            if (PASS == 0) pool_dispatch<0>(p.ws, cb >> 1, line * 64, 1, 64, 32 * half, c);
            else pool_dispatch<1>(p.ws, cb >> 1, (line >> 6) * SEQ + (line & 63), 64, 64, 32 * half, c);
        } else { const int id2 = id - N_POOL_LAT, cb = id2 & 7, blk = (id2 >> 3) & 7, b = id2 >> 6, c = cb * 128 + 2 * F.lane;
            if (PASS == 0) pool_dispatch<0>(p.ws, cb >> 1, MLAT + b * CTXL, 1, CTXL, 32 * blk, c);
            else { const bf16* PROJ = (const bf16*)(p.ws + WS_PROJ); const float* HM = (const float*)(p.ws + WS_HM); bf16* T = (bf16*)(p.ws + WS_T);
#pragma unroll 8
                for (int i = 0; i < 32; ++i) { const int row = MLAT + b * CTXL + 32 * blk + i; const f32x2g hv = *(const GAS f32x2g*)(HM + (size_t)row * DPOOL + c);
                    const unsigned wv = *(const GAS unsigned*)(PROJ + (size_t)row * NPROJ + CP + c); *(GAS unsigned*)(T + (size_t)row * DPOOL + c) = pk2(hv.x - bflo(wv), hv.y - bfhi(wv)); } }
        }
    }
}
template <int NO> __device__ __forceinline__ void gout_load(const float* O, int task, int lane, f32x4& o0, f32x4& o1) {
    const int row = task >> 2, c = (task & 3) * HV + 8 * lane;
    o0 = *(const GAS f32x4*)(O + (size_t)row * DM + c); o1 = *(const GAS f32x4*)(O + (size_t)row * DM + c + 4);
    if (NO == 2) { o0 += *(const GAS f32x4*)(O + (size_t)(MTOT + row) * DM + c); o1 += *(const GAS f32x4*)(O + (size_t)(MTOT + row) * DM + c + 4); }
}
__device__ __forceinline__ void gout_finish(const Params& p, const float* gain, int task, int lane, const f32x4& o0, const f32x4& o1) {
    const bf16* PROJ = (const bf16*)(p.ws + WS_PROJ); bf16* A = (bf16*)(p.ws + WS_AGLA);
    const int row = task >> 2, c = (task & 3) * HV + 8 * lane;
    const float ss = wave_sum((o0.x * o0.x + o0.y * o0.y) + (o0.z * o0.z + o0.w * o0.w) + (o1.x * o1.x + o1.y * o1.y) + (o1.z * o1.z + o1.w * o1.w));
    const float r = 1.0f / sqrtf(ss * (1.0f / HV) + RMS_EPS);
    const f32x4 g0 = *(const GAS f32x4*)(gain + c), g1 = *(const GAS f32x4*)(gain + c + 4);
    const v4u gw = *(const GAS v4u*)(PROJ + (size_t)row * NPROJ + CG + c);
    v4u w; w.x = pk2(o0.x * r * g0.x * bflo(gw.x), o0.y * r * g0.y * bfhi(gw.x)); w.y = pk2(o0.z * r * g0.z * bflo(gw.y), o0.w * r * g0.w * bfhi(gw.y));
    w.z = pk2(o1.x * r * g1.x * bflo(gw.z), o1.y * r * g1.y * bfhi(gw.z)); w.w = pk2(o1.z * r * g1.z * bflo(gw.w), o1.w * r * g1.w * bfhi(gw.w));
    *(GAS v4u*)(A + (size_t)row * DM + c) = w;
}
template <int NO> __device__ __forceinline__ void phase_gout(const Frame& F, const Params& p, int l, int M) {
    const float* O = (const float*)(p.ws + WS_O); const float* gain = p.gla_gain + (size_t)l * DM;
    for (int task = F.gw; task < M * NH; task += 2 * F.NGW) { const int task2 = task + F.NGW; const bool two = task2 < M * NH;
        f32x4 a0, a1, b0, b1; gout_load<NO>(O, task, F.lane, a0, a1); gout_load<NO>(O, two ? task2 : task, F.lane, b0, b1);
        gout_finish(p, gain, task, F.lane, a0, a1); if (two) gout_finish(p, gain, task2, F.lane, b0, b1); }
}

typedef float f32x16 __attribute__((ext_vector_type(16)));
__device__ __forceinline__ int swap23(int d) { return (d & ~12) | ((d & 4) << 1) | ((d & 8) >> 1); }
constexpr int PREP_ROW = 528;
constexpr int PREP_QS = 0, PREP_KS = 64 * PREP_ROW, PREP_QT = 2 * 64 * PREP_ROW, PREP_AL = 3 * 64 * PREP_ROW, PREP_TOT = PREP_AL + 4096;
constexpr int N_PREP_A = NCG * 4 * 2, N_PREP_V = NCG * 4;
constexpr int VT_ROW = 1040;

__device__ __forceinline__ float log_sigmoid_fast(float z) { return -__logf(1.0f + __expf(-z)); }
__device__ __forceinline__ void phase_gla_prep(const Frame& F, const Params& p, int l) {
    const bf16* PROJ = (const bf16*)(p.ws + WS_PROJ);
    bf16* QI = (bf16*)(p.ws + WS_QI); bf16* KST = (bf16*)(p.ws + WS_KST); bf16* PM = (bf16*)(p.ws + WS_PM); float* DCB = (float*)(p.ws + WS_DCB); bf16* VT = (bf16*)(p.ws + WS_VT);
    for (int item = F.vcu; item < N_PREP_A + N_PREP_V; item += F.G) {
        if (item < N_PREP_A) {
            const int cg = item >> 3, h = (item >> 1) & 3, dir = item & 1, r0 = cg * 64;
            LAS float* AL = (LAS float*)(F.lds + PREP_AL); LAS float* TOT = (LAS float*)(F.lds + PREP_TOT);
            LAS unsigned short* QS = (LAS unsigned short*)(F.lds + PREP_QS); LAS unsigned short* KS = (LAS unsigned short*)(F.lds + PREP_KS); LAS unsigned short* QT = (LAS unsigned short*)(F.lds + PREP_QT);
#pragma unroll
            for (int k = 0; k < 4; ++k) { const int id = F.tid + NTHREADS * k, row = id >> 5, c = id & 31; const bf16* pr = PROJ + (size_t)(r0 + row) * NPROJ + h * HK + 8 * c;
                *(LAS v4u*)(F.lds + PREP_QS + row * PREP_ROW + 16 * c) = *(const GAS v4u*)(pr + CQ); *(LAS v4u*)(F.lds + PREP_KS + row * PREP_ROW + 16 * c) = *(const GAS v4u*)(pr + CK); }
            { const int j = F.tid >> 3, r2 = (F.tid & 7) * 2; const unsigned w = *(const GAS unsigned*)(PROJ + (size_t)(r0 + j) * NPROJ + CA + dir * 16 + r2); AL[j * 16 + r2] = bflo(w); AL[j * 16 + r2 + 1] = bfhi(w); }
            const int d = F.tid & 255, jh = F.tid >> 8;
            float w[16];
#pragma unroll
            for (int r = 0; r < 16; ++r) w[r] = p.w_dup[(((size_t)l * 2 + dir) * RANK + r) * 1024 + h * HK + d];
            const float bz = p.b_dup[((size_t)l * 2 + dir) * 1024 + h * HK + d];
            __syncthreads();
            float ex[32]; float run = 0.f;
#pragma unroll
            for (int jo = 0; jo < 32; ++jo) { const LAS f32x4* a = (const LAS f32x4*)(AL + (jh * 32 + jo) * 16); float z = bz;
#pragma unroll
                for (int r4 = 0; r4 < 4; ++r4) { const f32x4 av = a[r4]; z += av.x * w[4 * r4] + av.y * w[4 * r4 + 1] + av.z * w[4 * r4 + 2] + av.w * w[4 * r4 + 3]; }
                ex[jo] = run; run += log_sigmoid_fast(z) * 0.0625f; }
            TOT[jh * 256 + d] = run;
            __syncthreads();
            const float t0 = TOT[d], t1 = TOT[256 + d], tot = run;
            const float first = dir ? t1 : t0;
            const float last = t0 + t1;
            const float off = (jh == dir) ? 0.f : first;
            const float Eref = __expf(first), Elr = __expf(last - first);
            const size_t gi = ((size_t)dir * NCG + cg) * 4 + h;
            if (jh == 0) DCB[gi * 256 + d] = __expf(last);
            unsigned kpack[16];
#pragma unroll
            for (int jo = 0; jo < 32; ++jo) { const int j = jh * 32 + jo;
                const float incl = (jo < 31) ? ex[(jo + 1) & 31] : tot;
                const float cum = (dir ? (tot - ex[jo]) : incl) + off;
                const float x = cum - first, e1 = __expf(x), e2 = __expf(-x);
                const float q = bf2f(QS[j * (PREP_ROW / 2) + d]), k = bf2f(KS[j * (PREP_ROW / 2) + d]);
                const float qin = q * e1, kin = k * e2;
                const unsigned qk = pg8::cvt_pk_bf16(qin, kin), qe = pg8::cvt_pk_bf16(qin * Eref, kin * Elr);
                QS[j * (PREP_ROW / 2) + d] = (unsigned short)qk; KS[j * (PREP_ROW / 2) + d] = (unsigned short)(qk >> 16); QT[j * (PREP_ROW / 2) + d] = (unsigned short)qe;
                if (jo & 1) kpack[jo >> 1] |= qe & 0xffff0000u; else kpack[jo >> 1] = qe >> 16; }
            { GAS v4u* kp = (GAS v4u*)(KST + (gi * 256 + d) * 64 + jh * 32);
#pragma unroll
              for (int c = 0; c < 4; ++c) kp[c] = (v4u){kpack[4 * c], kpack[4 * c + 1], kpack[4 * c + 2], kpack[4 * c + 3]}; }
            __syncthreads();
#pragma unroll
            for (int k = 0; k < 4; ++k) { const int id = F.tid + NTHREADS * k, row = id >> 5, c = id & 31;
                *(GAS v4u*)(QI + ((size_t)dir * MTOT + r0 + row) * 1024 + h * HK + 8 * c) = *(const LAS v4u*)(F.lds + PREP_QT + row * PREP_ROW + 16 * c); }
            { const int ti = F.wave >> 1, fr = F.lane & 15, fq = F.lane >> 4;
#pragma unroll
              for (int q2 = 0; q2 < 2; ++q2) { const int tj = (F.wave & 1) * 2 + q2; f32x4 acc = {0.f, 0.f, 0.f, 0.f};
#pragma unroll
                for (int ks = 0; ks < 8; ++ks) { const bf16x8 a = *(const LAS bf16x8*)(F.lds + PREP_KS + (16 * tj + fr) * PREP_ROW + (32 * ks + 8 * fq) * 2);
                    const bf16x8 bq = *(const LAS bf16x8*)(F.lds + PREP_QS + (16 * ti + fr) * PREP_ROW + (32 * ks + 8 * fq) * 2);
                    acc = __builtin_amdgcn_mfma_f32_16x16x32_bf16(a, bq, acc, 0, 0, 0); }
                const int i = 16 * ti + fr, j0 = 16 * tj + 4 * fq; float v[4];
#pragma unroll
                for (int reg = 0; reg < 4; ++reg) { const int j = j0 + reg; const bool keep = dir ? (j >= i) : (j <= i); v[reg] = keep ? acc[reg] : 0.f; }
                *(GAS u32x2g*)(PM + (gi * 64 + i) * 64 + j0) = (u32x2g){pk2(v[0], v[1]), pk2(v[2], v[3])}; } }
            __syncthreads();
        } else {
            const int it = item - N_PREP_A, cg = it >> 2, h = it & 3, r0 = cg * 64;
#pragma unroll
            for (int k = 0; k < 8; ++k) { const int id = F.tid + NTHREADS * k, row = id >> 6, c = id & 63;
                const v4u x = *(const GAS v4u*)(PROJ + (size_t)(r0 + row) * NPROJ + CV + h * HV + 8 * c); *(LAS v4u*)(F.lds + row * VT_ROW + 16 * c) = x; }
            __syncthreads();
#pragma unroll
            for (int k = 0; k < 8; ++k) { const int id = F.tid + NTHREADS * k, v = id & 511, jb = id >> 9; unsigned e[8];
#pragma unroll
                for (int jj = 0; jj < 8; ++jj) e[jj] = *(const LAS unsigned short*)(F.lds + (8 * jb + jj) * VT_ROW + 2 * v);
                *(GAS v4u*)(VT + (((size_t)cg * 4 + h) * 512 + v) * 64 + 8 * jb) = (v4u){e[0] | (e[1] << 16), e[2] | (e[3] << 16), e[4] | (e[5] << 16), e[6] | (e[7] << 16)}; }
            __syncthreads();
        }
    }
}

#define MFMA32(a, b, c) __builtin_amdgcn_mfma_f32_32x32x16_bf16((a), (b), (c), 0, 0, 0)
#define MFMA16(a, b, c) __builtin_amdgcn_mfma_f32_16x16x32_bf16((a), (b), (c), 0, 0, 0)
constexpr int S8_QI = 0, S8_EX = 65536, S8_EXSZ = 13312, S8_KST = S8_EX + 2 * S8_EXSZ, S8_ST = S8_KST + 32768, S8_STSZ = 32 * 528, S8_END = S8_ST + 2 * S8_STSZ;
static_assert(S8_END <= MISC_OFF, "scan LDS map");
__device__ __forceinline__ void glds16(const unsigned char* ws, unsigned off, LAS unsigned char* l) { __builtin_amdgcn_global_load_lds((const unsigned*)(ws + off), (LAS unsigned*)l, 16, 0, 0); }
__device__ __forceinline__ int scan_chunk(int n, int b, int dir) { n = n > 67 ? 67 : n; return n < 4 ? 128 + 4 * b + (dir ? 3 - n : n) : 64 * b + (dir ? 67 - n : n - 4); }
#define SC_WAIT_V(n) asm volatile("s_waitcnt vmcnt(" #n ")" ::: "memory")
#define SC_FENCE() asm volatile("" ::: "memory")

__device__ __forceinline__ void phase_gla_scan(const Frame& F, const Params& p) {
    const int item = F.vcu; if (item >= 256) return;
    const int g16 = item >> 4, vs = item & 15, b = g16 >> 3, h = (g16 >> 1) & 3, dir = g16 & 1;
    const int lane = F.lane, w = F.wave, r = lane & 31, hh = lane >> 5, fr = lane & 15, fq = lane >> 4, ti = w >> 1, tv = w & 1;
    LAS unsigned char* lds = F.lds; const unsigned char* ws = p.ws;
    const unsigned QI0 = (unsigned)(WS_QI + ((size_t)dir * MTOT * 1024 + h * HK) * 2), KST0 = (unsigned)(WS_KST + ((size_t)dir * NCG * 4 + h) * 32768) + (unsigned)w * 4096u;
    const unsigned PM0 = (unsigned)(WS_PM + ((size_t)dir * NCG * 4 + h) * 8192), DC0 = (unsigned)(WS_DCB + ((size_t)dir * NCG * 4 + h) * 1024), VT0 = (unsigned)(WS_VT + ((size_t)h * 512 + vs * 32) * 128);
    const unsigned O0 = (unsigned)(WS_O + ((size_t)dir * MTOT * DM + h * HV + vs * 32) * 4);
    unsigned qoff[4];
#pragma unroll
    for (int j = 0; j < 4; ++j) { const int row = 8 * w + 2 * j + (lane >> 5); qoff[j] = (unsigned)(row * 2048 + 16 * ((lane & 31) ^ (row & 15))); }
    const unsigned koffe = (unsigned)((lane >> 3) * 128 + 16 * ((lane & 7) ^ (lane >> 4))), koffo = (unsigned)((lane >> 3) * 128 + 16 * ((lane & 7) ^ ((lane >> 4) + 4)));
    const unsigned kme = (w & 1) ? koffo : koffe;
    const int x16 = fr, xk = (r >> 1) & 7, xf = (fr >> 1) & 7;
    f32x16 S;
#pragma unroll
    for (int i = 0; i < 16; ++i) S[i] = 0.f;
#define S8_ISSUE_SHARED(cgx, par) do { const unsigned qb_ = QI0 + (unsigned)(cgx) * 131072u; LAS unsigned char* e_ = lds + S8_EX + (par) * S8_EXSZ; \
        _Pragma("unroll") for (int j_ = 0; j_ < 4; ++j_) glds16(ws, qb_ + qoff[j_], lds + S8_QI + (par) * 32768 + (8 * w + 2 * j_) * 512); \
        glds16(ws, PM0 + (unsigned)(cgx) * 32768u + (unsigned)w * 1024u + kme, e_ + w * 1024); \
        if (w < 4) glds16(ws, VT0 + (unsigned)(cgx) * 262144u + (unsigned)w * 1024u + kme, e_ + 8192 + w * 1024); \
        else if (w == 4) glds16(ws, DC0 + (unsigned)(cgx) * 4096u + (unsigned)lane * 16u, e_ + 12288); \
        else glds16(ws, PM0 + (unsigned)(cgx) * 32768u + (unsigned)w * 1024u + kme, e_ + w * 1024); } while (0)
#define S8_ISSUE_KST(cgx) do { const unsigned kb_ = KST0 + (unsigned)(cgx) * 131072u; \
        _Pragma("unroll") for (int j_ = 0; j_ < 4; ++j_) glds16(ws, kb_ + j_ * 1024 + ((j_ & 1) ? koffo : koffe), lds + S8_KST + w * 4096 + j_ * 1024); } while (0)
    int cg = scan_chunk(0, b, dir);
    S8_ISSUE_SHARED(cg, 0); S8_ISSUE_KST(cg);
    for (int n = 0; n < 68; ++n) {
        const int par = n & 1, cgn = scan_chunk(n + 1, b, dir);
        LAS unsigned char* st = lds + S8_ST + par * S8_STSZ; const LAS unsigned char* qi = lds + S8_QI + par * 32768; const LAS unsigned char* ex = lds + S8_EX + par * S8_EXSZ;
        SC_WAIT_V(4);
#pragma unroll
        for (int g = 0; g < 4; ++g) *(LAS u32x2g*)(st + r * 528 + (32 * w + 8 * g + 4 * hh) * 2) = (u32x2g){pk2(S[4 * g], S[4 * g + 1]), pk2(S[4 * g + 2], S[4 * g + 3])};
        asm volatile("s_waitcnt lgkmcnt(0)" ::: "memory"); __builtin_amdgcn_s_barrier(); SC_FENCE();
        S8_ISSUE_SHARED(cgn, par ^ 1);
        f32x4 o = {0.f, 0.f, 0.f, 0.f};
#pragma unroll
        for (int ks = 0; ks < 8; ++ks) { const bf16x8 a = *(const LAS bf16x8*)(qi + (16 * ti + fr) * 512 + 16 * ((4 * ks + fq) ^ x16)); const bf16x8 bb = *(const LAS bf16x8*)(st + (16 * tv + fr) * 528 + (32 * ks + 8 * fq) * 2); o = MFMA16(a, bb, o); }
#pragma unroll
        for (int k2 = 0; k2 < 2; ++k2) { const bf16x8 a = *(const LAS bf16x8*)(ex + (16 * ti + fr) * 128 + 16 * ((4 * k2 + fq) ^ xf)); const bf16x8 bb = *(const LAS bf16x8*)(ex + 8192 + (16 * tv + fr) * 128 + 16 * ((4 * k2 + fq) ^ xf)); o = MFMA16(a, bb, o); }
        { const unsigned ob = O0 + (unsigned)cg * (64u * DM * 4u) + (unsigned)((16 * ti + 4 * fq) * (DM * 4) + (16 * tv + fr) * 4);
#pragma unroll
          for (int reg = 0; reg < 4; ++reg) *(GAS float*)(ws + ob + (unsigned)(reg * DM * 4)) = o[reg]; }
        SC_WAIT_V(10);
        SC_FENCE();
#pragma unroll
        for (int g = 0; g < 4; ++g) { const f32x4 dc = *(const LAS f32x4*)(ex + 12288 + (32 * w + 8 * g + 4 * hh) * 4); S[4 * g] *= dc.x; S[4 * g + 1] *= dc.y; S[4 * g + 2] *= dc.z; S[4 * g + 3] *= dc.w; }
#pragma unroll
        for (int s4 = 0; s4 < 4; ++s4) { const bf16x8 ka = *(const LAS bf16x8*)(lds + S8_KST + w * 4096 + r * 128 + 16 * ((2 * s4 + hh) ^ xk)); const bf16x8 vb = *(const LAS bf16x8*)(ex + 8192 + r * 128 + 16 * ((2 * s4 + hh) ^ xk)); S = MFMA32(ka, vb, S); }
        asm volatile("s_waitcnt lgkmcnt(0)" ::: "memory");
        S8_ISSUE_KST(cgn);
        cg = cgn;
    }
    SC_WAIT_V(0);
    __builtin_amdgcn_s_barrier();
#undef S8_ISSUE_SHARED
#undef S8_ISSUE_KST
}

enum { PH_PRO_A = 0, PH_PRO_B, PH_WIN, PH_LA, PH_GLA, PH_GOUT, PH_GO, PH_WOUT, PH_LN0, PH_FFI, PH_FFO, PH_LN1, PH_COUNT };

template <int PH> __device__ __forceinline__ void run_phase(const Frame& F0, const Params& p0, int l) {
    Frame F = F0; asm volatile("" : "+v"(F.tid));
    F.lane = F.tid & 63; F.wave = __builtin_amdgcn_readfirstlane(F.tid >> 6); F.gw = F.vcu * NWAVES + F.wave;
    Params p = p0; asm volatile("" : "+s"(p.ws));
    const int M = (l == DEPTH - 1) ? MLAT : MTOT;
    bf16* H = (bf16*)(p.ws + WS_H); bf16* PROJ = (bf16*)(p.ws + WS_PROJ); bf16* ACT = (bf16*)(p.ws + WS_ACT); float* X = (float*)(p.ws + WS_X); float* V = (float*)(p.ws + WS_V);
    bf16* AGLA = (bf16*)(p.ws + WS_AGLA); bf16* T = (bf16*)(p.ws + WS_T); float* TEMP = (float*)(p.ws + WS_TEMP); bf16* MRG = (bf16*)(p.ws + WS_MRG);
    pg8::StaticOrder S;
    if constexpr (PH == PH_PRO_A) phase_prologue_a(F, p);
    if constexpr (PH == PH_PRO_B) {
        const int ng = F.G / 4, c = (int)blockIdx.x, lyr = c / ng < DEPTH ? c / ng : DEPTH - 1;
        pg8::Gemm g{wlayer(p, lyr, WO_PO), wlayer(p, lyr, WO_PG), DM, 1024, 1024}; S.init(DM, 1024, ng, c < DEPTH * ng ? c % ng : (1 << 20)); EpiBf16Plain E{wlayer(p, lyr, WO_PC), 1024};
        pg8::gemm_phase<EpiBf16Plain, pg8::StaticOrder, true, true>(F.lds, g, S, E);
        phase_prologue_b(F, p); }
    if constexpr (PH == PH_WIN) { pg8::Gemm g{H, wlayer(p, l, WO_IN), MTOT, NPROJ, DM}; S.init(MTOT, NPROJ, F.G, (int)blockIdx.x); EpiProj E{PROJ};
        pg8::gemm_phase<EpiProj, pg8::StaticOrder, true, true>(F.lds, g, S, E); }
    if constexpr (PH == PH_LA) { phase_pool<0>(F, p, F.gw, F.NGW); phase_gla_prep(F, p, l); }
    if constexpr (PH == PH_GLA) { phase_pool<1>(F, p, F.gw, F.NGW); phase_gla_scan(F, p); }
    if constexpr (PH == PH_GOUT) { phase_gout<2>(F, p, l, M);
        pg8::Gemm g{T, wlayer(p, l, WO_PC), MLAT, DM, DPOOL}; S.init(MLAT, DM, F.G, (int)blockIdx.x); EpiGateTemp E{TEMP, PROJ};
        pg8::gemm_phase<EpiGateTemp, pg8::StaticOrder, true, true>(F.lds, g, S, E);
        if (l < DEPTH - 1) small_gemm_ctx(F, T, wlayer(p, l, WO_PC), DPOOL, E); }
    if constexpr (PH == PH_GO) { pg8::Gemm g{AGLA, wlayer(p, l, WO_GO), MLAT, DM, DM}; S.init(MLAT, DM, F.G, (int)blockIdx.x); EpiMerge E{MRG, TEMP, PROJ};
        pg8::gemm_phase<EpiMerge, pg8::StaticOrder, true, true>(F.lds, g, S, E);
        if (l < DEPTH - 1) small_gemm_ctx(F, AGLA, wlayer(p, l, WO_GO), DM, E); }
    if constexpr (PH == PH_WOUT) { pg8::Gemm g{MRG, wlayer(p, l, WO_OUT), MLAT, DM, DM}; S.init(MLAT, DM, F.G, (int)blockIdx.x);
        EpiResid E{V, l == 0 ? p.x : X, l == 0 ? p.ctx : X + (size_t)MLAT * DM, modv(p, l, 0, 2)};
        pg8::gemm_phase<EpiResid, pg8::StaticOrder, true, true>(F.lds, g, S, E);
        if (l < DEPTH - 1) small_gemm_ctx(F, MRG, wlayer(p, l, WO_OUT), DM, E); }
    if constexpr (PH == PH_LN0) phase_ln(F, p, l, 0, M);
    if constexpr (PH == PH_FFI) { pg8::Gemm g{H, wlayer(p, l, WO_FI), M, NFFI, DM}; S.init(M, NFFI, F.G, (int)blockIdx.x); EpiSwiglu E{ACT};
        pg8::gemm_phase<EpiSwiglu, pg8::StaticOrder, true, true>(F.lds, g, S, E); }
    if constexpr (PH == PH_FFO) { pg8::Gemm g{ACT, wlayer(p, l, WO_FO), MLAT, DM, DFF}; S.init(MLAT, DM, F.G, (int)blockIdx.x);
        EpiResid E{V, X, X + (size_t)MLAT * DM, modv(p, l, 0, 5)};
        pg8::gemm_phase<EpiResid, pg8::StaticOrder, true, true>(F.lds, g, S, E);
        if (l < DEPTH - 1) small_gemm_ctx(F, ACT, wlayer(p, l, WO_FO), DFF, E); }
    if constexpr (PH == PH_LN1) phase_ln(F, p, l, 1, M);
}
__device__ __forceinline__ Frame make_frame(unsigned char* lds) {
    Frame F; F.lds = (LAS unsigned char*)lds; F.tid = threadIdx.x; F.lane = F.tid & 63; F.wave = __builtin_amdgcn_readfirstlane(F.tid >> 6);
    F.G = gridDim.x; const int bx = blockIdx.x; F.vcu = (F.G % 8 == 0) ? (bx % 8) * (F.G / 8) + bx / 8 : bx; F.gw = F.vcu * NWAVES + F.wave; F.NGW = F.G * NWAVES;
    return F;
}

constexpr int CW_BAR = 4096;
__device__ __forceinline__ XcdBarrier mkbar(const Params& p, unsigned x, volatile LAS unsigned* st) { unsigned char* w = p.ws; asm volatile("" : "+s"(w), "+s"(x)); XcdBarrier b; b.bar = (unsigned*)(w + WS_CTL) + CW_BAR; b.x = x; b.st = st; return b; }
#define PHASE(ph, l) do { run_phase<ph>(F, p, (l)); xcd_barrier(mkbar(p, bar_x, bar_st)); } while (0)
__global__ void __launch_bounds__(NTHREADS, 2) k_mega(Params p) {
    extern __shared__ __attribute__((aligned(16))) unsigned char lds[];
    const Frame F = make_frame(lds);
    for (int u = F.tid; u < (LDS_BYTES - MISC_OFF) / 4; u += NTHREADS) ((LAS unsigned*)(F.lds + MISC_OFF))[u] = 0u;
    __syncthreads();
    volatile LAS unsigned* const bar_st = (volatile LAS unsigned*)(F.lds + MISC_OFF) + 8;
    const unsigned bar_x = xcd_barrier_post((unsigned*)(p.ws + WS_CTL) + CW_BAR, bar_st).x;
    PHASE(PH_PRO_A, 0);
    PHASE(PH_PRO_B, 0);
    for (int l = 0; l < DEPTH; ++l) {
        PHASE(PH_WIN, l);
        PHASE(PH_LA, l);
        PHASE(PH_GLA, l);
        PHASE(PH_GOUT, l);
        PHASE(PH_GO, l);
        PHASE(PH_WOUT, l);
        PHASE(PH_LN0, l);
        PHASE(PH_FFI, l);
        PHASE(PH_FFO, l);
        if (l < DEPTH - 1) PHASE(PH_LN1, l); else run_phase<PH_LN1>(F, p, l);
    }
}

extern "C" void kernel_launch(void* const* d_in, const int* in_sizes, int n_in, void* d_out, int out_size, void* d_ws, size_t ws_size, hipStream_t stream) {
    static int grid = 0;
    if (grid == 0) {
        if (n_in != 21 || out_size != MLAT * DM || ws_size < WS_END) { fprintf(stderr, "kernel_launch: unexpected problem (n_in %d, out %d, ws %zu, need %zu)\n", n_in, out_size, ws_size, (size_t)WS_END); grid = -1; return; }
        int dev = 0, cus = 0, per_cu = 0;
        if (hipGetDevice(&dev) != hipSuccess || hipDeviceGetAttribute(&cus, hipDeviceAttributeMultiprocessorCount, dev) != hipSuccess) { grid = -1; return; }
        if (hipFuncSetAttribute((const void*)k_mega, hipFuncAttributeMaxDynamicSharedMemorySize, LDS_BYTES) != hipSuccess) { fprintf(stderr, "kernel_launch: hipFuncSetAttribute failed\n"); grid = -1; return; }
        if (hipOccupancyMaxActiveBlocksPerMultiprocessor(&per_cu, (const void*)k_mega, NTHREADS, LDS_BYTES) != hipSuccess || per_cu < 1) fprintf(stderr, "kernel_launch: occupancy query reports %d workgroups per CU\n", per_cu);
        (void)hipGetLastError();
        grid = cus;
    }
    if (grid < 0) return;
    (void)hipMemsetAsync((char*)d_ws + WS_CTL, 0, CTL_BYTES, stream);
    Params p{};
    const float** pp = (const float**)&p;
    for (int i = 0; i < 21; ++i) pp[i] = (const float*)d_in[i];
    p.out = (float*)d_out; p.ws = (unsigned char*)d_ws; p.layer = 0; p.pad = 0;
    hipLaunchKernelGGL(k_mega, dim3(grid), dim3(NTHREADS), LDS_BYTES, stream, p);
}
```
